# Optimizing an MI355X kernel written in HIP

```python
import functools
import jax, jax.numpy as jnp
from jax import lax
import numpy as np

D_MODEL = 1024
BATCH = 8
SEQ = 4096
DEPTH = 1
DEC_BATCH = 32
DEC_SEQ = 1
PAST_LEN = 16384
PAGE_SIZE = 128

D_RNN = D_MODEL
RNN_BLOCKS = 4
RNN_BLOCK_W = D_RNN // RNN_BLOCKS
CONV_W = 4
LRU_C = 8.0
N_HEADS = 8
HEAD_DIM = 128
N_KV_HEADS = 2
D_ATT = N_HEADS * HEAD_DIM
N_IDX_HEADS = 8
IDX_DIM = 64
IDX_W_SCALE = (N_IDX_HEADS * IDX_DIM) ** -0.5
TOPK_MAX = 256
ROPE_THETA = 10000.0
Q_BLOCK = 128
EPS = 1e-6
SPLITS = (D_RNN, D_RNN, D_ATT, N_KV_HEADS * HEAD_DIM, N_KV_HEADS * HEAD_DIM, D_ATT,
          N_IDX_HEADS * IDX_DIM, IDX_DIM, N_IDX_HEADS, D_MODEL, D_MODEL)
D_IN = sum(SPLITS)

kernel_name = 'hybrid_rglru_dsa_decoder_step'


def rms_norm(x, g):
    xf = x.astype(jnp.float32)
    y = xf * lax.rsqrt(jnp.mean(xf * xf, axis=-1, keepdims=True) + EPS)
    return (y * g.astype(jnp.float32)).astype(x.dtype)


def layer_norm(x, g, b):
    xf = x.astype(jnp.float32)
    mu = jnp.mean(xf, axis=-1, keepdims=True)
    var = jnp.mean(jnp.square(xf - mu), axis=-1, keepdims=True)
    y = (xf - mu) * lax.rsqrt(var + EPS) * g.astype(jnp.float32) + b.astype(jnp.float32)
    return y.astype(x.dtype)


def rotary(x, pos):
    half = x.shape[-1] // 2
    inv_freq = ROPE_THETA ** (-jnp.arange(half, dtype=jnp.float32) / half)
    ang = pos.astype(jnp.float32)[:, None] * inv_freq[None, :]
    cos = jnp.cos(ang)[None, :, None, :]
    sin = jnp.sin(ang)[None, :, None, :]
    xf = x.astype(jnp.float32)
    x1, x2 = xf[..., :half], xf[..., half:]
    return jnp.concatenate([x1 * cos - x2 * sin, x2 * cos + x1 * sin], axis=-1).astype(x.dtype)


def adaln_modulation(c, w, b):
    m = jax.nn.silu(c) @ w + b
    shift, scale, gate = jnp.split(m, 3, axis=-1)
    return shift[:, None, :], scale[:, None, :], gate[:, None, :]


def split_cols(z):
    offsets = np.cumsum(SPLITS)[:-1].tolist()
    return jnp.split(z, offsets, axis=-1)


def causal_depthwise_conv(x, buf, w, b):
    T = x.shape[1]
    xp = jnp.concatenate([buf.astype(x.dtype), x], axis=1)
    y = b
    for j in range(CONV_W):
        y = y + xp[:, j:j + T] * w[j]
    return y, xp[:, T:]


def block_diag(x, w):
    B, T, _ = x.shape
    xb = x.reshape(B, T, RNN_BLOCKS, RNN_BLOCK_W)
    return jnp.einsum('btnc,ncd->btnd', xb, w).reshape(B, T, D_RNN)


def rg_lru(x, h0, w_ra, b_ra, w_rx, b_rx, lam):
    r = jax.nn.sigmoid(block_diag(x, w_ra) + b_ra).astype(jnp.float32)
    i = jax.nn.sigmoid(block_diag(x, w_rx) + b_rx)
    log_a = -LRU_C * r * jax.nn.softplus(-lam.astype(jnp.float32))
    a = jnp.exp(log_a)
    u = jnp.sqrt(-jnp.expm1(2.0 * log_a)) * (i * x).astype(jnp.float32)

    def step(h, au):
        a_t, u_t = au
        h = a_t * h + u_t
        return h, h

    h_last, hs = lax.scan(step, h0.astype(jnp.float32), (jnp.swapaxes(a, 0, 1), jnp.swapaxes(u, 0, 1)))
    return jnp.swapaxes(hs, 0, 1).astype(x.dtype), h_last.astype(h0.dtype)


def take_rows(rows, idx):
    return jax.vmap(lambda r, i: r[i])(rows, idx)


def indexer_topk(qi, wi, ki, q_pos, k_sel):
    s = jnp.einsum('bthd,bsd->bths', qi, ki).astype(jnp.float32)
    score = jnp.einsum('bths,bth->bts', jax.nn.relu(s), wi.astype(jnp.float32))
    key_pos = jnp.arange(ki.shape[1], dtype=jnp.int32)
    admissible = key_pos[None, None, :] <= q_pos[None, :, None]
    score = jnp.where(admissible, score, -jnp.inf)
    _, sel = lax.top_k(score, k_sel)
    valid = sel <= q_pos[None, :, None]
    return sel, valid


def gathered_attention(q, k_sel, v_sel, valid):
    B, T, H, Dh = q.shape
    qg = q.reshape(B, T, N_KV_HEADS, H // N_KV_HEADS, Dh)
    s = jnp.einsum('btgrd,btkgd->btgrk', qg, k_sel).astype(jnp.float32) * (HEAD_DIM ** -0.5)
    s = jnp.where(valid[:, :, None, None, :], s, -jnp.inf)
    p = jax.nn.softmax(s, axis=-1).astype(v_sel.dtype)
    o = jnp.einsum('btgrk,btkgd->btgrd', p, v_sel)
    return o.reshape(B, T, H * Dh)


def prompt_sparse_attention(q, k, v, qi, ki, wi, pos, k_sel):
    B, S = q.shape[0], q.shape[1]

    def one_block(t0):
        sl = lambda arr: lax.dynamic_slice_in_dim(arr, t0, Q_BLOCK, axis=1)
        pos_b = lax.dynamic_slice_in_dim(pos, t0, Q_BLOCK, axis=0)
        sel, valid = indexer_topk(sl(qi), sl(wi), ki, pos_b, k_sel)
        return gathered_attention(sl(q), take_rows(k, sel), take_rows(v, sel), valid)

    o = lax.map(one_block, jnp.arange(0, S, Q_BLOCK))
    return jnp.swapaxes(o, 0, 1).reshape(B, S, -1)


def sample_sparse_attention(q, k, v, qi, ki, wi, pos, k_sel, cache_k, cache_v, cache_idx_k, page_table, layer):
    B, T = q.shape[0], q.shape[1]
    past_ki = cache_idx_k[layer, page_table].reshape(B, -1, IDX_DIM)
    past_len = past_ki.shape[1]
    all_ki = jnp.concatenate([past_ki.astype(ki.dtype), ki], axis=1)
    sel, valid = indexer_topk(qi, wi, all_ki, pos, k_sel)
    in_past = (sel < past_len)[..., None, None]
    sp = jnp.minimum(sel, past_len - 1)
    phys = jnp.take_along_axis(page_table, (sp // PAGE_SIZE).reshape(B, -1), axis=1).reshape(sel.shape)
    off = sp % PAGE_SIZE
    sn = jnp.clip(sel - past_len, 0, T - 1)
    k_rows = jnp.where(in_past, cache_k[layer, phys, off].astype(k.dtype), take_rows(k, sn))
    v_rows = jnp.where(in_past, cache_v[layer, phys, off].astype(v.dtype), take_rows(v, sn))
    return gathered_attention(q, k_rows, v_rows, valid)


def trunk_layer(x, c, pos, conv_buf, h0, attend, p):
    B, T, _ = x.shape
    shift, scale, gate = adaln_modulation(c, p['w_ada'], p['b_ada'])
    xn = rms_norm(x, p['g_norm']) * (1.0 + scale) + shift
    z = xn @ p['w_in']
    xa, ga, q, k, v, gb, qi, ki, wi, ma, mb = split_cols(z)
    xa_conv, new_buf = causal_depthwise_conv(xa, conv_buf, p['w_conv'], p['b_conv'])
    ha, h_last = rg_lru(xa_conv, h0, p['w_ra'], p['b_ra'], p['w_rx'], p['b_rx'], p['lru_lambda'])
    ya = (ha * jax.nn.silu(ga)) @ p['w_pa']
    q = rotary(q.reshape(B, T, N_HEADS, HEAD_DIM), pos)
    k = rotary(k.reshape(B, T, N_KV_HEADS, HEAD_DIM), pos)
    v = v.reshape(B, T, N_KV_HEADS, HEAD_DIM)
    qi = rotary(qi.reshape(B, T, N_IDX_HEADS, IDX_DIM), pos)
    ki = rotary(layer_norm(ki, p['idx_k_norm_g'], p['idx_k_norm_b'])[:, :, None, :], pos)[:, :, 0, :]
    wi = wi * IDX_W_SCALE
    o = attend(q, k, v, qi, ki, wi, pos)
    yb = (o * jax.nn.silu(gb)) @ p['w_pb']
    m = jax.nn.sigmoid(ma) * ya + jax.nn.sigmoid(mb) * yb
    x = x + gate * (m @ p['w_o'])
    return x, (k, v, ki, new_buf, h_last)


def setup_inputs(seed: int = 0) -> dict:
    key = jax.random.key(seed)
    ks = jax.random.split(key, 32)
    f32 = jnp.float32
    n_pages = PAST_LEN // PAGE_SIZE
    n_used = DEC_BATCH * n_pages
    n_pool = n_used + max(1, n_used // 4)
    nrm = lambda k, shape, s: s * jax.random.normal(k, shape, f32)
    page_table = jax.random.permutation(ks[0], n_pool)[:n_used].reshape(DEC_BATCH, n_pages).astype(jnp.int32)
    a_base = jax.random.uniform(ks[1], (DEPTH, D_RNN), f32, 0.9, 0.999)
    s_base = a_base ** (1.0 / LRU_C)
    lru_lambda = jnp.log(s_base) - jnp.log1p(-s_base)
    return {
        'x_prompt': nrm(ks[2], (BATCH, SEQ, D_MODEL), 1.0),
        'x_sample': nrm(ks[3], (DEC_BATCH, DEC_SEQ, D_MODEL), 1.0),
        'cache_k': nrm(ks[4], (DEPTH, n_pool, PAGE_SIZE, N_KV_HEADS, HEAD_DIM), 1.0),
        'cache_v': nrm(ks[5], (DEPTH, n_pool, PAGE_SIZE, N_KV_HEADS, HEAD_DIM), 1.0),
        'cache_idx_k': nrm(ks[6], (DEPTH, n_pool, PAGE_SIZE, IDX_DIM), 1.0),
        'state_conv': nrm(ks[7], (DEPTH, DEC_BATCH, CONV_W - 1, D_RNN), 1.0),
        'state_rglru': nrm(ks[8], (DEPTH, DEC_BATCH, D_RNN), 0.5),
        'page_table': page_table,
        'c_prompt': nrm(ks[9], (BATCH, D_MODEL), 1.0),
        'c_sample': nrm(ks[10], (DEC_BATCH, D_MODEL), 1.0),
        'w_ada': nrm(ks[11], (DEPTH, D_MODEL, 3 * D_MODEL), 0.5 * D_MODEL ** -0.5),
        'b_ada': nrm(ks[12], (DEPTH, 3 * D_MODEL), 0.02),
        'g_norm': 1.0 + nrm(ks[13], (DEPTH, D_MODEL), 0.02),
        'w_in': nrm(ks[14], (DEPTH, D_MODEL, D_IN), D_MODEL ** -0.5),
        'w_conv': nrm(ks[15], (DEPTH, CONV_W, D_RNN), CONV_W ** -0.5),
        'b_conv': nrm(ks[16], (DEPTH, D_RNN), 0.02),
        'w_ra': nrm(ks[17], (DEPTH, RNN_BLOCKS, RNN_BLOCK_W, RNN_BLOCK_W), RNN_BLOCK_W ** -0.5),
        'b_ra': nrm(ks[18], (DEPTH, D_RNN), 0.02),
        'w_rx': nrm(ks[19], (DEPTH, RNN_BLOCKS, RNN_BLOCK_W, RNN_BLOCK_W), RNN_BLOCK_W ** -0.5),
        'b_rx': nrm(ks[20], (DEPTH, D_RNN), 0.02),
        'lru_lambda': lru_lambda,
        'idx_k_norm_g': 1.0 + nrm(ks[21], (DEPTH, IDX_DIM), 0.02),
        'idx_k_norm_b': nrm(ks[22], (DEPTH, IDX_DIM), 0.02),
        'w_pa': nrm(ks[23], (DEPTH, D_RNN, D_MODEL), D_RNN ** -0.5),
        'w_pb': nrm(ks[24], (DEPTH, D_ATT, D_MODEL), D_ATT ** -0.5),
        'w_o': nrm(ks[25], (DEPTH, D_MODEL, D_MODEL), D_MODEL ** -0.5),
        'g_final': 1.0 + nrm(ks[26], (D_MODEL,), 0.02),
    }


def reference(x_prompt, x_sample, cache_k, cache_v, cache_idx_k, state_conv, state_rglru, page_table,
              c_prompt, c_sample, w_ada, b_ada, g_norm, w_in, w_conv, b_conv, w_ra, b_ra, w_rx, b_rx,
              lru_lambda, idx_k_norm_g, idx_k_norm_b, w_pa, w_pb, w_o, g_final):
    pos_prompt = jnp.arange(SEQ, dtype=jnp.int32)
    pos_sample = PAST_LEN + jnp.arange(DEC_SEQ, dtype=jnp.int32)
    k_prompt = min(TOPK_MAX, SEQ // 4)
    k_sample = min(TOPK_MAX, (PAST_LEN + DEC_SEQ) // 4)
    hp, hs = x_prompt, x_sample
    kp, vp, kip, cp, lp = [], [], [], [], []
    ksm, vsm, kism, csm, lsm = [], [], [], [], []
    for l in range(DEPTH):
        p = {
            'w_ada': w_ada[l], 'b_ada': b_ada[l], 'g_norm': g_norm[l], 'w_in': w_in[l],
            'w_conv': w_conv[l], 'b_conv': b_conv[l], 'w_ra': w_ra[l], 'b_ra': b_ra[l],
            'w_rx': w_rx[l], 'b_rx': b_rx[l], 'lru_lambda': lru_lambda[l],
            'idx_k_norm_g': idx_k_norm_g[l], 'idx_k_norm_b': idx_k_norm_b[l],
            'w_pa': w_pa[l], 'w_pb': w_pb[l], 'w_o': w_o[l],
        }
        prompt_attend = functools.partial(prompt_sparse_attention, k_sel=k_prompt)
        sample_attend = functools.partial(sample_sparse_attention, k_sel=k_sample, cache_k=cache_k,
                                          cache_v=cache_v, cache_idx_k=cache_idx_k,
                                          page_table=page_table, layer=l)
        conv0 = jnp.zeros((BATCH, CONV_W - 1, D_RNN), x_prompt.dtype)
        h0 = jnp.zeros((BATCH, D_RNN), x_prompt.dtype)
        hp, st_p = trunk_layer(hp, c_prompt, pos_prompt, conv0, h0, prompt_attend, p)
        hs, st_s = trunk_layer(hs, c_sample, pos_sample, state_conv[l], state_rglru[l], sample_attend, p)
        kp.append(st_p[0]); vp.append(st_p[1]); kip.append(st_p[2]); cp.append(st_p[3]); lp.append(st_p[4])
        ksm.append(st_s[0]); vsm.append(st_s[1]); kism.append(st_s[2]); csm.append(st_s[3]); lsm.append(st_s[4])
    y_prompt = rms_norm(hp, g_final)
    y_sample = rms_norm(hs, g_final)
    new_k_prompt = jnp.stack(kp)
    new_v_prompt = jnp.stack(vp)
    new_idx_k_prompt = jnp.stack(kip)
    new_conv_prompt = jnp.stack(cp)
    new_lru_prompt = jnp.stack(lp)
    new_k_sample = jnp.stack(ksm)
    new_v_sample = jnp.stack(vsm)
    new_idx_k_sample = jnp.stack(kism)
    new_conv_sample = jnp.stack(csm)
    new_lru_sample = jnp.stack(lsm)
    return (y_prompt, y_sample, new_k_prompt, new_v_prompt, new_idx_k_prompt, new_conv_prompt, new_lru_prompt,
            new_k_sample, new_v_sample, new_idx_k_sample, new_conv_sample, new_lru_sample)
```

```cpp
#include <hip/hip_runtime.h>
#include <cstdio>
#include <cstdint>

#ifndef N_LAUNCH_MODE
#define N_LAUNCH_MODE 1
#endif
#ifndef LAST_PHASE
#define LAST_PHASE 7
#endif

namespace pg8 {
#define PG8_LAS __attribute__((address_space(3)))
typedef unsigned short bf16_t;
typedef short bf16x8 __attribute__((ext_vector_type(8)));
typedef float f32x4 __attribute__((ext_vector_type(4)));
typedef unsigned u32x4 __attribute__((ext_vector_type(4)));
typedef unsigned u32x2 __attribute__((ext_vector_type(2)));
constexpr int BM = 256, BK = 64, HALF = 128, HTB = HALF * BK * 2, STAGE_BYTES = 8 * HTB, NXCD = 8, WGM = 8;

__host__ __device__ __forceinline__ int lds_byte(int r, int c) { const int st = (r >> 4) * 2 + (c >> 5), rr = r & 15, cc = c & 31, ob = rr * 64 + cc * 2; return st * 1024 + (ob ^ (((ob >> 9) & 1) << 5)); }
__host__ __device__ __forceinline__ void stage_rc(int b, int& R, int& C) { const int st = b / 1024, sb = b % 1024, swz = sb ^ (((sb >> 9) & 1) << 5); R = (st >> 1) * 16 + swz / 64; C = (st & 1) * 32 + (swz % 64) / 2; }

struct Unit { int pm, pn; };
struct Gemm { const bf16_t* A; const bf16_t* Bt; int M, N, K; };

struct StaticOrder {
    int nM, nN, nwg, G, c;
    __host__ __device__ void init(int M, int N, int G_, int c_) { nM = M / BM; nN = N / BM; nwg = nM * nN; G = G_; c = c_; }
    __host__ __device__ bool next(int i, Unit& u) const {
        const long L = (long)i * G + c; if (L >= nwg) return false;
        int wgid = (int)L; { const int q = nwg / NXCD, r = nwg % NXCD, xcd = wgid % NXCD, off = wgid / NXCD; wgid = (xcd < r ? xcd * (q + 1) : r * (q + 1) + (xcd - r) * q) + off; }
        const int nig = WGM * nN, gid = wgid / nig, fm = gid * WGM, gsz = (nM - fm) < WGM ? (nM - fm) : WGM;
        u.pm = fm + ((wgid % nig) % gsz); u.pn = (wgid % nig) / gsz; return true;
    }
    __device__ __forceinline__ void a_ready(const Unit&) const {}
    __device__ __forceinline__ void done(const Unit&) const {}
};

__device__ __forceinline__ unsigned cvt_pk_bf16(float lo, float hi) { unsigned r; asm volatile("v_cvt_pk_bf16_f32 %0, %1, %2" : "=v"(r) : "v"(lo), "v"(hi)); return r; }

template <class Epi, class Sched, bool ALIGN_EPI = false, bool SP2 = true>
__device__ __forceinline__ void gemm_phase(PG8_LAS unsigned char* lds, const Gemm g, const Sched& S, const Epi& E) {
    const int tid = threadIdx.x, wid = __builtin_amdgcn_readfirstlane(tid >> 6), lane = tid & 63, wr = wid >> 2, wc = wid & 3, fr = lane & 15, fq = lane >> 4;
    const int K = g.K, nt = K / BK;
    unsigned voffA[2], voffB[2];
#pragma unroll
    for (int i = 0; i < 2; ++i) { int R, C; stage_rc(tid * 16 + i * 8192, R, C);
        voffA[i] = (unsigned)(R * K + C) * 2u; voffB[i] = (unsigned)(R * K + C) * 2u; }
    const size_t kstep = (size_t)(BK * 2);
    const size_t hstep = (size_t)HALF * K * 2;
    const size_t tstep = 2 * hstep;
    const unsigned ldsw = (unsigned)wid * 1024u;
    const int aoff = lds_byte(wr * 64 + fr, fq * 8), boff = lds_byte(wc * 32 + fr, fq * 8);
#define PG8_SA(b, h) (((b) * 2 + (h)) * HTB)
#define PG8_SB(b, h) ((4 + (b) * 2 + (h)) * HTB)
#define PG8_STAGE(bufoff, gbase, voff) do { _Pragma("unroll") for (int _i = 0; _i < 2; ++_i) \
        __builtin_amdgcn_global_load_lds((const unsigned*)((const char*)(gbase) + (voff)[_i]), (PG8_LAS unsigned*)(lds + (bufoff) + ldsw + _i * 8192), 16, 0, 0); } while (0)
#define PG8_LDA(dst, b, h) do { _Pragma("unroll") for (int m = 0; m < 4; ++m) _Pragma("unroll") for (int k = 0; k < 2; ++k) dst[m][k] = *(const PG8_LAS bf16x8*)(lds + PG8_SA(b, h) + aoff + m * 2048 + k * 1024); } while (0)
#define PG8_LDB(dst, b, h) do { _Pragma("unroll") for (int n = 0; n < 2; ++n) _Pragma("unroll") for (int k = 0; k < 2; ++k) dst[n][k] = *(const PG8_LAS bf16x8*)(lds + PG8_SB(b, h) + boff + n * 2048 + k * 1024); } while (0)
#define PG8_MMA(ai, bj, At, Bt) do { __builtin_amdgcn_s_setprio(1); _Pragma("unroll") for (int m = 0; m < 4; ++m) _Pragma("unroll") for (int n = 0; n < 2; ++n) _Pragma("unroll") for (int k = 0; k < 2; ++k) \
        acc[ai][bj][m][n] = __builtin_amdgcn_mfma_f32_16x16x32_bf16(Bt[n][k], At[m][k], acc[ai][bj][m][n], 0, 0, 0); __builtin_amdgcn_s_setprio(0); } while (0)
#define PG8_WAIT_V(n) asm volatile("s_waitcnt vmcnt(" #n ")" ::: "memory")
#define PG8_WAIT_L(n) asm volatile("s_waitcnt lgkmcnt(" #n ")" ::: "memory")
#define PG8_BAR __builtin_amdgcn_s_barrier()
#define PG8_SCHED __builtin_amdgcn_sched_barrier(0)
    Unit cur, nxt; int ui = 0;
    if (!S.next(0, cur)) return;
    f32x4 acc[2][2][4][2];
#pragma unroll
    for (int a = 0; a < 2; ++a)
#pragma unroll
        for (int b = 0; b < 2; ++b)
#pragma unroll
            for (int m = 0; m < 4; ++m)
#pragma unroll
                for (int n = 0; n < 2; ++n) acc[a][b][m][n] = (f32x4){0.f, 0.f, 0.f, 0.f};
    bf16x8 At[4][2], B0[2][2], B1[2][2];
    const char* cA = (const char*)g.A + (size_t)cur.pm * tstep; const char* cB = (const char*)g.Bt + (size_t)cur.pn * tstep;
    S.a_ready(cur);
    if constexpr (SP2) {
        PG8_STAGE(PG8_SB(0, 0), cB, voffB); PG8_STAGE(PG8_SB(0, 1), cB + hstep, voffB); PG8_STAGE(PG8_SA(0, 0), cA, voffA); PG8_STAGE(PG8_SA(0, 1), cA + hstep, voffA);
        if (wr == 1) PG8_BAR;
        PG8_WAIT_V(2); PG8_BAR;
        PG8_STAGE(PG8_SB(1, 0), cB + kstep, voffB); PG8_STAGE(PG8_SA(1, 0), cA + kstep, voffA); PG8_STAGE(PG8_SB(1, 1), cB + hstep + kstep, voffB);
        PG8_WAIT_V(6); PG8_BAR;
    } else {
        PG8_STAGE(PG8_SB(0, 0), cB, voffB); PG8_STAGE(PG8_SA(0, 0), cA, voffA); PG8_STAGE(PG8_SB(0, 1), cB + hstep, voffB); PG8_STAGE(PG8_SA(0, 1), cA + hstep, voffA);
        if (wr == 1) PG8_BAR;
        PG8_WAIT_V(4); PG8_BAR;
        PG8_STAGE(PG8_SB(1, 0), cB + kstep, voffB); PG8_STAGE(PG8_SA(1, 0), cA + kstep, voffA); PG8_STAGE(PG8_SB(1, 1), cB + hstep + kstep, voffB);
        PG8_WAIT_V(6); PG8_BAR;
    }
    for (;;) {
        const bool has_next = S.next(ui + 1, nxt);
        const char* nA = has_next ? (const char*)g.A + (size_t)nxt.pm * tstep : cA; const char* nB = has_next ? (const char*)g.Bt + (size_t)nxt.pn * tstep : cB;
        for (int t = 0; t < nt; t += 2) {
            const bool last = (t == nt - 2);
            const char* a1 = cA + (size_t)(t + 1) * kstep;
            const char* a2 = last ? nA : cA + (size_t)(t + 2) * kstep; const char* b2 = last ? nB : cB + (size_t)(t + 2) * kstep;
            const char* a3 = a2 + kstep; const char* b3 = b2 + kstep;
            if (last && has_next) S.a_ready(nxt);
            if constexpr (SP2) {
            PG8_LDB(B0, 0, 0); PG8_LDB(B1, 0, 1); PG8_SCHED; PG8_LDA(At, 0, 0); PG8_STAGE(PG8_SA(1, 1), a1 + hstep, voffA);
            PG8_WAIT_V(8); PG8_WAIT_L(0); PG8_BAR; PG8_MMA(0, 0, At, B0); PG8_MMA(0, 1, At, B1); PG8_BAR; PG8_SCHED;
            PG8_LDA(At, 0, 1); PG8_STAGE(PG8_SB(0, 0), b2, voffB); PG8_STAGE(PG8_SB(0, 1), b2 + hstep, voffB); PG8_STAGE(PG8_SA(0, 0), a2, voffA);
            PG8_WAIT_V(8); PG8_WAIT_L(0); PG8_BAR; PG8_MMA(1, 0, At, B0); PG8_MMA(1, 1, At, B1); PG8_BAR; PG8_SCHED;
            PG8_LDB(B0, 1, 0); PG8_LDB(B1, 1, 1); PG8_SCHED; PG8_LDA(At, 1, 0); PG8_STAGE(PG8_SA(0, 1), a2 + hstep, voffA);
            PG8_WAIT_V(8); PG8_WAIT_L(0); PG8_BAR; PG8_MMA(0, 0, At, B0); PG8_MMA(0, 1, At, B1); PG8_BAR; PG8_SCHED;
            PG8_LDA(At, 1, 1); PG8_STAGE(PG8_SB(1, 0), b3, voffB); PG8_STAGE(PG8_SB(1, 1), b3 + hstep, voffB); PG8_STAGE(PG8_SA(1, 0), a3, voffA);
            PG8_WAIT_V(8); PG8_WAIT_L(0); PG8_BAR; PG8_MMA(1, 0, At, B0); PG8_MMA(1, 1, At, B1); PG8_BAR; PG8_SCHED;
            } else {
            PG8_LDB(B0, 0, 0); PG8_SCHED; PG8_LDA(At, 0, 0); PG8_STAGE(PG8_SA(1, 1), a1 + hstep, voffA);
            PG8_WAIT_L(8); PG8_BAR; PG8_WAIT_L(0); PG8_MMA(0, 0, At, B0); PG8_BAR; PG8_SCHED;
            PG8_LDB(B1, 0, 1); PG8_STAGE(PG8_SB(0, 0), b2, voffB);
            PG8_BAR; PG8_WAIT_L(0); PG8_MMA(0, 1, At, B1); PG8_BAR;
            PG8_LDA(At, 0, 1); PG8_STAGE(PG8_SA(0, 0), a2, voffA);
            PG8_BAR; PG8_WAIT_L(0); PG8_MMA(1, 0, At, B0); PG8_BAR; PG8_SCHED;
            PG8_STAGE(PG8_SB(0, 1), b2 + hstep, voffB);
            PG8_WAIT_V(6); PG8_BAR; PG8_MMA(1, 1, At, B1); PG8_BAR;
            PG8_LDB(B0, 1, 0); PG8_SCHED; PG8_LDA(At, 1, 0); PG8_STAGE(PG8_SA(0, 1), a2 + hstep, voffA);
            PG8_WAIT_L(8); PG8_BAR; PG8_WAIT_L(0); PG8_MMA(0, 0, At, B0); PG8_BAR; PG8_SCHED;
            PG8_LDB(B1, 1, 1); PG8_STAGE(PG8_SB(1, 0), b3, voffB);
            PG8_BAR; PG8_WAIT_L(0); PG8_MMA(0, 1, At, B1); PG8_BAR;
            PG8_LDA(At, 1, 1); PG8_STAGE(PG8_SA(1, 0), a3, voffA);
            PG8_BAR; PG8_WAIT_L(0); PG8_MMA(1, 0, At, B0); PG8_BAR; PG8_SCHED;
            PG8_STAGE(PG8_SB(1, 1), b3 + hstep, voffB);
            PG8_WAIT_V(6); PG8_BAR; PG8_MMA(1, 1, At, B1); PG8_BAR;
            }
        }
        if constexpr (ALIGN_EPI) { if (wr == 0) PG8_BAR; }
        E(acc, cur, wr, wc, fr, fq); S.done(cur);
        if (!has_next) break;
#pragma unroll
        for (int a = 0; a < 2; ++a)
#pragma unroll
            for (int b = 0; b < 2; ++b)
#pragma unroll
                for (int m = 0; m < 4; ++m)
#pragma unroll
                    for (int n = 0; n < 2; ++n) acc[a][b][m][n] = (f32x4){0.f, 0.f, 0.f, 0.f};
        cur = nxt; cA = nA; cB = nB; ++ui;
        if constexpr (ALIGN_EPI) { if (wr == 1) PG8_BAR; }
    }
    PG8_WAIT_V(0);
    if constexpr (!ALIGN_EPI) { if (wr == 0) PG8_BAR; }
    PG8_BAR;
#undef PG8_SA
#undef PG8_SB
#undef PG8_STAGE
#undef PG8_LDA
#undef PG8_LDB
#undef PG8_MMA
#undef PG8_WAIT_V
#undef PG8_WAIT_L
#undef PG8_BAR
#undef PG8_SCHED
}
}

constexpr int DM = 1024, NBATCH = 8, SEQ = 4096, MP = NBATCH * SEQ, NS = 32, MT = MP + 256;
constexpr int PAST = 16384, PAGE = 128, NPG = PAST / PAGE;
constexpr int D_IN = 7240, NT_IN = 29, N_IN_PAD = NT_IN * 256;
constexpr int C_XA = 0, C_GA = 1024, C_Q = 2048, C_K = 3072, C_V = 3328, C_GB = 3584, C_QI = 4608, C_KI = 5120, C_WI = 5184, C_MA = 5192, C_MB = 6216;
constexpr float EPS = 1e-6f;
constexpr float IDX_W_SCALE = 0.04419417382415922f;
constexpr int NWAVES = 8, NTHR = 512;

constexpr size_t O_YP = 0, O_YS = O_YP + (size_t)MP * DM, O_KP = O_YS + (size_t)NS * DM, O_VP = O_KP + (size_t)MP * 256, O_IKP = O_VP + (size_t)MP * 256,
                 O_CP = O_IKP + (size_t)MP * 64, O_LP = O_CP + (size_t)NBATCH * 3 * DM, O_KS = O_LP + (size_t)NBATCH * DM, O_VS = O_KS + (size_t)NS * 256,
                 O_IKS = O_VS + (size_t)NS * 256, O_CS = O_IKS + (size_t)NS * 64, O_LS = O_CS + (size_t)NS * 3 * DM, O_END = O_LS + (size_t)NS * DM;

constexpr size_t MiB = 1u << 20;
constexpr size_t WS_CTL = 0;
constexpr size_t WS_MOD = 1 * MiB;
constexpr size_t WS_SUMSQ = WS_MOD + 512 * 1024;
constexpr size_t ZERO_BYTES = 2 * MiB;
constexpr size_t WS_RT128 = 2 * MiB;
constexpr size_t WS_RT64 = WS_RT128 + 3 * MiB;
constexpr size_t WS_WG = 7 * MiB;
constexpr size_t WS_WPA = 8 * MiB, WS_WPB = 10 * MiB, WS_WO = 12 * MiB;
constexpr size_t WS_WIN = 14 * MiB;
constexpr size_t WS_WI = 30 * MiB;
constexpr size_t WS_KI = 32 * MiB;
constexpr size_t WS_SSC = 38 * MiB;
constexpr size_t WS_MSK = 48 * MiB;
constexpr size_t ACT = (size_t)MT * DM * 2;
constexpr size_t WS_XN = 64 * MiB;
constexpr size_t WS_XA = WS_XN + 65 * MiB, WS_SGA = WS_XA + 65 * MiB, WS_Q = WS_SGA + 65 * MiB, WS_SGB = WS_Q + 65 * MiB, WS_SMA = WS_SGB + 65 * MiB, WS_SMB = WS_SMA + 65 * MiB;
constexpr size_t WS_PA = WS_SMB + 65 * MiB, WS_PB = WS_PA + 65 * MiB, WS_T1 = WS_PB + 65 * MiB, WS_MM = WS_T1 + 65 * MiB;
constexpr size_t WS_KB = WS_MM + 65 * MiB, WS_VB = WS_KB + 17 * MiB, WS_QI = WS_VB + 17 * MiB, WS_END = WS_QI + 33 * MiB;
static_assert(ACT <= 65 * MiB, "activation size");

constexpr int CW_BAR = 4096;

constexpr int RING_BYTES = 131072;
constexpr int LDSCTL_OFF = 160 * 1024 - 512, LDS_BYTES = 160 * 1024;

#define GAS __attribute__((address_space(1)))
#define LAS __attribute__((address_space(3)))
typedef unsigned short bf16;
typedef unsigned v4u __attribute__((ext_vector_type(4)));
typedef unsigned v2u __attribute__((ext_vector_type(2)));
typedef float f32x4 __attribute__((ext_vector_type(4)));
typedef float f32x2 __attribute__((ext_vector_type(2)));
typedef short bf16x8 __attribute__((ext_vector_type(8)));
#define LDS_WAIT() asm volatile("s_waitcnt lgkmcnt(0)" ::: "memory")
#define VM_WAIT() asm volatile("s_waitcnt vmcnt(0)" ::: "memory")
__device__ __forceinline__ unsigned f2bf(float f) { unsigned u = __builtin_bit_cast(unsigned, f); return (u + 0x7fffu + ((u >> 16) & 1u)) >> 16; }
__device__ __forceinline__ unsigned pk2(float lo, float hi) { return f2bf(lo) | (f2bf(hi) << 16); }
__device__ __forceinline__ float bf2f(unsigned short b) { return __uint_as_float(((unsigned)b) << 16); }
__device__ __forceinline__ float sigmoidf_(float x) { return 1.0f / (1.0f + __expf(-x)); }
__device__ __forceinline__ float siluf_(float x) { return x / (1.0f + __expf(-x)); }

#define XB_TMO      128
#define XB_XCNT(j)  (256  + 64 * (j))
#define XB_XSUB(j)  (1280 + 64 * (j))
#define XB_XGEN(j)  (2304 + 64 * (j))
#define XB_TOP      3328
#define XB_TOPGEN   3392
#define XCD_BAR_WORDS 3456
#define XB_SPIN_CAP (1u << 18)
__device__ __forceinline__ unsigned xb_ld(unsigned* p)              { return __hip_atomic_load(p, __ATOMIC_RELAXED, __HIP_MEMORY_SCOPE_AGENT); }
__device__ __forceinline__ unsigned xb_add(unsigned* p, unsigned v) { return __hip_atomic_fetch_add(p, v, __ATOMIC_RELAXED, __HIP_MEMORY_SCOPE_AGENT); }
__device__ __forceinline__ unsigned xb_xcc_id() { return (unsigned)__builtin_amdgcn_s_getreg((3 << 11) | 20) & 0xFu; }
#define XB_SPIN(cond, bar) do { unsigned _sp = 0; while (cond) { __builtin_amdgcn_s_sleep(1); \
    if ((++_sp & 255u) == 0u) { if (xb_ld(&(bar)[XB_TMO])) break; if (_sp > XB_SPIN_CAP) { atomicAdd(&(bar)[XB_TMO], 1u); break; } } } } while (0)
struct XcdBarrier { unsigned* bar; unsigned x; volatile LAS unsigned* st; };
__device__ __forceinline__ XcdBarrier xcd_barrier_post(unsigned* bar, volatile LAS unsigned* st) {
    XcdBarrier b; b.bar = bar; b.x = xb_xcc_id(); b.st = st;
    if (threadIdx.x == 0) (void)xb_add(&bar[XB_XCNT(b.x)], 1u);
    return b;
}
__device__ __forceinline__ void xcd_barrier_complete(unsigned* bar, unsigned x, unsigned& nloc, unsigned& nx) {
    const unsigned G = gridDim.x * gridDim.y * gridDim.z;
    unsigned sum, cnt, mine, sp = 0u;
    for (;;) {
        sum = 0u; cnt = 0u; mine = 0u;
#pragma unroll
        for (unsigned j = 0; j < 16; ++j) { const unsigned c = xb_ld(&bar[XB_XCNT(j)]); sum += c; cnt += (c > 0u) ? 1u : 0u; mine = (j == x) ? c : mine; }
        if (sum == G) break;
        __builtin_amdgcn_s_sleep(1);
        if ((++sp & 255u) == 0u) { if (xb_ld(&bar[XB_TMO])) break; if (sp > XB_SPIN_CAP) { atomicAdd(&bar[XB_TMO], 1u); break; } }
    }
    nloc = mine > 0u ? mine : 1u; nx = cnt > 0u ? cnt : 1u;
}
__device__ __forceinline__ void xcd_barrier(const XcdBarrier& b) {
    asm volatile("s_waitcnt vmcnt(0)" ::: "memory");
    __syncthreads();
    if (threadIdx.x == 0) {
        unsigned* bar = b.bar;
        __builtin_amdgcn_s_waitcnt(0);
        unsigned nloc = b.st[0], nx = b.st[1];
        if (nloc == 0u) { xcd_barrier_complete(bar, b.x, nloc, nx); b.st[0] = nloc; b.st[1] = nx; }
        const unsigned old = xb_add(&bar[XB_XSUB(b.x)], 1u);
        const unsigned gen = old / nloc;
        if (old + 1u == (gen + 1u) * nloc) {
            __builtin_amdgcn_fence(__ATOMIC_RELEASE, "agent");
            asm volatile("s_waitcnt vmcnt(0)" ::: "memory");
            const unsigned og = xb_add(&bar[XB_TOP], 1u);
            const unsigned tg = og / nx;
            if (og + 1u == (tg + 1u) * nx) xb_add(&bar[XB_TOPGEN], 1u);
            else XB_SPIN(xb_ld(&bar[XB_TOPGEN]) == tg, bar);
            __builtin_amdgcn_fence(__ATOMIC_ACQUIRE, "agent");
            xb_add(&bar[XB_XGEN(b.x)], 1u);
            asm volatile("s_waitcnt vmcnt(0)" ::: "memory");
        } else {
            XB_SPIN(xb_ld(&bar[XB_XGEN(b.x)]) == gen, bar);
            __builtin_amdgcn_fence(__ATOMIC_ACQUIRE, "agent");
            asm volatile("s_waitcnt vmcnt(0)" ::: "memory");
        }
    }
    __syncthreads();
}

struct Args { const float* in[27]; const int* page_table; float* out; unsigned char* ws; int ph_lo, ph_hi; };
struct Frame {
    LAS unsigned char* lds;
    int tid, lane, wave, vcu, G;
    const float* const* in;
    float* out; unsigned char* ws;
};
__device__ __forceinline__ float wave_sum(float v) {
#pragma unroll
    for (int o = 1; o < 64; o <<= 1) v += __shfl_xor(v, o);
    return v;
}

__host__ __device__ __forceinline__ int perm_plain(int g) { const int bj = g >> 7, wc = (g >> 5) & 3, n = (g >> 4) & 1, fq = (g >> 2) & 3, j = g & 3; return 128 * bj + 32 * wc + 8 * fq + 4 * n + j; }
__host__ __device__ __forceinline__ int perm_rot128(int g) { const int bj = g >> 7, wc = (g >> 5) & 3, n = (g >> 4) & 1, fq = (g >> 2) & 3, j = g & 3; return 128 * bj + 64 * n + 16 * wc + 4 * fq + j; }
__host__ __device__ __forceinline__ int perm_rot64(int g) { const int bj = g >> 7, wc = (g >> 5) & 3, n = (g >> 4) & 1, fq = (g >> 2) & 3, j = g & 3; return 64 * (2 * bj + (wc >> 1)) + 32 * n + 16 * (wc & 1) + 4 * fq + j; }
__device__ __forceinline__ int win_src_col(int gg) {
    const int pn = gg >> 8, g = gg & 255;
    if (pn < 4)  return C_XA + pn * 256 + perm_plain(g);
    if (pn < 8)  return C_GA + (pn - 4) * 256 + perm_plain(g);
    if (pn < 12) return C_Q + (pn - 8) * 256 + perm_rot128(g);
    if (pn == 12) return C_K + perm_rot128(g);
    if (pn == 13) return C_V + perm_plain(g);
    if (pn < 18) return C_GB + (pn - 14) * 256 + perm_plain(g);
    if (pn < 20) return C_QI + (pn - 18) * 256 + perm_rot64(g);
    if (pn == 20) { const int bj = g >> 7, wc = (g >> 5) & 3, n = (g >> 4) & 1, fq = (g >> 2) & 3, j = g & 3;
        if (wc == 0) return C_KI + 32 * bj + 16 * n + 4 * fq + j;
        if (wc == 1 && bj == 0 && n == 0 && fq < 2) return C_WI + 4 * fq + j;
        return -1; }
    if (pn < 25) return C_MA + (pn - 21) * 256 + perm_plain(g);
    return C_MB + (pn - 25) * 256 + perm_plain(g);
}

template <int MODE>
__device__ __forceinline__ void p0_transpose_item(const float* W, int K, int N, bf16* WT, LAS float* scr, int item, int lane, int ndst) {
    const int nblk = ndst / 32, kb = item / nblk, nb = item % nblk, k0 = 64 * kb, g0 = 32 * nb;
    const int gme = g0 + (lane & 31);
    int src;
    if (MODE == 0) src = win_src_col(gme);
    else if (MODE == 1) src = (gme & ~255) + perm_plain(gme & 255);
    else src = gme;
#pragma unroll 8
    for (int i = 0; i < 32; ++i) { const int kk = 2 * i + (lane >> 5); scr[kk * 33 + (lane & 31)] = (src >= 0) ? W[(size_t)(k0 + kk) * N + src] : 0.f; }
    LDS_WAIT(); asm volatile("" ::: "memory");
    const int c = lane & 7;
#pragma unroll
    for (int j = 0; j < 4; ++j) { const int n = (lane >> 3) + 8 * j; const LAS float* s = scr + (8 * c) * 33 + n;
        v4u o; o.x = pk2(s[0 * 33], s[1 * 33]); o.y = pk2(s[2 * 33], s[3 * 33]); o.z = pk2(s[4 * 33], s[5 * 33]); o.w = pk2(s[6 * 33], s[7 * 33]);
        *(GAS v4u*)(WT + (size_t)(g0 + n) * K + k0 + 8 * c) = o; }
    LDS_WAIT(); asm volatile("" ::: "memory");
}

__device__ __forceinline__ void p0_prologue(Frame& F) {
    LAS float* scr = (LAS float*)(F.lds + F.wave * 16384);
    const int gw = F.vcu * NWAVES + F.wave, NGW = F.G * NWAVES, lane = F.lane;
    const float* c_prompt = F.in[8]; const float* c_sample = F.in[9]; const float* w_ada = F.in[10]; const float* b_ada = F.in[11];
    float* MOD = (float*)(F.ws + WS_MOD);
    for (int task = gw; task < 48 * 32; task += NGW) {
        const int cg = task % 48, ks = task / 48, col = cg * 64 + lane, k0 = ks * 32;
        float sc[40];
#pragma unroll
        for (int r = 0; r < 40; ++r) { const float* cr = (r < 8) ? (c_prompt + (size_t)r * DM) : (c_sample + (size_t)(r - 8) * DM); const float cv = cr[k0 + (lane & 31)]; sc[r] = siluf_(cv); }
        float acc[40];
#pragma unroll
        for (int r = 0; r < 40; ++r) acc[r] = 0.f;
        for (int kk = 0; kk < 32; ++kk) {
            const float w = w_ada[(size_t)(k0 + kk) * 3072 + col];
#pragma unroll
            for (int r = 0; r < 40; ++r) acc[r] = fmaf(__shfl(sc[r], kk), w, acc[r]);
        }
        const float bias = (ks == 0) ? b_ada[col] : 0.f;
#pragma unroll
        for (int r = 0; r < 40; ++r) atomicAdd(MOD + (size_t)r * 3072 + col, acc[r] + bias);
    }
    {
        constexpr int I_IN = (DM / 64) * (N_IN_PAD / 32), I_SQ = (DM / 64) * (DM / 32);
        for (int it = gw; it < I_IN + 3 * I_SQ; it += NGW) {
            int r = it;
            if (r < I_IN) { p0_transpose_item<0>(F.in[13], DM, D_IN, (bf16*)(F.ws + WS_WIN), scr, r, lane, N_IN_PAD); continue; } r -= I_IN;
            if (r < I_SQ) { p0_transpose_item<1>(F.in[23], DM, DM, (bf16*)(F.ws + WS_WPA), scr, r, lane, DM); continue; } r -= I_SQ;
            if (r < I_SQ) { p0_transpose_item<1>(F.in[24], DM, DM, (bf16*)(F.ws + WS_WPB), scr, r, lane, DM); continue; } r -= I_SQ;
            p0_transpose_item<2>(F.in[25], DM, DM, (bf16*)(F.ws + WS_WO), scr, r, lane, DM);
        }
    }
    {
        f32x2* RT128 = (f32x2*)(F.ws + WS_RT128); f32x2* RT64 = (f32x2*)(F.ws + WS_RT64);
        const int gt = gw * 64 + lane, NGT = NGW * 64;
        for (int i = gt; i < 4097 * 64; i += NGT) { const int p = i >> 6, d = i & 63; const float pos = (p == 4096) ? 16384.f : (float)p;
            const float inv = powf(10000.f, -(float)d / 64.f); const float ang = pos * inv; float s, c; sincosf(ang, &s, &c); RT128[i] = (f32x2){c, s}; }
        for (int i = gt; i < 4097 * 32; i += NGT) { const int p = i >> 5, d = i & 31; const float pos = (p == 4096) ? 16384.f : (float)p;
            const float inv = powf(10000.f, -(float)d / 32.f); const float ang = pos * inv; float s, c; sincosf(ang, &s, &c); RT64[i] = (f32x2){c, s}; }
        const float* sconv = F.in[5]; float* ocs = F.out + O_CS;
        for (int i = gt; i < NS * 2 * DM; i += NGT) { const int b = i / (2 * DM), r = (i / DM) & 1, ch = i % DM; ocs[(size_t)b * 3 * DM + r * DM + ch] = sconv[(size_t)b * 3 * DM + (r + 1) * DM + ch]; }
    }
}

__device__ __forceinline__ void p0b_norm(Frame& F) {
    const int gw = F.vcu * NWAVES + F.wave, NGW = F.G * NWAVES, lane = F.lane;
    const float* MOD = (const float*)(F.ws + WS_MOD); const float* gn = F.in[12];
    bf16* XN = (bf16*)(F.ws + WS_XN);
    for (int m = gw; m < MP + NS; m += NGW) {
        const float* xrow = (m < MP) ? (F.in[0] + (size_t)m * DM) : (F.in[1] + (size_t)(m - MP) * DM);
        const int mr = (m < MP) ? (m >> 12) : (8 + m - MP);
        const float* shift = MOD + (size_t)mr * 3072; const float* scale = shift + 1024;
        const GAS f32x4* xr = (const GAS f32x4*)xrow + lane;
        f32x4 v[4]; float s = 0.f;
#pragma unroll
        for (int j = 0; j < 4; ++j) { v[j] = xr[64 * j]; s += (v[j].x * v[j].x + v[j].y * v[j].y) + (v[j].z * v[j].z + v[j].w * v[j].w); }
        const float rstd = 1.0f / sqrtf(wave_sum(s) * (1.f / DM) + EPS);
        GAS unsigned long long* o8 = (GAS unsigned long long*)(XN + (size_t)m * DM) + lane;
#pragma unroll
        for (int j = 0; j < 4; ++j) { const int c0 = 256 * j + 4 * lane;
            const f32x4 g4 = *(const f32x4*)(gn + c0), sc4 = *(const f32x4*)(scale + c0), sh4 = *(const f32x4*)(shift + c0);
            const float y0 = v[j].x * rstd * g4.x * (1.f + sc4.x) + sh4.x, y1 = v[j].y * rstd * g4.y * (1.f + sc4.y) + sh4.y;
            const float y2 = v[j].z * rstd * g4.z * (1.f + sc4.z) + sh4.z, y3 = v[j].w * rstd * g4.w * (1.f + sc4.w) + sh4.w;
            o8[64 * j] = (unsigned long long)pk2(y0, y1) | ((unsigned long long)pk2(y2, y3) << 32); }
    }
}

struct EpiIn {
    unsigned char* ws; float* out; const float* lng; const float* lnb;
    __device__ __forceinline__ void operator()(const pg8::f32x4 (&acc)[2][2][4][2], const pg8::Unit& u, int wr, int wc, int fr, int fq) const {
        using pg8::cvt_pk_bf16;
        const int pn = u.pn; const bool samp = (u.pm == MP / 256);
        const int rbase = u.pm * 256 + wr * 64 + fr;
        if (pn < 8 || pn == 13 || (pn >= 14 && pn < 18) || pn >= 21) {
            bf16* dst; int tcol; int act;
            if (pn < 4) { dst = (bf16*)(ws + WS_XA); tcol = pn * 256; act = 0; }
            else if (pn < 8) { dst = (bf16*)(ws + WS_SGA); tcol = (pn - 4) * 256; act = 1; }
            else if (pn == 13) { dst = (bf16*)(ws + WS_VB); tcol = 0; act = 0; }
            else if (pn < 18) { dst = (bf16*)(ws + WS_SGB); tcol = (pn - 14) * 256; act = 1; }
            else if (pn < 25) { dst = (bf16*)(ws + WS_SMA); tcol = (pn - 21) * 256; act = 2; }
            else { dst = (bf16*)(ws + WS_SMB); tcol = (pn - 25) * 256; act = 2; }
            const int ld = (pn == 13) ? 256 : DM;
#pragma unroll
            for (int ai = 0; ai < 2; ++ai)
#pragma unroll
                for (int m = 0; m < 4; ++m) {
                    const int row = rbase + ai * 128 + m * 16;
#pragma unroll
                    for (int bj = 0; bj < 2; ++bj) {
                        pg8::f32x4 v0 = acc[ai][bj][m][0], v1 = acc[ai][bj][m][1];
                        const int c0 = tcol + 128 * bj + 32 * wc + 8 * fq;
                        if (pn == 13) {
                            float* o = nullptr;
                            if (!samp) o = out + O_VP + (size_t)row * 256 + c0; else if (row - MP < NS) o = out + O_VS + (size_t)(row - MP) * 256 + c0;
                            if (o) { *(pg8::f32x4*)o = v0; *(pg8::f32x4*)(o + 4) = v1; }
                        }
                        if (pn < 4) {
                            if (!samp) { const int t = row & (SEQ - 1); if (t >= SEQ - 3) { float* o = out + O_CP + (size_t)(row >> 12) * 3 * DM + (size_t)(t - (SEQ - 3)) * DM + c0; *(pg8::f32x4*)o = v0; *(pg8::f32x4*)(o + 4) = v1; } }
                            else if (row - MP < NS) { float* o = out + O_CS + (size_t)(row - MP) * 3 * DM + 2 * DM + c0; *(pg8::f32x4*)o = v0; *(pg8::f32x4*)(o + 4) = v1; }
                        }
                        if (act == 1) {
#pragma unroll
                            for (int j = 0; j < 4; ++j) { v0[j] = siluf_(v0[j]); v1[j] = siluf_(v1[j]); }
                        } else if (act == 2) {
#pragma unroll
                            for (int j = 0; j < 4; ++j) { v0[j] = sigmoidf_(v0[j]); v1[j] = sigmoidf_(v1[j]); }
                        }
                        pg8::u32x4 w; w.x = cvt_pk_bf16(v0[0], v0[1]); w.y = cvt_pk_bf16(v0[2], v0[3]); w.z = cvt_pk_bf16(v1[0], v1[1]); w.w = cvt_pk_bf16(v1[2], v1[3]);
                        *(pg8::u32x4*)(dst + (size_t)row * ld + c0) = w;
                    }
                }
        } else if (pn < 13) {
            const f32x2* RT = (const f32x2*)(ws + WS_RT128);
            const int d0 = 16 * wc + 4 * fq;
            const bool isk = (pn == 12);
            bf16* dst = isk ? (bf16*)(ws + WS_KB) : (bf16*)(ws + WS_Q); const int ld = isk ? 256 : DM; const int tcol = isk ? 0 : (pn - 8) * 256;
#pragma unroll
            for (int ai = 0; ai < 2; ++ai)
#pragma unroll
                for (int m = 0; m < 4; ++m) {
                    const int row = rbase + ai * 128 + m * 16;
                    const int p = samp ? 4096 : (row & (SEQ - 1));
                    const pg8::f32x4 cs01 = *(const pg8::f32x4*)(RT + (size_t)p * 64 + d0), cs23 = *(const pg8::f32x4*)(RT + (size_t)p * 64 + d0 + 2);
                    const float c[4] = {cs01[0], cs01[2], cs23[0], cs23[2]}, s[4] = {cs01[1], cs01[3], cs23[1], cs23[3]};
#pragma unroll
                    for (int bj = 0; bj < 2; ++bj) {
                        const pg8::f32x4 x1 = acc[ai][bj][m][0], x2 = acc[ai][bj][m][1];
                        pg8::f32x4 o1, o2;
#pragma unroll
                        for (int j = 0; j < 4; ++j) { o1[j] = x1[j] * c[j] - x2[j] * s[j]; o2[j] = x2[j] * c[j] + x1[j] * s[j]; }
                        const int c1 = tcol + 128 * bj + d0;
                        if (isk) {
                            float* o = nullptr;
                            if (!samp) o = out + O_KP + (size_t)row * 256 + c1; else if (row - MP < NS) o = out + O_KS + (size_t)(row - MP) * 256 + c1;
                            if (o) { *(pg8::f32x4*)o = o1; *(pg8::f32x4*)(o + 64) = o2; }
                        }
                        pg8::u32x2 w1, w2; w1.x = cvt_pk_bf16(o1[0], o1[1]); w1.y = cvt_pk_bf16(o1[2], o1[3]); w2.x = cvt_pk_bf16(o2[0], o2[1]); w2.y = cvt_pk_bf16(o2[2], o2[3]);
                        *(pg8::u32x2*)(dst + (size_t)row * ld + c1) = w1; *(pg8::u32x2*)(dst + (size_t)row * ld + c1 + 64) = w2;
                    }
                }
        } else if (pn < 20) {
            const f32x2* RT = (const f32x2*)(ws + WS_RT64);
            const int d0 = 16 * (wc & 1) + 4 * fq;
            bf16* dst = (bf16*)(ws + WS_QI);
#pragma unroll
            for (int ai = 0; ai < 2; ++ai)
#pragma unroll
                for (int m = 0; m < 4; ++m) {
                    const int row = rbase + ai * 128 + m * 16;
                    const int p = samp ? 4096 : (row & (SEQ - 1));
                    const pg8::f32x4 cs01 = *(const pg8::f32x4*)(RT + (size_t)p * 32 + d0), cs23 = *(const pg8::f32x4*)(RT + (size_t)p * 32 + d0 + 2);
                    const float c[4] = {cs01[0], cs01[2], cs23[0], cs23[2]}, s[4] = {cs01[1], cs01[3], cs23[1], cs23[3]};
#pragma unroll
                    for (int bj = 0; bj < 2; ++bj) {
                        const pg8::f32x4 x1 = acc[ai][bj][m][0], x2 = acc[ai][bj][m][1];
                        pg8::f32x4 o1, o2;
#pragma unroll
                        for (int j = 0; j < 4; ++j) { o1[j] = x1[j] * c[j] - x2[j] * s[j]; o2[j] = x2[j] * c[j] + x1[j] * s[j]; }
                        const int hh = (pn - 18) * 4 + 2 * bj + (wc >> 1);
                        const int c1 = hh * 64 + d0;
                        pg8::u32x2 w1, w2; w1.x = cvt_pk_bf16(o1[0], o1[1]); w1.y = cvt_pk_bf16(o1[2], o1[3]); w2.x = cvt_pk_bf16(o2[0], o2[1]); w2.y = cvt_pk_bf16(o2[2], o2[3]);
                        *(pg8::u32x2*)(dst + (size_t)row * 512 + c1) = w1; *(pg8::u32x2*)(dst + (size_t)row * 512 + c1 + 32) = w2;
                    }
                }
        } else {
            if (wc == 0) {
                const f32x2* RT = (const f32x2*)(ws + WS_RT64);
                bf16* dst = (bf16*)(ws + WS_KI);
#pragma unroll
                for (int ai = 0; ai < 2; ++ai)
#pragma unroll
                    for (int m = 0; m < 4; ++m) {
                        const int row = rbase + ai * 128 + m * 16;
                        const int p = samp ? 4096 : (row & (SEQ - 1));
                        float sum = 0.f;
#pragma unroll
                        for (int bj = 0; bj < 2; ++bj)
#pragma unroll
                            for (int n = 0; n < 2; ++n) { const pg8::f32x4 x = acc[ai][bj][m][n]; sum += (x[0] + x[1]) + (x[2] + x[3]); }
                        sum += __shfl_xor(sum, 16); sum += __shfl_xor(sum, 32);
                        const float mu = sum * (1.f / 64.f); float q = 0.f;
#pragma unroll
                        for (int bj = 0; bj < 2; ++bj)
#pragma unroll
                            for (int n = 0; n < 2; ++n) { const pg8::f32x4 d = acc[ai][bj][m][n] - mu; q += (d[0] * d[0] + d[1] * d[1]) + (d[2] * d[2] + d[3] * d[3]); }
                        q += __shfl_xor(q, 16); q += __shfl_xor(q, 32);
                        const float rstd = 1.0f / sqrtf(q * (1.f / 64.f) + EPS);
                        float* o = nullptr;
                        if (!samp) o = out + O_IKP + (size_t)row * 64; else if (row - MP < NS) o = out + O_IKS + (size_t)(row - MP) * 64;
#pragma unroll
                        for (int n = 0; n < 2; ++n) {
                            const int d0 = 16 * n + 4 * fq;
                            const pg8::f32x4 g1 = *(const pg8::f32x4*)(lng + d0), g2 = *(const pg8::f32x4*)(lng + 32 + d0), b1 = *(const pg8::f32x4*)(lnb + d0), b2 = *(const pg8::f32x4*)(lnb + 32 + d0);
                            const pg8::f32x4 cs01 = *(const pg8::f32x4*)(RT + (size_t)p * 32 + d0), cs23 = *(const pg8::f32x4*)(RT + (size_t)p * 32 + d0 + 2);
                            const float c[4] = {cs01[0], cs01[2], cs23[0], cs23[2]}, s[4] = {cs01[1], cs01[3], cs23[1], cs23[3]};
                            pg8::f32x4 o1, o2;
#pragma unroll
                            for (int j = 0; j < 4; ++j) { const float y1 = (acc[ai][0][m][n][j] - mu) * rstd * g1[j] + b1[j], y2 = (acc[ai][1][m][n][j] - mu) * rstd * g2[j] + b2[j];
                                o1[j] = y1 * c[j] - y2 * s[j]; o2[j] = y2 * c[j] + y1 * s[j]; }
                            if (o) { *(pg8::f32x4*)(o + d0) = o1; *(pg8::f32x4*)(o + 32 + d0) = o2; }
                            pg8::u32x2 w1, w2; w1.x = cvt_pk_bf16(o1[0], o1[1]); w1.y = cvt_pk_bf16(o1[2], o1[3]); w2.x = cvt_pk_bf16(o2[0], o2[1]); w2.y = cvt_pk_bf16(o2[2], o2[3]);
                            *(pg8::u32x2*)(dst + (size_t)row * 64 + d0) = w1; *(pg8::u32x2*)(dst + (size_t)row * 64 + 32 + d0) = w2;
                        }
                    }
            } else if (wc == 1 && fq < 2) {
                float* WI = (float*)(ws + WS_WI);
#pragma unroll
                for (int ai = 0; ai < 2; ++ai)
#pragma unroll
                    for (int m = 0; m < 4; ++m) { const int row = rbase + ai * 128 + m * 16; *(pg8::f32x4*)(WI + (size_t)row * 8 + 4 * fq) = acc[ai][0][m][0] * IDX_W_SCALE; }
            }
        }
    }
};


__device__ __forceinline__ float softplus_neg(float lam) { const float x = -lam; return (x > 20.f) ? x : log1pf(__expf(x)); }
__device__ __forceinline__ void gate_au(float r, float ig, float xc, float sp, float& a, float& u) {
    const float log_a = -8.0f * r * sp; a = __expf(log_a); u = sqrtf(-expm1f(2.0f * log_a)) * (ig * xc);
}
__device__ __forceinline__ void p0_build_wg(Frame& F) {
    const int gw = F.vcu * NWAVES + F.wave, NGW = F.G * NWAVES, lane = F.lane;
    const float* w_ra = F.in[16]; const float* w_rx = F.in[18]; v4u* WG = (v4u*)(F.ws + WS_WG);
    for (int task = gw; task < 4 * 16 * 16; task += NGW) {
        const int s = task & 15, cg = (task >> 4) & 15, blk = task >> 8, n = lane & 31, hi = lane >> 5;
        const float* W = (n < 16) ? w_ra : w_rx; const int col = 16 * cg + (n & 15);
        float v[8];
#pragma unroll
        for (int j = 0; j < 8; ++j) v[j] = W[((size_t)blk * 256 + 16 * s + 8 * hi + j) * 256 + col];
        v4u o; o.x = pk2(v[0], v[1]); o.y = pk2(v[2], v[3]); o.z = pk2(v[4], v[5]); o.w = pk2(v[6], v[7]);
        WG[(size_t)task * 64 + lane] = o;
    }
}
constexpr int RG_XC = 0, RG_AU = 65536, RG_CAR = RG_AU + 32768, RG_HP = RG_CAR + 4096, RG_END = RG_HP + 256;
typedef float f32x16 __attribute__((ext_vector_type(16)));
__device__ __forceinline__ void p2_rglru_prompt_unit(Frame& F, int unit) {
    const int b = unit >> 5, nblk = (unit >> 3) & 3, cs = unit & 7;
    const int tid = F.tid, lane = F.lane, w = F.wave, wm = w & 3, wn = w >> 2;
    const bf16* XA = (const bf16*)(F.ws + WS_XA); const bf16* SGA = (const bf16*)(F.ws + WS_SGA); bf16* PA = (bf16*)(F.ws + WS_PA);
    const float* w_conv = F.in[14]; const float* b_conv = F.in[15]; const float* b_ra = F.in[17]; const float* b_rx = F.in[19]; const float* lam = F.in[20];
    LAS unsigned char* lds = F.lds;
    bf16x8 Bf[16];
    { const v4u* WG = (const v4u*)(F.ws + WS_WG) + ((size_t)(nblk * 16 + 2 * cs + wn) * 16) * 64 + lane;
#pragma unroll
      for (int s = 0; s < 16; ++s) { v4u t = WG[(size_t)s * 64]; Bf[s] = *reinterpret_cast<bf16x8*>(&t); } }
    const int col = lane & 31, isI = (col >> 4) & 1, chl = 16 * wn + (col & 15), chb = 32 * cs + chl, chg = nblk * 256 + chb;
    const float gbias = isI ? b_rx[chg] : b_ra[chg]; const float sp = softplus_neg(lam[chg]);
    const int co = tid & 31, rs = tid >> 5;
    float cw[4][8], cb[8];
#pragma unroll
    for (int e = 0; e < 8; ++e) { cb[e] = b_conv[nblk * 256 + 8 * co + e];
#pragma unroll
        for (int j = 0; j < 4; ++j) cw[j][e] = w_conv[(size_t)j * DM + nblk * 256 + 8 * co + e]; }
    const int sch = tid & 31, sj = tid >> 5;
    if (tid < 32) ((LAS float*)(lds + RG_HP))[tid] = 0.f;
    const size_t rowb = (size_t)b * SEQ;
    for (int tile = 0; tile < SEQ / 128; ++tile) {
        const int t0 = tile * 128;
        {
#pragma unroll 1
            for (int half = 0; half < 2; ++half) {
                float xin[7][8];
#pragma unroll
                for (int r = 0; r < 7; ++r) { const int t = t0 + 8 * rs + 4 * half + r - 3;
                    v4u raw = (v4u){0u, 0u, 0u, 0u};
                    if (t >= 0) raw = *(const GAS v4u*)(XA + (rowb + t) * DM + nblk * 256 + 8 * co);
                    xin[r][0] = __uint_as_float(raw.x << 16); xin[r][1] = __uint_as_float(raw.x & 0xffff0000u); xin[r][2] = __uint_as_float(raw.y << 16); xin[r][3] = __uint_as_float(raw.y & 0xffff0000u);
                    xin[r][4] = __uint_as_float(raw.z << 16); xin[r][5] = __uint_as_float(raw.z & 0xffff0000u); xin[r][6] = __uint_as_float(raw.w << 16); xin[r][7] = __uint_as_float(raw.w & 0xffff0000u); }
#pragma unroll
                for (int r = 0; r < 4; ++r) { float y[8];
#pragma unroll
                    for (int e = 0; e < 8; ++e) y[e] = cb[e] + cw[0][e] * xin[r][e] + cw[1][e] * xin[r + 1][e] + cw[2][e] * xin[r + 2][e] + cw[3][e] * xin[r + 3][e];
                    const int row = 8 * rs + 4 * half + r;
                    v4u o; o.x = pk2(y[0], y[1]); o.y = pk2(y[2], y[3]); o.z = pk2(y[4], y[5]); o.w = pk2(y[6], y[7]);
                    *(LAS v4u*)(lds + RG_XC + row * 512 + ((co ^ (row & 15)) << 4)) = o; }
            }
        }
        __syncthreads();
        f32x16 acc = {};
        { const int row = 32 * wm + (lane & 31), hi = lane >> 5;
#pragma unroll
          for (int s = 0; s < 16; ++s) { const bf16x8 a = *(const LAS bf16x8*)(lds + RG_XC + row * 512 + (((2 * s + hi) ^ (row & 15)) << 4));
              acc = __builtin_amdgcn_mfma_f32_32x32x16_bf16(a, Bf[s], acc, 0, 0, 0); } }
        { const int hi = lane >> 5;
          float g[16];
#pragma unroll
          for (int i = 0; i < 16; ++i) g[i] = sigmoidf_(acc[i] + gbias);
          float rcv[8];
#pragma unroll
          for (int k = 0; k < 8; ++k) { const float snd = isI ? g[k] : g[8 + k]; rcv[k] = __shfl_xor(snd, 16); }
#pragma unroll
          for (int k = 0; k < 8; ++k) { const int i = isI ? (8 + k) : k; const float rr = isI ? rcv[k] : g[k], ii = isI ? g[8 + k] : rcv[k];
              const int tok = 32 * wm + (i & 3) + 8 * (i >> 2) + 4 * hi;
              const int cch = chb >> 3;
              const unsigned short xb = *(const LAS unsigned short*)(lds + RG_XC + tok * 512 + ((cch ^ (tok & 15)) << 4) + (chb & 7) * 2);
              float a, u; gate_au(rr, ii, bf2f(xb), sp, a, u);
              *(LAS f32x2*)(lds + RG_AU + (tok * 32 + chl) * 8) = (f32x2){a, u}; } }
        __syncthreads();
        { float av[8], uv[8];
#pragma unroll
          for (int k = 0; k < 8; ++k) { const f32x2 t = *(const LAS f32x2*)(lds + RG_AU + ((8 * sj + k) * 32 + sch) * 8); av[k] = t.x; uv[k] = t.y; }
          float A = 1.f, H = 0.f;
#pragma unroll
          for (int k = 0; k < 8; ++k) { H = av[k] * H + uv[k]; A *= av[k]; }
          *(LAS f32x2*)(lds + RG_CAR + (sj * 32 + sch) * 8) = (f32x2){A, H};
          __syncthreads();
          float h = ((const LAS float*)(lds + RG_HP))[(tile & 1) * 32 + sch];
          for (int jj = 0; jj < sj; ++jj) { const f32x2 c = *(const LAS f32x2*)(lds + RG_CAR + (jj * 32 + sch) * 8); h = c.x * h + c.y; }
          const size_t orow = rowb + t0 + 8 * sj; const int och = nblk * 256 + 32 * cs + sch;
#pragma unroll
          for (int k = 0; k < 8; ++k) { h = av[k] * h + uv[k];
              const float sg = bf2f(SGA[(orow + k) * DM + och]);
              PA[(orow + k) * DM + och] = (bf16)f2bf(h * sg); }
          if (sj == 15) { ((LAS float*)(lds + RG_HP))[((tile + 1) & 1) * 32 + sch] = h;
              if (tile == SEQ / 128 - 1) F.out[O_LP + (size_t)b * DM + och] = h; }
        }
    }
    __syncthreads();
}
__device__ __forceinline__ void p2_rglru_sample_unit(Frame& F, int b) {
    const int tid = F.tid;
    const float* sconv = F.in[5] + (size_t)b * 3 * DM; const float* h0 = F.in[6] + (size_t)b * DM;
    const float* w_conv = F.in[14]; const float* b_conv = F.in[15]; const float* w_ra = F.in[16]; const float* b_ra = F.in[17]; const float* w_rx = F.in[18]; const float* b_rx = F.in[19]; const float* lam = F.in[20];
    const float* xa = F.out + O_CS + (size_t)b * 3 * DM + 2 * DM;
    const bf16* SGA = (const bf16*)(F.ws + WS_SGA); bf16* PA = (bf16*)(F.ws + WS_PA);
    LAS float* xc = (LAS float*)F.lds;
    __syncthreads();
    for (int ch = tid; ch < DM; ch += NTHR)
        xc[ch] = b_conv[ch] + w_conv[ch] * sconv[ch] + w_conv[DM + ch] * sconv[DM + ch] + w_conv[2 * DM + ch] * sconv[2 * DM + ch] + w_conv[3 * DM + ch] * xa[ch];
    __syncthreads();
    for (int ch = tid; ch < DM; ch += NTHR) {
        const int blk = ch >> 8, chb = ch & 255;
        float ar = b_ra[ch], ai = b_rx[ch];
        const float* wr = w_ra + (size_t)blk * 65536 + chb; const float* wx = w_rx + (size_t)blk * 65536 + chb;
        for (int k = 0; k < 256; ++k) { const float x = xc[blk * 256 + k]; ar = fmaf(x, wr[(size_t)k * 256], ar); ai = fmaf(x, wx[(size_t)k * 256], ai); }
        float a, u; gate_au(sigmoidf_(ar), sigmoidf_(ai), xc[ch], softplus_neg(lam[ch]), a, u);
        const float h = a * h0[ch] + u;
        F.out[O_LS + (size_t)b * DM + ch] = h;
        PA[(size_t)(MP + b) * DM + ch] = (bf16)f2bf(h * bf2f(SGA[(size_t)(MP + b) * DM + ch]));
    }
    __syncthreads();
}
__device__ __forceinline__ void p2_rglru(Frame& F) {
    for (int u = F.vcu; u < NBATCH * 32; u += F.G) p2_rglru_prompt_unit(F, u);
    for (int b = F.G - 1 - F.vcu; b < NS; b += F.G) p2_rglru_sample_unit(F, b);
}


constexpr int IX_SC = 0, IX_BITS = 131072, IX_END = IX_BITS + 16384;
constexpr int TOPK = 256;
__device__ __forceinline__ float next_up(float x) { unsigned u = __float_as_uint(x); if (x == 0.f) return __uint_as_float(1u); u = (x > 0.f) ? u + 1u : u - 1u; return __uint_as_float(u); }
__device__ __forceinline__ float wave_min_f(float v) {
#pragma unroll
    for (int o = 1; o < 64; o <<= 1) v = fminf(v, __shfl_xor(v, o));
    return v; }
__device__ __forceinline__ float wave_max_f(float v) {
#pragma unroll
    for (int o = 1; o < 64; o <<= 1) v = fmaxf(v, __shfl_xor(v, o));
    return v; }
__device__ __forceinline__ void p3a_prompt_unit(Frame& F, int b, int qblk) {
    const int lane = F.lane, w = F.wave, tid = F.tid;
    LAS unsigned char* lds = F.lds;
    const bf16* QI = (const bf16*)(F.ws + WS_QI); const bf16* KI = (const bf16*)(F.ws + WS_KI); const float* WI = (const float*)(F.ws + WS_WI);
    const size_t rowb = (size_t)b * SEQ;
    const int nkt = qblk + 1;
    const float NEG = -__builtin_inff();
#pragma unroll 1
    for (int s = 0; s < 4; ++s) {
        const int qq0 = qblk * 32 + 8 * s;
        const bool need_sel = (qq0 + 7 >= TOPK);
        if (need_sel) {
            const int rho = lane & 31, hi = lane >> 5;
            const int ql = 2 * (rho >> 4) + ((rho >> 2) & 1), head = 4 * ((rho >> 3) & 1) + (rho & 3);
            bf16x8 qa[2][4];
#pragma unroll
            for (int mt = 0; mt < 2; ++mt)
#pragma unroll
                for (int s4 = 0; s4 < 4; ++s4) { v4u t = *(const GAS v4u*)(QI + (rowb + qq0 + 4 * mt + ql) * 512 + head * 64 + 16 * s4 + 8 * hi); qa[mt][s4] = *reinterpret_cast<bf16x8*>(&t); }
            float wq[2][2][8];
#pragma unroll
            for (int mt = 0; mt < 2; ++mt)
#pragma unroll
                for (int g = 0; g < 2; ++g) { const float* wp = WI + (rowb + qq0 + 4 * mt + 2 * g + hi) * 8; const f32x4 a = *(const f32x4*)wp, c = *(const f32x4*)(wp + 4);
                    wq[mt][g][0] = a.x; wq[mt][g][1] = a.y; wq[mt][g][2] = a.z; wq[mt][g][3] = a.w; wq[mt][g][4] = c.x; wq[mt][g][5] = c.y; wq[mt][g][6] = c.z; wq[mt][g][7] = c.w; }
#pragma unroll 1
            for (int kt = w; kt < nkt; kt += NWAVES) {
                const int key = kt * 32 + (lane & 31);
                bf16x8 kb[4];
#pragma unroll
                for (int s4 = 0; s4 < 4; ++s4) { v4u t = *(const GAS v4u*)(KI + (rowb + key) * 64 + 16 * s4 + 8 * hi); kb[s4] = *reinterpret_cast<bf16x8*>(&t); }
#pragma unroll
                for (int mt = 0; mt < 2; ++mt) {
                    f32x16 acc = {};
#pragma unroll
                    for (int s4 = 0; s4 < 4; ++s4) acc = __builtin_amdgcn_mfma_f32_32x32x16_bf16(qa[mt][s4], kb[s4], acc, 0, 0, 0);
#pragma unroll
                    for (int g = 0; g < 2; ++g) { float sc = 0.f;
#pragma unroll
                        for (int h = 0; h < 8; ++h) sc = fmaf(wq[mt][g][h], fmaxf(acc[8 * g + h], 0.f), sc);
                        const int qloc = 4 * mt + 2 * g + hi;
                        if (key > qq0 + qloc) sc = NEG;
                        *(LAS float*)(lds + IX_SC + (qloc * 4096 + key) * 4) = sc; }
                }
            }
        }
        __syncthreads();
        {
            const int t = qq0 + w;
            unsigned long long mine = 0ull;
            if (t + 1 <= TOPK) {
#pragma unroll
                for (int r = 0; r < 64; ++r) { const unsigned long long bl = __ballot(lane <= t - 64 * r); mine = (lane == r) ? bl : mine; }
            } else {
                float v[64];
                const LAS float* scb = (const LAS float*)(lds + IX_SC) + w * 4096 + lane;
#pragma unroll
                for (int r = 0; r < 64; ++r) { const float x = scb[64 * r]; v[r] = (lane <= t - 64 * r) ? x : NEG; }
                float mn = __builtin_inff(), mx = NEG;
#pragma unroll
                for (int r = 0; r < 64; ++r) { mx = fmaxf(mx, v[r]); mn = fminf(mn, (v[r] == NEG) ? __builtin_inff() : v[r]); }
                float lo = wave_min_f(mn), hi = next_up(wave_max_f(mx));
                int cnt_hi = 0; float T = hi, E = lo; int need = 0;
                for (int it = 0; it < 400; ++it) {
                    const float mid = 0.5f * lo + 0.5f * hi;
                    if (!(mid > lo && mid < hi)) { T = hi; E = lo; need = TOPK - cnt_hi; break; }
                    int c = 0;
#pragma unroll
                    for (int r = 0; r < 64; ++r) c += __popcll(__ballot(v[r] >= mid));
                    if (c == TOPK) { T = mid; need = 0; break; }
                    if (c > TOPK) lo = mid; else { hi = mid; cnt_hi = c; }
                }
#pragma unroll 1
                for (int r = 0; r < 64; ++r) {
                    const float xv = scb[64 * r]; const float vr = (lane <= t - 64 * r) ? xv : NEG;
                    unsigned long long bl = __ballot(vr >= T);
                    if (need > 0) { const unsigned long long eq = __ballot(vr == E); const int ce = __popcll(eq);
                        if (ce > 0) { const int pre = __builtin_amdgcn_mbcnt_hi((unsigned)(eq >> 32), __builtin_amdgcn_mbcnt_lo((unsigned)eq, 0u));
                            bl |= __ballot(vr == E && pre < need); need = (ce >= need) ? 0 : need - ce; } }
                    mine = (lane == r) ? bl : mine;
                }
            }
            *(LAS unsigned long long*)(lds + IX_BITS + ((8 * s + w) * 64 + lane) * 8) = mine;
        }
        __syncthreads();
    }
    {
        unsigned long long* MSK = (unsigned long long*)(F.ws + WS_MSK) + ((size_t)(b * 128 + qblk) * 64) * 32;
        const int ntile = 4 * (qblk >> 3) + 4;
        const int r32 = lane & 31, hi = lane >> 5;
        for (int j = w; j < ntile; j += NWAVES) {
            const unsigned long long wd = *(const LAS unsigned long long*)(lds + IX_BITS + (r32 * 64 + j) * 8) >> (4 * hi);
            unsigned long long mine = 0ull;
#pragma unroll
            for (int p = 0; p < 2; ++p)
#pragma unroll
                for (int r = 0; r < 16; ++r) { const int bit = 32 * p + (r & 3) + 8 * (r >> 2); const unsigned long long m = __ballot((wd >> bit) & 1ull); mine = (lane == p * 16 + r) ? m : mine; }
            if (lane < 32) MSK[(size_t)j * 32 + lane] = mine;
        }
    }
    __syncthreads();
}
__device__ __forceinline__ void p3a_sample_unit(Frame& F, const int* page_table, int b, int chunk) {
    const int tid = F.tid;
    LAS float* qs = (LAS float*)F.lds;
    const bf16* QI = (const bf16*)(F.ws + WS_QI); const float* WI = (const float*)(F.ws + WS_WI); const float* cidx = F.in[4];
    float* SSC = (float*)(F.ws + WS_SSC);
    __syncthreads();
    qs[tid] = bf2f(QI[(size_t)(MP + b) * 512 + tid]);
    __syncthreads();
    if (tid < 8) qs[512 + tid] = WI[(size_t)(MP + b) * 8 + tid];
    __syncthreads();
#pragma unroll 1
    for (int e = 0; e < 2; ++e) {
        const int key = chunk * 1024 + e * 512 + tid;
        const int phys = page_table[b * NPG + (key >> 7)];
        const f32x4* kr = (const f32x4*)(cidx + ((size_t)phys * PAGE + (key & 127)) * 64);
        f32x4 kv[16];
#pragma unroll
        for (int d4 = 0; d4 < 16; ++d4) kv[d4] = kr[d4];
        float sc = 0.f;
#pragma unroll 1
        for (int h = 0; h < 8; ++h) { float sh = 0.f;
#pragma unroll
            for (int d4 = 0; d4 < 16; ++d4) { const f32x4 q4 = *(const LAS f32x4*)(qs + h * 64 + 4 * d4); sh = fmaf(q4.x, kv[d4].x, fmaf(q4.y, kv[d4].y, fmaf(q4.z, kv[d4].z, fmaf(q4.w, kv[d4].w, sh)))); }
            sc = fmaf(qs[512 + h], fmaxf(sh, 0.f), sc); asm volatile("" ::: "memory"); }
        SSC[(size_t)b * 16400 + key] = sc;
    }
    __syncthreads();
}
__device__ __forceinline__ void p3a_indexer(Frame& F, const int* page_table) {
    for (int i = F.vcu; i < 1024; i += F.G) { const int slot = i >> 8, v = i & 255, b = v & 7, j = v >> 3;
        const int qblk = (slot == 0) ? j : (slot == 1) ? 63 - j : (slot == 2) ? 64 + j : 127 - j;
        p3a_prompt_unit(F, b, qblk); }
    for (int u = F.vcu; u < NS * 16; u += F.G) p3a_sample_unit(F, page_table, u >> 4, u & 15);
}


namespace att {
constexpr float SCALE = 0.08838834764831845f;
constexpr int NW = 8, QBLK = 32, KVBLK = 64, QB = NW * QBLK, D = 128;
constexpr int SHM_V = KVBLK * D * 2, SHM_K = KVBLK * D * 2;
constexpr int LDS_ATT = 2 * SHM_V + 2 * SHM_K + NW * 64 * 4;
constexpr float THR = 8.f;
constexpr int QS = 1024, KS = 256, OS = 1024;
typedef short s16x4 __attribute__((ext_vector_type(4)));
typedef unsigned u32x4 __attribute__((ext_vector_type(4)));
#define KSWZ(row, colB) ((row) * 256 + ((colB) ^ (((row) & 7) << 4)))
#define SBAR() __builtin_amdgcn_sched_barrier(0)
__device__ __forceinline__ int v_st(int k, int c) { const int kk = (k & ~0xC) | ((k & 4) << 1) | ((k & 8) >> 1); return ((kk >> 3) * 4 + (c >> 5)) * 512 + ((kk & 7) * 32 + (c & 31)) * 2; }
__device__ __forceinline__ int v_rd_base(int lane) { return ((lane & 3) << 3) | (((lane >> 2) & 3) << 6) | (((lane >> 4) & 1) << 5) | (((lane >> 5) & 1) << 8); }
constexpr int v_rd_off(int d0, int ks, int half) { return d0 * 512 + ks * 4096 + half * 2048; }
__device__ __forceinline__ int crow(int r, int hi) { return (r & 3) + 8 * (r >> 2) + 4 * hi; }
__device__ __forceinline__ unsigned cvtpk(float lo, float hi) { unsigned r; asm volatile("v_cvt_pk_bf16_f32 %0, %1, %2" : "=v"(r) : "v"(lo), "v"(hi)); return r; }
__device__ __forceinline__ bf16x8 load8(const bf16* p) { return *reinterpret_cast<const bf16x8*>(p); }
typedef __attribute__((address_space(4))) const unsigned long long* cmask_ptr;
__device__ __forceinline__ void mask_tile_bits(f32x16& p0, f32x16& p1, const unsigned long long* mwg) {
    const float NEG = -__builtin_inff();
    const unsigned long long pm = (unsigned long long)(uintptr_t)mwg;
    const unsigned plo = __builtin_amdgcn_readfirstlane((unsigned)pm), phi = __builtin_amdgcn_readfirstlane((unsigned)(pm >> 32));
    cmask_ptr mw = (cmask_ptr)(((unsigned long long)phi << 32) | plo);
#pragma unroll
    for (int r = 0; r < 16; ++r) {
        const unsigned long long m0 = mw[r], m1 = mw[16 + r];
        float a = p0[r], b = p1[r];
        asm volatile("v_cndmask_b32_e64 %0, %1, %0, %2" : "+v"(a) : "v"(NEG), "s"(m0));
        asm volatile("v_cndmask_b32_e64 %0, %1, %0, %2" : "+v"(b) : "v"(NEG), "s"(m1));
        p0[r] = a; p1[r] = b;
    }
}
__device__ __forceinline__ void partialSM(f32x16& p0, f32x16& p1, float& m_reg, float& mn, float& alpha) {
    float pmax = p0[0]; for (int r = 1; r < 16; ++r) pmax = fmaxf(pmax, p0[r]); for (int r = 0; r < 16; ++r) pmax = fmaxf(pmax, p1[r]);
    { auto rr = __builtin_amdgcn_permlane32_swap(__float_as_uint(pmax), __float_as_uint(pmax), false, false);
      pmax = fmaxf(__uint_as_float(rr[0]), __uint_as_float(rr[1])); }
    constexpr float C2 = 1.4426950408889634f * SCALE;
    if (__builtin_expect(__all((pmax - m_reg) * SCALE <= THR), 1)) { mn = m_reg; alpha = 1.f; }
    else { mn = fmaxf(m_reg, pmax); alpha = __builtin_amdgcn_exp2f((m_reg - mn) * C2); m_reg = mn; }
    const float mnL = -mn * C2;
    for (int r = 0; r < 16; ++r) p0[r] = fmaf(p0[r], C2, mnL); for (int r = 0; r < 16; ++r) p1[r] = fmaf(p1[r], C2, mnL);
    for (int r = 0; r < 16; ++r) p0[r] = __builtin_amdgcn_exp2f(p0[r]);
}
__device__ __forceinline__ void finishSM(f32x16& p0, f32x16& p1, float alpha, float& l_reg, bf16x8& pa0, bf16x8& pa1, bf16x8& pa2, bf16x8& pa3) {
    for (int r = 0; r < 16; ++r) p1[r] = __builtin_amdgcn_exp2f(p1[r]);
    float ps = 0; for (int r = 0; r < 16; ++r) ps += p0[r]; for (int r = 0; r < 16; ++r) ps += p1[r];
    { auto rr = __builtin_amdgcn_permlane32_swap(__float_as_uint(ps), __float_as_uint(ps), false, false);
      ps = __uint_as_float(rr[0]) + __uint_as_float(rr[1]); }
    l_reg = l_reg * alpha + ps;
#define PK4(P, B_, OUT) do { unsigned a0 = cvtpk(P[B_+0], P[B_+1]), a1 = cvtpk(P[B_+2], P[B_+3]);                          \
        unsigned b0 = cvtpk(P[B_+4], P[B_+5]), b1 = cvtpk(P[B_+6], P[B_+7]);                                             \
        auto r0 = __builtin_amdgcn_permlane32_swap(a0, b0, false, false); auto r1 = __builtin_amdgcn_permlane32_swap(a1, b1, false, false); \
        u32x4 w = {r0[0], r1[0], r0[1], r1[1]}; OUT = *reinterpret_cast<bf16x8*>(&w); } while (0)
    PK4(p0, 0, pa0); PK4(p0, 8, pa1); PK4(p1, 0, pa2); PK4(p1, 8, pa3);
#undef PK4
}
template <int KB>
__device__ __forceinline__ void qkt(f32x16& p0, f32x16& p1, const char* K_lds, int r32, int hi, const bf16x8* qr) {
    p0 = f32x16{}; p1 = f32x16{};
    const char* kb[4];
#pragma unroll
    for (int dd = 0; dd < 4; ++dd) kb[dd] = K_lds + KB * SHM_K + KSWZ(r32, (dd * 16 + hi * 8) * 2);
#pragma unroll
    for (int d0 = 0; d0 < 8; ++d0) { const char* a = kb[d0 & 3] + (d0 >> 2) * 128;
        bf16x8 b0 = *reinterpret_cast<const bf16x8*>(a);
        bf16x8 b1 = *reinterpret_cast<const bf16x8*>(a + 32 * 256);
        p0 = __builtin_amdgcn_mfma_f32_32x32x16_bf16(b0, qr[d0], p0, 0, 0, 0);
        p1 = __builtin_amdgcn_mfma_f32_32x32x16_bf16(b1, qr[d0], p1, 0, 0, 0); }
}
template <int VB>
__device__ __forceinline__ void pv_tile(f32x16* o, int vb0, bf16x8 pa0, bf16x8 pa1, bf16x8 pa2, bf16x8 pa3) {
#define TRRD(dst, off) asm volatile("ds_read_b64_tr_b16 %0, %1 offset:%2" : "=&v"(dst) : "v"(vb0), "i"(off) : "memory")
#define PV_D0(d0) do { s16x4 l0, l1, l2, l3, h0, h1, h2, h3; constexpr int b_ = VB * SHM_V + v_rd_off(d0, 0, 0); \
        TRRD(l0, b_); TRRD(h0, b_ + 2048); TRRD(l1, b_ + 4096); TRRD(h1, b_ + 6144); TRRD(l2, b_ + 8192); TRRD(h2, b_ + 10240); TRRD(l3, b_ + 12288); TRRD(h3, b_ + 14336); \
        asm volatile("s_waitcnt lgkmcnt(0)" ::: "memory"); SBAR();   \
        o[d0] = __builtin_amdgcn_mfma_f32_32x32x16_bf16(pa0, (bf16x8){l0[0], l0[1], l0[2], l0[3], h0[0], h0[1], h0[2], h0[3]}, o[d0], 0, 0, 0);   \
        o[d0] = __builtin_amdgcn_mfma_f32_32x32x16_bf16(pa1, (bf16x8){l1[0], l1[1], l1[2], l1[3], h1[0], h1[1], h1[2], h1[3]}, o[d0], 0, 0, 0);   \
        o[d0] = __builtin_amdgcn_mfma_f32_32x32x16_bf16(pa2, (bf16x8){l2[0], l2[1], l2[2], l2[3], h2[0], h2[1], h2[2], h2[3]}, o[d0], 0, 0, 0);   \
        o[d0] = __builtin_amdgcn_mfma_f32_32x32x16_bf16(pa3, (bf16x8){l3[0], l3[1], l3[2], l3[3], h3[0], h3[1], h3[2], h3[3]}, o[d0], 0, 0, 0); } while (0)
    PV_D0(0); PV_D0(1); PV_D0(2); PV_D0(3);
#undef PV_D0
#undef TRRD
}
struct BlockRef { const bf16* Q; const bf16* K; const bf16* V; bf16* O; const bf16* G; const unsigned long long* M; int P0; };
struct Seam { bf16x8 qr[8]; bf16x8 st_v0, st_v1, st_k0, st_k1; };
#define ROWK(p, k0, rr) ((p) + (size_t)((k0) + (rr)) * KS + sc)
#define VMW() asm volatile("s_waitcnt vmcnt(0)" ::: "memory")
#define VMWN(n) asm volatile("s_waitcnt vmcnt(%0)" :: "i"(n) : "memory")
#define SLOAD_H(Kp, Vp, k0) do { S.st_v0 = load8(ROWK(Vp, k0, sr)); S.st_v1 = load8(ROWK(Vp, k0, 32 + sr));              \
                         S.st_k0 = load8(ROWK(Kp, k0, sr)); S.st_k1 = load8(ROWK(Kp, k0, 32 + sr)); } while (0)
#define SWRITE_HK(bf) do { *(bf16x8*)(K_lds + (bf) * SHM_K + kws) = S.st_k0; *(bf16x8*)(K_lds + (bf) * SHM_K + kws + 32 * 256) = S.st_k1; } while (0)
#define SWRITE_HV(bf) do { *(bf16x8*)(V_lds + (bf) * SHM_V + vst0) = S.st_v0; *(bf16x8*)(V_lds + (bf) * SHM_V + vst1) = S.st_v1; } while (0)
#define SWRITE_H(bf) do { SWRITE_HV(bf); SWRITE_HK(bf); } while (0)
__device__ __forceinline__ void attn_prime(const BlockRef& cur, char* lds, Seam& S) {
    const int tid = threadIdx.x, wid = __builtin_amdgcn_readfirstlane(tid >> 6), lane = tid & 63, r32 = lane & 31, hi = lane >> 5;
    const int sr = tid >> 4, sc = (tid & 15) * 8, kws = KSWZ(sr, sc * 2); char* K_lds = lds + 2 * SHM_V;
    for (int d0 = 0; d0 < 8; ++d0) S.qr[d0] = load8(cur.Q + (size_t)(wid * QBLK + r32) * QS + d0 * 16 + hi * 8);
    SLOAD_H(cur.K, cur.V, 0); VMW(); SWRITE_HK(0);
    __syncthreads();
}
__device__ __forceinline__ void attn_block(const BlockRef& cur, const BlockRef& nxt, char* lds, Seam& S) {
    const int tid = threadIdx.x, wid = __builtin_amdgcn_readfirstlane(tid >> 6), lane = tid & 63, r32 = lane & 31, hi = lane >> 5;
    const int NT = (cur.P0 + QB - 1) / KVBLK + 1;
    char* V_lds = lds; char* K_lds = lds + 2 * SHM_V;
    float* wsl = (float*)(lds + 2 * SHM_V + 2 * SHM_K) + wid * 64; float* li_l = wsl, * al_l = wsl + 32;
    float m_reg = -1e30f, l_reg = 0; f32x16 o[4] = {};
    const int sr = tid >> 4, sc = (tid & 15) * 8, vst0 = v_st(sr, sc), vst1 = v_st(32 + sr, sc), kws = KSWZ(sr, sc * 2);
    const int vb0 = (int)(uintptr_t)V_lds + v_rd_base(lane);
    const bf16* Kh = cur.K; const bf16* Vh = cur.V;
    const unsigned long long* Mw = cur.M + (size_t)wid * 64 * 32;
#define RESC(a) do { if (__any((a) < 1.f)) { if (hi == 0) al_l[r32] = (a); asm volatile("s_waitcnt lgkmcnt(0)" ::: "memory");              \
                     for (int d_ = 0; d_ < 4; ++d_) for (int r = 0; r < 16; ++r) o[d_][r] *= al_l[crow(r, hi)]; } } while (0)
#define KBASE(t) ((t) * KVBLK)
#define MASKT(P0_, P1_, t) mask_tile_bits(P0_, P1_, Mw + (size_t)(t) * 32)
    constexpr int NQL = 8;
#define SEAM_K0() do { VMWN(NQL); SWRITE_HK(0); SBAR(); } while (0)
    f32x16 pA0, pA1, pB0, pB1; float mnA, mnB, alA, alB; bf16x8 pa0, pa1, pa2, pa3;
    SWRITE_HV(0); SBAR();
    if (NT > 1) { SLOAD_H(Kh, Vh, KBASE(1)); }
    SBAR(); qkt<0>(pA0, pA1, K_lds, r32, hi, S.qr);
    MASKT(pA0, pA1, 0); partialSM(pA0, pA1, m_reg, mnA, alA);
    if (NT > 1) { VMW(); SWRITE_H(1); }
    __syncthreads();
#define HALF_STEP(PX0, PX1, mnX, alX, PY0, PY1, alY, t, KB, VB, SB) do {                                                      \
        SBAR(); qkt<KB>(PX0, PX1, K_lds, r32, hi, S.qr);                                             \
        finishSM(PY0, PY1, alY, l_reg, pa0, pa1, pa2, pa3); SBAR();                                                           \
        if ((t) + 1 < NT) { SLOAD_H(Kh, Vh, KBASE((t) + 1)); SBAR(); }                                               \
        pv_tile<VB>(o, vb0, pa0, pa1, pa2, pa3); MASKT(PX0, PX1, (t)); partialSM(PX0, PX1, m_reg, mnX, alX);                                        \
        __syncthreads();                                                                                                      \
        if ((t) + 1 < NT) { VMW(); SWRITE_H(SB); }                                                                          \
        RESC(alX); __syncthreads(); } while (0)
    for (int t = 1; t + 1 < NT; t += 2) {
        HALF_STEP(pB0, pB1, mnB, alB, pA0, pA1, alA, t, 1, 0, 0);
        HALF_STEP(pA0, pA1, mnA, alA, pB0, pB1, alB, t + 1, 0, 1, 1);
    }
    const bool even = (NT & 1) == 0;
    if (even) { SBAR(); qkt<1>(pB0, pB1, K_lds, r32, hi, S.qr); SBAR(); }
    SLOAD_H(nxt.K, nxt.V, 0); SBAR();
#pragma unroll
    for (int d0 = 0; d0 < 8; ++d0) S.qr[d0] = load8(nxt.Q + (size_t)(wid * QBLK + r32) * QS + d0 * 16 + hi * 8);
    SBAR();
    finishSM(pA0, pA1, alA, l_reg, pa0, pa1, pa2, pa3); SBAR();
    pv_tile<0>(o, vb0, pa0, pa1, pa2, pa3);
    if (even) { MASKT(pB0, pB1, NT - 1); partialSM(pB0, pB1, m_reg, mnB, alB); __syncthreads(); RESC(alB);
        finishSM(pB0, pB1, alB, l_reg, pa0, pa1, pa2, pa3); SBAR(); pv_tile<1>(o, vb0, pa0, pa1, pa2, pa3); }
    SBAR(); SEAM_K0();
    if (hi == 0) li_l[r32] = l_reg; asm volatile("s_waitcnt lgkmcnt(0)" ::: "memory");
    float rli[16];
#pragma unroll
    for (int r = 0; r < 16; ++r) rli[r] = __builtin_amdgcn_rcpf(li_l[crow(r, hi)]);
    bf16* Ow = cur.O + (size_t)(wid * QBLK) * OS; const bf16* Gw = cur.G + (size_t)(wid * QBLK) * OS;
#pragma unroll
    for (int r = 0; r < 16; ++r) { const int orow = crow(r, hi);
#pragma unroll
        for (int d0 = 0; d0 < 4; ++d0) { const float gv = bf2f(Gw[(size_t)orow * OS + d0 * 32 + r32]);
            const float v = o[d0][r] * rli[r] * gv;
            const float vn = __shfl_xor(v, 1);
            if ((r32 & 1) == 0) *(unsigned*)(Ow + (size_t)orow * OS + d0 * 32 + r32) = cvtpk(v, vn); } }
    __syncthreads();
#undef RESC
#undef KBASE
#undef MASKT
#undef SEAM_K0
#undef HALF_STEP
}
#undef ROWK
#undef VMW
#undef VMWN
#undef SLOAD_H
#undef SWRITE_HK
#undef SWRITE_HV
#undef SWRITE_H
#undef KSWZ
#undef SBAR
}

__device__ __forceinline__ att::BlockRef att_ref(Frame& F, int L, int pass) {
    const int b = L & 7, k = L >> 3, h = k >> 3, x = k & 7, qb = pass ? 15 - x : x;
    const size_t row0 = (size_t)b * SEQ + (size_t)qb * 256;
    att::BlockRef r;
    r.Q = (const bf16*)(F.ws + WS_Q) + row0 * DM + h * 128; r.O = (bf16*)(F.ws + WS_PB) + row0 * DM + h * 128; r.G = (const bf16*)(F.ws + WS_SGB) + row0 * DM + h * 128;
    r.K = (const bf16*)(F.ws + WS_KB) + (size_t)b * SEQ * 256 + (h >> 2) * 128; r.V = (const bf16*)(F.ws + WS_VB) + (size_t)b * SEQ * 256 + (h >> 2) * 128;
    r.M = (const unsigned long long*)(F.ws + WS_MSK) + ((size_t)(b * 128 + qb * 8) * 64) * 32; r.P0 = qb * 256;
    return r;
}
__device__ __forceinline__ void p3b_attention(Frame& F) {
    const int total = 512, stride = F.G;
    int L = blockIdx.x; if (L >= total) return;
    int pass = 0;
    att::BlockRef cur = att_ref(F, L, 0);
    att::Seam S;
    att::attn_prime(cur, (char*)F.lds, S);
    for (;;) {
        const bool more_pass = (pass == 0), more_item = L + stride < total, last = !more_pass && !more_item;
        int passn = pass + 1, Ln = L;
        if (!more_pass) { passn = 0; Ln = more_item ? L + stride : L; }
        const att::BlockRef nxt = last ? cur : att_ref(F, Ln, passn);
        att::attn_block(cur, nxt, (char*)F.lds, S);
        if (last) break;
        cur = nxt; pass = passn; L = Ln;
    }
}


constexpr int SM_Q = 0, SM_SEL = 4096, SM_CNT = SM_SEL + 1024, SM_S = 8192, SM_RED = SM_S + 8192, SM_END = SM_RED + 256;
__device__ __forceinline__ int block_sum_i(LAS int* red, int v, int wave, int lane, int& phase) {
    LAS int* slot = red + (phase & 1) * 8; phase ^= 1;
    if (lane == 0) slot[wave] = v;
    __syncthreads();
    int s = 0;
#pragma unroll
    for (int i = 0; i < 8; ++i) s += slot[i];
    return s;
}
__device__ __forceinline__ void p3b_sample_unit(Frame& F, const int* page_table, int b) {
    const int tid = F.tid, lane = F.lane, w = F.wave;
    LAS unsigned char* lds = F.lds;
    LAS float* qf = (LAS float*)(lds + SM_Q);
    LAS int* sel = (LAS int*)(lds + SM_SEL);
    LAS int* cntw = (LAS int*)(lds + SM_CNT);
    LAS float* Sb = (LAS float*)(lds + SM_S);
    LAS int* red = (LAS int*)(lds + SM_RED);
    const float NEG = -__builtin_inff();
    const bf16* Qb = (const bf16*)(F.ws + WS_Q) + (size_t)(MP + b) * DM; const bf16* QI = (const bf16*)(F.ws + WS_QI) + (size_t)(MP + b) * 512;
    const float* WI = (const float*)(F.ws + WS_WI) + (size_t)(MP + b) * 8; const float* SSC = (const float*)(F.ws + WS_SSC) + (size_t)b * 16400;
    const float* kself = F.out + O_KS + (size_t)b * 256; const float* vself = F.out + O_VS + (size_t)b * 256; const float* kiself = F.out + O_IKS + (size_t)b * 64;
    const float* cache_k = F.in[2]; const float* cache_v = F.in[3];
    __syncthreads();
    for (int i = tid; i < 1024; i += NTHR) qf[i] = bf2f(Qb[i]);
    if (tid == 0) cntw[0] = 0;
    float self_sc = 0.f;
    { float part = 0.f;
        const int h = lane >> 3, d0 = 8 * (lane & 7); float sh = 0.f;
#pragma unroll
        for (int d = 0; d < 8; ++d) sh = fmaf(bf2f(QI[h * 64 + d0 + d]), kiself[d0 + d], sh);
        sh += __shfl_xor(sh, 1); sh += __shfl_xor(sh, 2); sh += __shfl_xor(sh, 4);
        part = ((lane & 7) == 0) ? WI[h] * fmaxf(sh, 0.f) : 0.f;
        self_sc = wave_sum(part); }
    float v[33];
#pragma unroll
    for (int r = 0; r < 32; ++r) v[r] = SSC[512 * r + tid];
    v[32] = (tid == 0) ? self_sc : NEG;
    int phase = 0;
    float mn = __builtin_inff(), mx = NEG;
#pragma unroll
    for (int r = 0; r < 33; ++r) { mx = fmaxf(mx, v[r]); mn = fminf(mn, (v[r] == NEG) ? __builtin_inff() : v[r]); }
    mn = wave_min_f(mn); mx = wave_max_f(mx);
    { LAS float* fr = (LAS float*)(red + 16);
      if (lane == 0) { fr[w] = mn; fr[8 + w] = mx; }
      __syncthreads();
      mn = fr[0]; mx = fr[8];
#pragma unroll
      for (int i = 1; i < 8; ++i) { mn = fminf(mn, fr[i]); mx = fmaxf(mx, fr[8 + i]); } }
    float lo = mn, hi = next_up(mx); int cnt_hi = 0; float T = hi, E = lo; int need = 0;
    for (int it = 0; it < 400; ++it) {
        const float mid = 0.5f * lo + 0.5f * hi;
        if (!(mid > lo && mid < hi)) { T = hi; E = lo; need = TOPK - cnt_hi; break; }
        int c = 0;
#pragma unroll
        for (int r = 0; r < 33; ++r) c += __popcll(__ballot(v[r] >= mid));
        c = block_sum_i(red, c, w, lane, phase);
        if (c == TOPK) { T = mid; need = 0; break; }
        if (c > TOPK) lo = mid; else { hi = mid; cnt_hi = c; }
    }
    int X = 0;
    if (need > 0) {
        int xl = 0, xh = PAST + 1;
        for (int it = 0; it < 20; ++it) {
            if (xh - xl <= 1) break;
            const int xm = (xl + xh) >> 1; int c = 0;
#pragma unroll
            for (int r = 0; r < 33; ++r) c += __popcll(__ballot(v[r] == E && (512 * r + tid) < xm));
            c = block_sum_i(red, c, w, lane, phase);
            if (c >= need) xh = xm; else xl = xm;
        }
        X = xh;
    }
#pragma unroll
    for (int r = 0; r < 33; ++r) { const int key = 512 * r + tid;
        if (v[r] >= T || (need > 0 && v[r] == E && key < X)) { const int p = __hip_atomic_fetch_add(cntw, 1, __ATOMIC_RELAXED, __HIP_MEMORY_SCOPE_WORKGROUP); if (p < TOPK) sel[p] = key; } }
    __syncthreads();
    {
        const int k = tid & 255, g = tid >> 8; const int key = sel[k];
        const float* kr; if (key < PAST) { const int phys = page_table[b * NPG + (key >> 7)]; kr = cache_k + (((size_t)phys * PAGE + (key & 127)) * 2 + g) * 128; } else kr = kself + g * 128;
        float s4[4] = {0.f, 0.f, 0.f, 0.f};
#pragma unroll 4
        for (int d4 = 0; d4 < 32; ++d4) { const f32x4 k4 = *(const f32x4*)(kr + 4 * d4);
#pragma unroll
            for (int hh = 0; hh < 4; ++hh) { const f32x4 q4 = *(const LAS f32x4*)(qf + (4 * g + hh) * 128 + 4 * d4); s4[hh] = fmaf(q4.x, k4.x, fmaf(q4.y, k4.y, fmaf(q4.z, k4.z, fmaf(q4.w, k4.w, s4[hh])))); } }
#pragma unroll
        for (int hh = 0; hh < 4; ++hh) Sb[(4 * g + hh) * 256 + k] = s4[hh] * att::SCALE;
    }
    __syncthreads();
    {
        float x[4]; float m = NEG;
#pragma unroll
        for (int j = 0; j < 4; ++j) { x[j] = Sb[w * 256 + lane + 64 * j]; m = fmaxf(m, x[j]); }
        m = wave_max_f(m); float sum = 0.f;
#pragma unroll
        for (int j = 0; j < 4; ++j) { x[j] = __expf(x[j] - m); sum += x[j]; }
        sum = wave_sum(sum); const float inv = 1.0f / sum;
#pragma unroll
        for (int j = 0; j < 4; ++j) Sb[w * 256 + lane + 64 * j] = x[j] * inv;
    }
    __syncthreads();
    {
        const int d = tid & 127, hq = tid >> 7, g = hq >> 1; float o0 = 0.f, o1 = 0.f;
        for (int k = 0; k < TOPK; ++k) { const int key = sel[k];
            const float* vr; if (key < PAST) { const int phys = page_table[b * NPG + (key >> 7)]; vr = cache_v + (((size_t)phys * PAGE + (key & 127)) * 2 + g) * 128; } else vr = vself + g * 128;
            const float vv = vr[d]; o0 = fmaf(Sb[(2 * hq) * 256 + k], vv, o0); o1 = fmaf(Sb[(2 * hq + 1) * 256 + k], vv, o1); }
        const bf16* SGB = (const bf16*)(F.ws + WS_SGB) + (size_t)(MP + b) * DM; bf16* PB = (bf16*)(F.ws + WS_PB) + (size_t)(MP + b) * DM;
        PB[(2 * hq) * 128 + d] = (bf16)f2bf(o0 * bf2f(SGB[(2 * hq) * 128 + d])); PB[(2 * hq + 1) * 128 + d] = (bf16)f2bf(o1 * bf2f(SGB[(2 * hq + 1) * 128 + d]));
    }
    __syncthreads();
}

template <int STAGE> struct EpiMerge {
    unsigned char* ws;
    __device__ __forceinline__ void operator()(const pg8::f32x4 (&acc)[2][2][4][2], const pg8::Unit& u, int wr, int wc, int fr, int fq) const {
        const bf16* GATE = (const bf16*)(ws + (STAGE == 0 ? WS_SMA : WS_SMB)); const bf16* T1 = (const bf16*)(ws + WS_T1); bf16* DST = (bf16*)(ws + (STAGE == 0 ? WS_T1 : WS_MM));
        const int rbase = u.pm * 256 + wr * 64 + fr;
#pragma unroll
        for (int ai = 0; ai < 2; ++ai)
#pragma unroll
            for (int m = 0; m < 4; ++m) { const int row = rbase + ai * 128 + m * 16;
#pragma unroll
                for (int bj = 0; bj < 2; ++bj) { const size_t off = (size_t)row * DM + u.pn * 256 + 128 * bj + 32 * wc + 8 * fq;
                    const v4u gt = *(const GAS v4u*)(GATE + off);
                    float g[8] = {__uint_as_float(gt.x << 16), __uint_as_float(gt.x & 0xffff0000u), __uint_as_float(gt.y << 16), __uint_as_float(gt.y & 0xffff0000u),
                                  __uint_as_float(gt.z << 16), __uint_as_float(gt.z & 0xffff0000u), __uint_as_float(gt.w << 16), __uint_as_float(gt.w & 0xffff0000u)};
                    float r[8];
#pragma unroll
                    for (int j = 0; j < 4; ++j) { r[j] = g[j] * acc[ai][bj][m][0][j]; r[4 + j] = g[4 + j] * acc[ai][bj][m][1][j]; }
                    if (STAGE == 1) { const v4u tt = *(const GAS v4u*)(T1 + off);
                        r[0] += __uint_as_float(tt.x << 16); r[1] += __uint_as_float(tt.x & 0xffff0000u); r[2] += __uint_as_float(tt.y << 16); r[3] += __uint_as_float(tt.y & 0xffff0000u);
                        r[4] += __uint_as_float(tt.z << 16); r[5] += __uint_as_float(tt.z & 0xffff0000u); r[6] += __uint_as_float(tt.w << 16); r[7] += __uint_as_float(tt.w & 0xffff0000u); }
                    v4u o; o.x = pg8::cvt_pk_bf16(r[0], r[1]); o.y = pg8::cvt_pk_bf16(r[2], r[3]); o.z = pg8::cvt_pk_bf16(r[4], r[5]); o.w = pg8::cvt_pk_bf16(r[6], r[7]);
                    *(GAS v4u*)(DST + off) = o; } }
    }
};
struct EpiOut {
    unsigned char* ws; float* out; const float* xp; const float* xs;
    __device__ __forceinline__ void operator()(const pg8::f32x4 (&acc)[2][2][4][2], const pg8::Unit& u, int wr, int wc, int fr, int fq) const {
        const float* MOD = (const float*)(ws + WS_MOD); float* SUMSQ = (float*)(ws + WS_SUMSQ);
        const int rbase = u.pm * 256 + wr * 64 + fr; const bool samp = (u.pm == MP / 256);
#pragma unroll
        for (int ai = 0; ai < 2; ++ai)
#pragma unroll
            for (int m = 0; m < 4; ++m) { const int row = rbase + ai * 128 + m * 16;
                const bool valid = !samp || (row - MP < NS);
                const int mr = samp ? (8 + ((row - MP) & 31)) : (row >> 12);
                const float* gate = MOD + (size_t)mr * 3072 + 2048;
                const float* xr = samp ? (xs + (size_t)((row - MP) & 31) * DM) : (xp + (size_t)row * DM);
                float* orow = samp ? (out + O_YS + (size_t)((row - MP) & 31) * DM) : (out + O_YP + (size_t)row * DM);
                float ss = 0.f;
#pragma unroll
                for (int bj = 0; bj < 2; ++bj)
#pragma unroll
                    for (int n = 0; n < 2; ++n) { const int col = u.pn * 256 + 128 * bj + 32 * wc + 16 * n + 4 * fq;
                        const pg8::f32x4 x4 = *(const pg8::f32x4*)(xr + col), g4 = *(const pg8::f32x4*)(gate + col);
                        const pg8::f32x4 hv = x4 + g4 * acc[ai][bj][m][n];
                        ss += (hv[0] * hv[0] + hv[1] * hv[1]) + (hv[2] * hv[2] + hv[3] * hv[3]);
                        if (valid) *(pg8::f32x4*)(orow + col) = hv; }
                ss += __shfl_xor(ss, 16); ss += __shfl_xor(ss, 32);
                if (fq == 0 && valid) atomicAdd(SUMSQ + row, ss); }
    }
};
__device__ __forceinline__ void p6_final_norm(Frame& F) {
    const int gw = F.vcu * NWAVES + F.wave, NGW = F.G * NWAVES, lane = F.lane;
    const float* SUMSQ = (const float*)(F.ws + WS_SUMSQ); const float* gf = F.in[26];
    for (int m = gw; m < MP + NS; m += NGW) {
        float* yr = (m < MP) ? (F.out + O_YP + (size_t)m * DM) : (F.out + O_YS + (size_t)(m - MP) * DM);
        const float rstd = 1.0f / sqrtf(SUMSQ[m] * (1.f / DM) + EPS);
        GAS f32x4* y4 = (GAS f32x4*)yr + lane;
#pragma unroll
        for (int j = 0; j < 4; ++j) { const f32x4 g4 = *(const f32x4*)(gf + 256 * j + 4 * lane); f32x4 v = y4[64 * j]; v = v * rstd * g4; y4[64 * j] = v; }
    }
}

__global__ void __launch_bounds__(NTHR, 2) fwd(Args args) {
    extern __shared__ __attribute__((aligned(16))) unsigned char lds_raw[];
    Frame F;
    F.lds = (LAS unsigned char*)lds_raw;
    F.tid = threadIdx.x; F.lane = F.tid & 63; F.wave = __builtin_amdgcn_readfirstlane(F.tid >> 6);
    F.G = gridDim.x; { const int bx = blockIdx.x; F.vcu = (F.G % 8 == 0) ? (bx % 8) * (F.G / 8) + bx / 8 : bx; }
    F.in = args.in; F.out = args.out; F.ws = args.ws;
    volatile LAS unsigned* MISC = (volatile LAS unsigned*)(F.lds + LDSCTL_OFF);
    for (int u = F.tid; u < (LDS_BYTES - LDSCTL_OFF) / 4; u += NTHR) ((LAS unsigned*)(F.lds + LDSCTL_OFF))[u] = 0u;
    __syncthreads();
    XcdBarrier bar; bar.bar = (unsigned*)(F.ws + WS_CTL) + CW_BAR; bar.x = 0; bar.st = nullptr;
#if N_LAUNCH_MODE == 1
    bar = xcd_barrier_post((unsigned*)(F.ws + WS_CTL) + CW_BAR, MISC + 8);
#define GRID_BAR() xcd_barrier(bar)
#else
#define GRID_BAR() do {} while (0)
#endif
    const int lo = args.ph_lo, hi = args.ph_hi;
#ifndef PHASE_MASK
#define PHASE_MASK 0xFFFF
#endif
#define IN(k) (((PHASE_MASK >> (k)) & 1) && lo <= (k) && (k) < hi)
#define BOTH(k) (IN(k) && IN((k) + 1))
    if (IN(0)) { p0_prologue(F); p0_build_wg(F);
        if (BOTH(0)) GRID_BAR(); }
    if (IN(1)) { p0b_norm(F); if (BOTH(1)) GRID_BAR(); }
    if (IN(2)) {
        pg8::Gemm g{(const bf16*)(F.ws + WS_XN), (const bf16*)(F.ws + WS_WIN), MT, N_IN_PAD, DM}; pg8::StaticOrder S; S.init(MT, N_IN_PAD, F.G, (int)blockIdx.x);
        EpiIn E{F.ws, F.out, F.in[21], F.in[22]};
        pg8::gemm_phase<EpiIn, pg8::StaticOrder, true, true>(F.lds, g, S, E);
        if (BOTH(2)) GRID_BAR();
    }
    if (IN(3)) {
#ifndef NO_RGLRU
        p2_rglru(F);
#endif
#ifndef NO_IDX
        p3a_indexer(F, args.page_table);
#endif
        if (BOTH(3)) GRID_BAR();
    }
    if (IN(4)) {
        { pg8::Gemm g{(const bf16*)(F.ws + WS_PA), (const bf16*)(F.ws + WS_WPA), MT, DM, DM}; pg8::StaticOrder S; S.init(MT, DM, F.G, (int)blockIdx.x);
          EpiMerge<0> E{F.ws};
          pg8::gemm_phase<EpiMerge<0>, pg8::StaticOrder, true, true>(F.lds, g, S, E); }
        for (int b = F.G - 1 - F.vcu; b < NS; b += F.G) p3b_sample_unit(F, args.page_table, b);
        __syncthreads();
        p3b_attention(F);
        if (BOTH(4)) GRID_BAR();
    }
    if (IN(5)) {
        pg8::Gemm g{(const bf16*)(F.ws + WS_PB), (const bf16*)(F.ws + WS_WPB), MT, DM, DM}; pg8::StaticOrder S; S.init(MT, DM, F.G, (int)blockIdx.x);
        EpiMerge<1> E{F.ws};
        pg8::gemm_phase<EpiMerge<1>, pg8::StaticOrder, true, true>(F.lds, g, S, E);
        if (BOTH(5)) GRID_BAR();
    }
    if (IN(6)) {
        pg8::Gemm g{(const bf16*)(F.ws + WS_MM), (const bf16*)(F.ws + WS_WO), MT, DM, DM}; pg8::StaticOrder S; S.init(MT, DM, F.G, (int)blockIdx.x);
        EpiOut E{F.ws, F.out, F.in[0], F.in[1]};
        pg8::gemm_phase<EpiOut, pg8::StaticOrder, true, true>(F.lds, g, S, E);
        if (BOTH(6)) GRID_BAR();
    }
    if (IN(7)) { p6_final_norm(F); }
}

extern "C" void kernel_launch(void* const* d_in, const int* in_sizes, int n_in, void* d_out, int out_size, void* d_ws, size_t ws_size, hipStream_t stream) {
    static int grid = 0;
    if (grid == 0) {
        if (n_in != 27 || (size_t)out_size != O_END || ws_size < WS_END) { fprintf(stderr, "kernel_launch: unexpected shapes n_in %d out %d ws %zu (want 27, %zu, >= %zu)\n", n_in, out_size, ws_size, (size_t)O_END, (size_t)WS_END); grid = -1; return; }
        int dev = 0, cus = 0;
        if (hipGetDevice(&dev) != hipSuccess || hipDeviceGetAttribute(&cus, hipDeviceAttributeMultiprocessorCount, dev) != hipSuccess) { grid = -1; return; }
        if (hipFuncSetAttribute((const void*)fwd, hipFuncAttributeMaxDynamicSharedMemorySize, LDS_BYTES) != hipSuccess) { fprintf(stderr, "kernel_launch: hipFuncSetAttribute failed\n"); grid = -1; return; }
        int per_cu = 0;
        if (hipOccupancyMaxActiveBlocksPerMultiprocessor(&per_cu, (const void*)fwd, NTHR, LDS_BYTES) != hipSuccess || per_cu < 1) fprintf(stderr, "kernel_launch: occupancy query says %d\n", per_cu);
        (void)hipGetLastError();
        grid = cus;
    }
    if (grid < 0) return;
    hipMemsetAsync((char*)d_ws + WS_CTL, 0, ZERO_BYTES, stream);
    Args a{};
    for (int i = 0; i < 27; ++i) a.in[i] = (const float*)d_in[i];
    a.page_table = (const int*)d_in[7];
    a.out = (float*)d_out; a.ws = (unsigned char*)d_ws;
#if N_LAUNCH_MODE == 1
    a.ph_lo = 0; a.ph_hi = LAST_PHASE + 1;
    hipLaunchKernelGGL(fwd, dim3(grid), dim3(NTHR), LDS_BYTES, stream, a);
#else
    for (int p = 0; p <= LAST_PHASE; ++p) { a.ph_lo = p; a.ph_hi = p + 1; hipLaunchKernelGGL(fwd, dim3(grid), dim3(NTHR), LDS_BYTES, stream, a); }
#endif
}
```

```cpp
#include <hip/hip_runtime.h>
#include <cstdio>
#include <cstdint>

#ifndef REPEAT_PHASE
#define REPEAT_PHASE -1
#endif
#define REP(k) for (int rep_ = 0; rep_ < ((REPEAT_PHASE == (k)) ? 2 : 1); ++rep_)
#ifndef N_LAUNCH_MODE
#define N_LAUNCH_MODE 1
#endif
#ifndef LAST_PHASE
#define LAST_PHASE 6
#endif

namespace pg8 {
#define PG8_LAS __attribute__((address_space(3)))
typedef unsigned short bf16_t;
typedef short bf16x8 __attribute__((ext_vector_type(8)));
typedef float f32x4 __attribute__((ext_vector_type(4)));
typedef unsigned u32x4 __attribute__((ext_vector_type(4)));
typedef unsigned u32x2 __attribute__((ext_vector_type(2)));
constexpr int BM = 256, BK = 64, HALF = 128, HTB = HALF * BK * 2, STAGE_BYTES = 8 * HTB, NXCD = 8, WGM = 8;

__host__ __device__ __forceinline__ int lds_byte(int r, int c) { const int st = (r >> 4) * 2 + (c >> 5), rr = r & 15, cc = c & 31, ob = rr * 64 + cc * 2; return st * 1024 + (ob ^ (((ob >> 9) & 1) << 5)); }
__host__ __device__ __forceinline__ void stage_rc(int b, int& R, int& C) { const int st = b / 1024, sb = b % 1024, swz = sb ^ (((sb >> 9) & 1) << 5); R = (st >> 1) * 16 + swz / 64; C = (st & 1) * 32 + (swz % 64) / 2; }

struct Unit { int pm, pn; };
struct Gemm { const bf16_t* A; const bf16_t* Bt; int M, N, K; };

struct StaticOrder {
    int nM, nN, nwg, G, c, wgm;
    __host__ __device__ void init(int M, int N, int G_, int c_, int wgm_ = WGM) { nM = M / BM; nN = N / BM; nwg = nM * nN; G = G_; c = c_; wgm = wgm_; }
    __host__ __device__ bool next(int i, Unit& u) const {
        const long L = (long)i * G + c; if (L >= nwg) return false;
        int wgid = (int)L; { const int q = nwg / NXCD, r = nwg % NXCD, xcd = wgid % NXCD, off = wgid / NXCD; wgid = (xcd < r ? xcd * (q + 1) : r * (q + 1) + (xcd - r) * q) + off; }
        const int nig = wgm * nN, gid = wgid / nig, fm = gid * wgm, gsz = (nM - fm) < wgm ? (nM - fm) : wgm;
        u.pm = fm + ((wgid % nig) % gsz); u.pn = (wgid % nig) / gsz; return true;
    }
    __device__ __forceinline__ void a_ready(const Unit&) const {}
    __device__ __forceinline__ void done(const Unit&) const {}
};

__device__ __forceinline__ unsigned cvt_pk_bf16(float lo, float hi) { unsigned r; asm volatile("v_cvt_pk_bf16_f32 %0, %1, %2" : "=v"(r) : "v"(lo), "v"(hi)); return r; }

template <class Epi, class Sched, bool ALIGN_EPI = false, bool SP2 = true>
__device__ __forceinline__ void gemm_phase(PG8_LAS unsigned char* lds, const Gemm g, const Sched& S, const Epi& E) {
    const int tid = threadIdx.x, wid = __builtin_amdgcn_readfirstlane(tid >> 6), lane = tid & 63, wr = wid >> 2, wc = wid & 3, fr = lane & 15, fq = lane >> 4;
    const int K = g.K, nt = K / BK;
    unsigned voffA[2], voffB[2];
#pragma unroll
    for (int i = 0; i < 2; ++i) { int R, C; stage_rc(tid * 16 + i * 8192, R, C);
        voffA[i] = (unsigned)(R * K + C) * 2u; voffB[i] = (unsigned)(R * K + C) * 2u; }
    const size_t kstep = (size_t)(BK * 2);
    const size_t hstep = (size_t)HALF * K * 2;
    const size_t tstep = 2 * hstep;
    const unsigned ldsw = (unsigned)wid * 1024u;
    const int aoff = lds_byte(wr * 64 + fr, fq * 8), boff = lds_byte(wc * 32 + fr, fq * 8);
#define PG8_SA(b, h) (((b) * 2 + (h)) * HTB)
#define PG8_SB(b, h) ((4 + (b) * 2 + (h)) * HTB)
#define PG8_STAGE(bufoff, gbase, voff) do { _Pragma("unroll") for (int _i = 0; _i < 2; ++_i) \
        __builtin_amdgcn_global_load_lds((const unsigned*)((const char*)(gbase) + (voff)[_i]), (PG8_LAS unsigned*)(lds + (bufoff) + ldsw + _i * 8192), 16, 0, 0); } while (0)
#define PG8_LDA(dst, b, h) do { _Pragma("unroll") for (int m = 0; m < 4; ++m) _Pragma("unroll") for (int k = 0; k < 2; ++k) dst[m][k] = *(const PG8_LAS bf16x8*)(lds + PG8_SA(b, h) + aoff + m * 2048 + k * 1024); } while (0)
#define PG8_LDB(dst, b, h) do { _Pragma("unroll") for (int n = 0; n < 2; ++n) _Pragma("unroll") for (int k = 0; k < 2; ++k) dst[n][k] = *(const PG8_LAS bf16x8*)(lds + PG8_SB(b, h) + boff + n * 2048 + k * 1024); } while (0)
#define PG8_MMA(ai, bj, At, Bt) do { __builtin_amdgcn_s_setprio(1); _Pragma("unroll") for (int m = 0; m < 4; ++m) _Pragma("unroll") for (int n = 0; n < 2; ++n) _Pragma("unroll") for (int k = 0; k < 2; ++k) \
        acc[ai][bj][m][n] = __builtin_amdgcn_mfma_f32_16x16x32_bf16(Bt[n][k], At[m][k], acc[ai][bj][m][n], 0, 0, 0); __builtin_amdgcn_s_setprio(0); } while (0)
#define PG8_WAIT_V(n) asm volatile("s_waitcnt vmcnt(" #n ")" ::: "memory")
#define PG8_WAIT_L(n) asm volatile("s_waitcnt lgkmcnt(" #n ")" ::: "memory")
#define PG8_BAR __builtin_amdgcn_s_barrier()
#define PG8_SCHED __builtin_amdgcn_sched_barrier(0)
    Unit cur, nxt; int ui = 0;
    if (!S.next(0, cur)) return;
    f32x4 acc[2][2][4][2];
#pragma unroll
    for (int a = 0; a < 2; ++a)
#pragma unroll
        for (int b = 0; b < 2; ++b)
#pragma unroll
            for (int m = 0; m < 4; ++m)
#pragma unroll
                for (int n = 0; n < 2; ++n) acc[a][b][m][n] = (f32x4){0.f, 0.f, 0.f, 0.f};
    bf16x8 At[4][2], B0[2][2], B1[2][2];
    const char* cA = (const char*)g.A + (size_t)cur.pm * tstep; const char* cB = (const char*)g.Bt + (size_t)cur.pn * tstep;
    S.a_ready(cur);
    if constexpr (SP2) {
        PG8_STAGE(PG8_SB(0, 0), cB, voffB); PG8_STAGE(PG8_SB(0, 1), cB + hstep, voffB); PG8_STAGE(PG8_SA(0, 0), cA, voffA); PG8_STAGE(PG8_SA(0, 1), cA + hstep, voffA);
        if (wr == 1) PG8_BAR;
        PG8_WAIT_V(2); PG8_BAR;
        PG8_STAGE(PG8_SB(1, 0), cB + kstep, voffB); PG8_STAGE(PG8_SA(1, 0), cA + kstep, voffA); PG8_STAGE(PG8_SB(1, 1), cB + hstep + kstep, voffB);
        PG8_WAIT_V(6); PG8_BAR;
    } else {
        PG8_STAGE(PG8_SB(0, 0), cB, voffB); PG8_STAGE(PG8_SA(0, 0), cA, voffA); PG8_STAGE(PG8_SB(0, 1), cB + hstep, voffB); PG8_STAGE(PG8_SA(0, 1), cA + hstep, voffA);
        if (wr == 1) PG8_BAR;
        PG8_WAIT_V(4); PG8_BAR;
        PG8_STAGE(PG8_SB(1, 0), cB + kstep, voffB); PG8_STAGE(PG8_SA(1, 0), cA + kstep, voffA); PG8_STAGE(PG8_SB(1, 1), cB + hstep + kstep, voffB);
        PG8_WAIT_V(6); PG8_BAR;
    }
    for (;;) {
        const bool has_next = S.next(ui + 1, nxt);
        const char* nA = has_next ? (const char*)g.A + (size_t)nxt.pm * tstep : cA; const char* nB = has_next ? (const char*)g.Bt + (size_t)nxt.pn * tstep : cB;
        for (int t = 0; t < nt; t += 2) {
            const bool last = (t == nt - 2);
            const char* a1 = cA + (size_t)(t + 1) * kstep;
            const char* a2 = last ? nA : cA + (size_t)(t + 2) * kstep; const char* b2 = last ? nB : cB + (size_t)(t + 2) * kstep;
            const char* a3 = a2 + kstep; const char* b3 = b2 + kstep;
            if (last && has_next) S.a_ready(nxt);
            if constexpr (SP2) {
            PG8_LDB(B0, 0, 0); PG8_LDB(B1, 0, 1); PG8_SCHED; PG8_LDA(At, 0, 0); PG8_STAGE(PG8_SA(1, 1), a1 + hstep, voffA);
            PG8_WAIT_V(8); PG8_WAIT_L(0); PG8_BAR; PG8_MMA(0, 0, At, B0); PG8_MMA(0, 1, At, B1); PG8_BAR; PG8_SCHED;
            PG8_LDA(At, 0, 1); PG8_STAGE(PG8_SB(0, 0), b2, voffB); PG8_STAGE(PG8_SB(0, 1), b2 + hstep, voffB); PG8_STAGE(PG8_SA(0, 0), a2, voffA);
            PG8_WAIT_V(8); PG8_WAIT_L(0); PG8_BAR; PG8_MMA(1, 0, At, B0); PG8_MMA(1, 1, At, B1); PG8_BAR; PG8_SCHED;
            PG8_LDB(B0, 1, 0); PG8_LDB(B1, 1, 1); PG8_SCHED; PG8_LDA(At, 1, 0); PG8_STAGE(PG8_SA(0, 1), a2 + hstep, voffA);
            PG8_WAIT_V(8); PG8_WAIT_L(0); PG8_BAR; PG8_MMA(0, 0, At, B0); PG8_MMA(0, 1, At, B1); PG8_BAR; PG8_SCHED;
            PG8_LDA(At, 1, 1); PG8_STAGE(PG8_SB(1, 0), b3, voffB); PG8_STAGE(PG8_SB(1, 1), b3 + hstep, voffB); PG8_STAGE(PG8_SA(1, 0), a3, voffA);
            PG8_WAIT_V(8); PG8_WAIT_L(0); PG8_BAR; PG8_MMA(1, 0, At, B0); PG8_MMA(1, 1, At, B1); PG8_BAR; PG8_SCHED;
            } else {
            PG8_LDB(B0, 0, 0); PG8_SCHED; PG8_LDA(At, 0, 0); PG8_STAGE(PG8_SA(1, 1), a1 + hstep, voffA);
            PG8_WAIT_L(8); PG8_BAR; PG8_WAIT_L(0); PG8_MMA(0, 0, At, B0); PG8_BAR; PG8_SCHED;
            PG8_LDB(B1, 0, 1); PG8_STAGE(PG8_SB(0, 0), b2, voffB);
            PG8_BAR; PG8_WAIT_L(0); PG8_MMA(0, 1, At, B1); PG8_BAR;
            PG8_LDA(At, 0, 1); PG8_STAGE(PG8_SA(0, 0), a2, voffA);
            PG8_BAR; PG8_WAIT_L(0); PG8_MMA(1, 0, At, B0); PG8_BAR; PG8_SCHED;
            PG8_STAGE(PG8_SB(0, 1), b2 + hstep, voffB);
            PG8_WAIT_V(6); PG8_BAR; PG8_MMA(1, 1, At, B1); PG8_BAR;
            PG8_LDB(B0, 1, 0); PG8_SCHED; PG8_LDA(At, 1, 0); PG8_STAGE(PG8_SA(0, 1), a2 + hstep, voffA);
            PG8_WAIT_L(8); PG8_BAR; PG8_WAIT_L(0); PG8_MMA(0, 0, At, B0); PG8_BAR; PG8_SCHED;
            PG8_LDB(B1, 1, 1); PG8_STAGE(PG8_SB(1, 0), b3, voffB);
            PG8_BAR; PG8_WAIT_L(0); PG8_MMA(0, 1, At, B1); PG8_BAR;
            PG8_LDA(At, 1, 1); PG8_STAGE(PG8_SA(1, 0), a3, voffA);
            PG8_BAR; PG8_WAIT_L(0); PG8_MMA(1, 0, At, B0); PG8_BAR; PG8_SCHED;
            PG8_STAGE(PG8_SB(1, 1), b3 + hstep, voffB);
            PG8_WAIT_V(6); PG8_BAR; PG8_MMA(1, 1, At, B1); PG8_BAR;
            }
        }
        if constexpr (ALIGN_EPI) { if (wr == 0) PG8_BAR; }
        E(acc, cur, wr, wc, fr, fq); if constexpr (Epi::PROBE_TWICE) { if (REPEAT_PHASE == 20) E(acc, cur, wr, wc, fr, fq); } S.done(cur);
        if (!has_next) break;
#pragma unroll
        for (int a = 0; a < 2; ++a)
#pragma unroll
            for (int b = 0; b < 2; ++b)
#pragma unroll
                for (int m = 0; m < 4; ++m)
#pragma unroll
                    for (int n = 0; n < 2; ++n) acc[a][b][m][n] = (f32x4){0.f, 0.f, 0.f, 0.f};
        cur = nxt; cA = nA; cB = nB; ++ui;
        if constexpr (ALIGN_EPI) { if (wr == 1) PG8_BAR; }
    }
    PG8_WAIT_V(0);
    if constexpr (!ALIGN_EPI) { if (wr == 0) PG8_BAR; }
    PG8_BAR;
#undef PG8_SA
#undef PG8_SB
#undef PG8_STAGE
#undef PG8_LDA
#undef PG8_LDB
#undef PG8_MMA
#undef PG8_WAIT_V
#undef PG8_WAIT_L
#undef PG8_BAR
#undef PG8_SCHED
}
}

constexpr int DM = 1024, NBATCH = 8, SEQ = 4096, MP = NBATCH * SEQ, NS = 32, MT = MP + 256;
constexpr int PAST = 16384, PAGE = 128, NPG = PAST / PAGE;
constexpr int D_IN = 7240, NT_IN = 29, N_IN_PAD = NT_IN * 256;
constexpr int C_XA = 0, C_GA = 1024, C_Q = 2048, C_K = 3072, C_V = 3328, C_GB = 3584, C_QI = 4608, C_KI = 5120, C_WI = 5184, C_MA = 5192, C_MB = 6216;
constexpr float EPS = 1e-6f;
constexpr float IDX_W_SCALE = 0.04419417382415922f;
constexpr int NWAVES = 8, NTHR = 512;

constexpr size_t O_YP = 0, O_YS = O_YP + (size_t)MP * DM, O_KP = O_YS + (size_t)NS * DM, O_VP = O_KP + (size_t)MP * 256, O_IKP = O_VP + (size_t)MP * 256,
                 O_CP = O_IKP + (size_t)MP * 64, O_LP = O_CP + (size_t)NBATCH * 3 * DM, O_KS = O_LP + (size_t)NBATCH * DM, O_VS = O_KS + (size_t)NS * 256,
                 O_IKS = O_VS + (size_t)NS * 256, O_CS = O_IKS + (size_t)NS * 64, O_LS = O_CS + (size_t)NS * 3 * DM, O_END = O_LS + (size_t)NS * DM;

constexpr size_t MiB = 1u << 20;
constexpr size_t WS_CTL = 0;
constexpr size_t WS_MOD = 1 * MiB;
constexpr size_t WS_SUMSQ = WS_MOD + 512 * 1024;
constexpr size_t ZERO_BYTES = 2 * MiB;
constexpr size_t WS_RT128 = 2 * MiB;
constexpr size_t WS_RT64 = WS_RT128 + 3 * MiB;
constexpr size_t WS_WG = 7 * MiB;
constexpr size_t WS_WPA = 8 * MiB, WS_WPB = 10 * MiB, WS_WO = 12 * MiB;
constexpr size_t WS_WIN = 14 * MiB;
constexpr size_t WS_WI = 30 * MiB;
constexpr size_t WS_KI = 32 * MiB;
constexpr size_t WS_SSC = 38 * MiB;
constexpr size_t WS_XCH = 44 * MiB;
constexpr size_t WS_MSK = 48 * MiB;
constexpr size_t ACT = (size_t)MT * DM * 2;
constexpr size_t WS_XN = 64 * MiB;
constexpr size_t WS_XC = WS_XN;
constexpr size_t WS_XA = WS_XN + 65 * MiB, WS_SGA = WS_XA + 65 * MiB, WS_Q = WS_SGA + 65 * MiB, WS_SGB = WS_Q + 65 * MiB, WS_SMA = WS_SGB + 65 * MiB, WS_SMB = WS_SMA + 65 * MiB;
constexpr size_t WS_PA = WS_SMB + 65 * MiB, WS_PB = WS_PA + 65 * MiB, WS_T1 = WS_PB + 65 * MiB, WS_MM = WS_T1 + 65 * MiB;
constexpr size_t WS_KB = WS_MM + 65 * MiB, WS_VB = WS_KB + 17 * MiB, WS_QI = WS_VB + 17 * MiB, WS_END = WS_QI + 33 * MiB;
static_assert(ACT <= 65 * MiB, "activation size");

constexpr int CW_BAR = 4096;
constexpr int CW_PANEL = 8192;

constexpr int RING_BYTES = 131072;
constexpr int CW_MODCNT = CW_PANEL + 64 * 176;
constexpr int LDSCTL_OFF = 160 * 1024 - 512, LDS_BYTES = 160 * 1024;

#define GAS __attribute__((address_space(1)))
#define LAS __attribute__((address_space(3)))
typedef unsigned short bf16;
typedef unsigned v4u __attribute__((ext_vector_type(4)));
typedef unsigned v2u __attribute__((ext_vector_type(2)));
typedef float f32x4 __attribute__((ext_vector_type(4)));
typedef float f32x2 __attribute__((ext_vector_type(2)));
typedef short bf16x8 __attribute__((ext_vector_type(8)));
#define LDS_WAIT() asm volatile("s_waitcnt lgkmcnt(0)" ::: "memory")
#define VM_WAIT() asm volatile("s_waitcnt vmcnt(0)" ::: "memory")
__device__ __forceinline__ unsigned f2bf(float f) { unsigned u = __builtin_bit_cast(unsigned, f); return (u + 0x7fffu + ((u >> 16) & 1u)) >> 16; }
__device__ __forceinline__ unsigned pk2(float lo, float hi) { return f2bf(lo) | (f2bf(hi) << 16); }
__device__ __forceinline__ float bf2f(unsigned short b) { return __uint_as_float(((unsigned)b) << 16); }
__device__ __forceinline__ float sigmoidf_(float x) { return __builtin_amdgcn_rcpf(1.0f + __builtin_amdgcn_exp2f(-1.4426950408889634f * x)); }
__device__ __forceinline__ float siluf_(float x) { return x * __builtin_amdgcn_rcpf(1.0f + __builtin_amdgcn_exp2f(-1.4426950408889634f * x)); }

#define XB_TMO      128
#define XB_XCNT(j)  (256  + 64 * (j))
#define XB_XSUB(j)  (1280 + 64 * (j))
#define XB_XGEN(j)  (2304 + 64 * (j))
#define XB_TOP      3328
#define XB_TOPGEN   3392
#define XCD_BAR_WORDS 3456
#define XB_SPIN_CAP (1u << 18)
__device__ __forceinline__ unsigned xb_ld(unsigned* p)              { return __hip_atomic_load(p, __ATOMIC_RELAXED, __HIP_MEMORY_SCOPE_AGENT); }
__device__ __forceinline__ unsigned xb_add(unsigned* p, unsigned v) { return __hip_atomic_fetch_add(p, v, __ATOMIC_RELAXED, __HIP_MEMORY_SCOPE_AGENT); }
__device__ __forceinline__ unsigned xb_xcc_id() { return (unsigned)__builtin_amdgcn_s_getreg((3 << 11) | 20) & 0xFu; }
#define XB_SPIN(cond, bar) do { unsigned _sp = 0; while (cond) { __builtin_amdgcn_s_sleep(1); \
    if ((++_sp & 255u) == 0u) { if (xb_ld(&(bar)[XB_TMO])) break; if (_sp > XB_SPIN_CAP) { atomicAdd(&(bar)[XB_TMO], 1u); break; } } } } while (0)
struct XcdBarrier { unsigned* bar; unsigned x; volatile LAS unsigned* st; };
__device__ __forceinline__ XcdBarrier xcd_barrier_post(unsigned* bar, volatile LAS unsigned* st) {
    XcdBarrier b; b.bar = bar; b.x = xb_xcc_id(); b.st = st;
    if (threadIdx.x == 0) (void)xb_add(&bar[XB_XCNT(b.x)], 1u);
    return b;
}
__device__ __forceinline__ void xcd_barrier_complete(unsigned* bar, unsigned x, unsigned& nloc, unsigned& nx) {
    const unsigned G = gridDim.x * gridDim.y * gridDim.z;
    unsigned sum, cnt, mine, sp = 0u;
    for (;;) {
        sum = 0u; cnt = 0u; mine = 0u;
#pragma unroll
        for (unsigned j = 0; j < 16; ++j) { const unsigned c = xb_ld(&bar[XB_XCNT(j)]); sum += c; cnt += (c > 0u) ? 1u : 0u; mine = (j == x) ? c : mine; }
        if (sum == G) break;
        __builtin_amdgcn_s_sleep(1);
        if ((++sp & 255u) == 0u) { if (xb_ld(&bar[XB_TMO])) break; if (sp > XB_SPIN_CAP) { atomicAdd(&bar[XB_TMO], 1u); break; } }
    }
    nloc = mine > 0u ? mine : 1u; nx = cnt > 0u ? cnt : 1u;
}
__device__ __forceinline__ void xcd_barrier(const XcdBarrier& b) {
    asm volatile("s_waitcnt vmcnt(0)" ::: "memory");
    __syncthreads();
    if (threadIdx.x == 0) {
        unsigned* bar = b.bar;
        __builtin_amdgcn_s_waitcnt(0);
        unsigned nloc = b.st[0], nx = b.st[1];
        if (nloc == 0u) { xcd_barrier_complete(bar, b.x, nloc, nx); b.st[0] = nloc; b.st[1] = nx; }
        const unsigned old = xb_add(&bar[XB_XSUB(b.x)], 1u);
        const unsigned gen = old / nloc;
        if (old + 1u == (gen + 1u) * nloc) {
            __builtin_amdgcn_fence(__ATOMIC_RELEASE, "agent");
            asm volatile("s_waitcnt vmcnt(0)" ::: "memory");
            const unsigned og = xb_add(&bar[XB_TOP], 1u);
            const unsigned tg = og / nx;
            if (og + 1u == (tg + 1u) * nx) xb_add(&bar[XB_TOPGEN], 1u);
            else XB_SPIN(xb_ld(&bar[XB_TOPGEN]) == tg, bar);
            __builtin_amdgcn_fence(__ATOMIC_ACQUIRE, "agent");
            xb_add(&bar[XB_XGEN(b.x)], 1u);
            asm volatile("s_waitcnt vmcnt(0)" ::: "memory");
        } else {
            XB_SPIN(xb_ld(&bar[XB_XGEN(b.x)]) == gen, bar);
            __builtin_amdgcn_fence(__ATOMIC_ACQUIRE, "agent");
            asm volatile("s_waitcnt vmcnt(0)" ::: "memory");
        }
    }
    __syncthreads();
}

struct Args { const float* in[27]; const int* page_table; float* out; unsigned char* ws; float* out_real; int ph_lo, ph_hi; };
struct Frame {
    LAS unsigned char* lds;
    int tid, lane, wave, vcu, G;
    const float* const* in;
    float* out; unsigned char* ws;
};
__device__ __forceinline__ float wave_sum(float v) {
#pragma unroll
    for (int o = 1; o < 64; o <<= 1) v += __shfl_xor(v, o);
    return v;
}

__host__ __device__ __forceinline__ int perm_plain(int g) { const int bj = g >> 7, wc = (g >> 5) & 3, n = (g >> 4) & 1, fq = (g >> 2) & 3, j = g & 3; return 128 * bj + 32 * wc + 8 * fq + 4 * n + j; }
__host__ __device__ __forceinline__ int perm_rot128(int g) { const int bj = g >> 7, wc = (g >> 5) & 3, n = (g >> 4) & 1, fq = (g >> 2) & 3, j = g & 3; return 128 * bj + 64 * n + 16 * wc + 4 * fq + j; }
__host__ __device__ __forceinline__ int perm_rot64(int g) { const int bj = g >> 7, wc = (g >> 5) & 3, n = (g >> 4) & 1, fq = (g >> 2) & 3, j = g & 3; return 64 * (2 * bj + (wc >> 1)) + 32 * n + 16 * (wc & 1) + 4 * fq + j; }
__device__ __forceinline__ int win_src_col(int gg) {
    const int pn = gg >> 8, g = gg & 255;
    if (pn < 4)  return C_XA + pn * 256 + perm_plain(g);
    if (pn < 8)  return C_GA + (pn - 4) * 256 + perm_plain(g);
    if (pn < 12) return C_Q + (pn - 8) * 256 + perm_rot128(g);
    if (pn == 12) return C_K + perm_rot128(g);
    if (pn == 13) return C_V + perm_plain(g);
    if (pn < 18) return C_GB + (pn - 14) * 256 + perm_plain(g);
    if (pn < 20) return C_QI + (pn - 18) * 256 + perm_rot64(g);
    if (pn == 20) { const int bj = g >> 7, wc = (g >> 5) & 3, n = (g >> 4) & 1, fq = (g >> 2) & 3, j = g & 3;
        if (wc == 0) return C_KI + 32 * bj + 16 * n + 4 * fq + j;
        if (wc == 1 && bj == 0 && n == 0 && fq < 2) return C_WI + 4 * fq + j;
        return -1; }
    if (pn < 25) return C_MA + (pn - 21) * 256 + perm_plain(g);
    return C_MB + (pn - 25) * 256 + perm_plain(g);
}

template <int MODE>
__device__ __forceinline__ void p0_transpose_item(const float* W, int K, int N, bf16* WT, LAS float* scr, int item, int lane, int ndst) {
    const int nblk = ndst / 32, kb = item / nblk, nb = item % nblk, k0 = 64 * kb, g0 = 32 * nb;
    const int gme = g0 + (lane & 31);
    int src;
    if (MODE == 0) src = win_src_col(gme);
    else if (MODE == 1) src = (gme & ~255) + perm_plain(gme & 255);
    else src = gme;
    float wl[32];
#pragma unroll
    for (int i = 0; i < 32; ++i) { const int kk = 2 * i + (lane >> 5); wl[i] = (src >= 0) ? W[(size_t)(k0 + kk) * N + src] : 0.f; }
#pragma unroll
    for (int i = 0; i < 32; ++i) { const int kk = 2 * i + (lane >> 5); scr[kk * 33 + (lane & 31)] = wl[i]; }
    LDS_WAIT(); asm volatile("" ::: "memory");
    const int c = lane & 7;
#pragma unroll
    for (int j = 0; j < 4; ++j) { const int n = (lane >> 3) + 8 * j; const LAS float* s = scr + (8 * c) * 33 + n;
        v4u o; o.x = pk2(s[0 * 33], s[1 * 33]); o.y = pk2(s[2 * 33], s[3 * 33]); o.z = pk2(s[4 * 33], s[5 * 33]); o.w = pk2(s[6 * 33], s[7 * 33]);
        *(GAS v4u*)(WT + (size_t)(g0 + n) * K + k0 + 8 * c) = o; }
    LDS_WAIT(); asm volatile("" ::: "memory");
}

__device__ __forceinline__ void p0_prologue(Frame& F) {
    LAS float* scr = (LAS float*)(F.lds + F.wave * 16384);
    const int gw = F.vcu * NWAVES + F.wave, NGW = F.G * NWAVES, lane = F.lane;
    const float* c_prompt = F.in[8]; const float* c_sample = F.in[9]; const float* w_ada = F.in[10]; const float* b_ada = F.in[11];
    float* MOD = (float*)(F.ws + WS_MOD);
    for (int bt = F.vcu; bt < 48 * 4; bt += F.G) {
        const int cg = bt % 48, kq = bt / 48, col = cg * 64 + lane, k0 = (kq * 8 + F.wave) * 32;
        float wv[32];
#pragma unroll
        for (int kk = 0; kk < 32; ++kk) wv[kk] = w_ada[(size_t)(k0 + kk) * 3072 + col];
        float sc[40];
#pragma unroll
        for (int r = 0; r < 40; ++r) { const float* cr = (r < 8) ? (c_prompt + (size_t)r * DM) : (c_sample + (size_t)(r - 8) * DM); const float cv = cr[k0 + (lane & 31)]; sc[r] = siluf_(cv); }
        float acc[40];
#pragma unroll
        for (int r = 0; r < 40; ++r) acc[r] = 0.f;
#pragma unroll
        for (int kk = 0; kk < 32; ++kk) {
#pragma unroll
            for (int r = 0; r < 40; ++r) acc[r] = fmaf(__int_as_float(__builtin_amdgcn_readlane(__float_as_int(sc[r]), kk)), wv[kk], acc[r]);
        }
        LAS float* red = (LAS float*)F.lds;
        __syncthreads();
#pragma unroll
        for (int r = 0; r < 40; ++r) red[(F.wave * 40 + r) * 64 + lane] = acc[r];
        __syncthreads();
        for (int e = F.tid; e < 40 * 64; e += NTHR) { const int r = e >> 6, l = e & 63; float t = 0.f;
#pragma unroll
            for (int ww = 0; ww < 8; ++ww) t += red[(ww * 40 + r) * 64 + l];
            if (kq == 0) t += b_ada[cg * 64 + l];
            atomicAdd(MOD + (size_t)r * 3072 + cg * 64 + l, t); }
        asm volatile("s_waitcnt vmcnt(0)" ::: "memory");
        __syncthreads();
        if (F.tid == 0) { __builtin_amdgcn_fence(__ATOMIC_RELEASE, "agent"); __hip_atomic_fetch_add((unsigned*)(F.ws + WS_CTL) + CW_MODCNT, 1u, __ATOMIC_RELAXED, __HIP_MEMORY_SCOPE_AGENT); }
    }
    {
        f32x2* RT128 = (f32x2*)(F.ws + WS_RT128); f32x2* RT64 = (f32x2*)(F.ws + WS_RT64);
        const int gt = gw * 64 + lane, NGT = NGW * 64;
        for (int i = gt; i < 4097 * 64; i += NGT) { const int p = i >> 6, d = i & 63; const float pos = (p == 4096) ? 16384.f : (float)p;
            const float inv = powf(10000.f, -(float)d / 64.f); const float ang = pos * inv; float s, c; sincosf(ang, &s, &c); RT128[i] = (f32x2){c, s}; }
        for (int i = gt; i < 4097 * 32; i += NGT) { const int p = i >> 5, d = i & 31; const float pos = (p == 4096) ? 16384.f : (float)p;
            const float inv = powf(10000.f, -(float)d / 32.f); const float ang = pos * inv; float s, c; sincosf(ang, &s, &c); RT64[i] = (f32x2){c, s}; }
        const float* sconv = F.in[5]; float* ocs = F.out + O_CS;
        for (int i = gt; i < NS * 2 * DM; i += NGT) { const int b = i / (2 * DM), r = (i / DM) & 1, ch = i % DM; ocs[(size_t)b * 3 * DM + r * DM + ch] = sconv[(size_t)b * 3 * DM + (r + 1) * DM + ch]; }
    }
}

__device__ __forceinline__ void p1_weights(Frame& F) {
    LAS float* scr = (LAS float*)(F.lds + F.wave * 16384);
    const int gw = F.vcu * NWAVES + F.wave, NGW = F.G * NWAVES, lane = F.lane;
    {
        constexpr int I_IN = (DM / 64) * (N_IN_PAD / 32), I_SQ = (DM / 64) * (DM / 32);
        for (int it = gw; it < I_IN + 3 * I_SQ; it += NGW) {
            int r = it;
            if (r < I_IN) { p0_transpose_item<0>(F.in[13], DM, D_IN, (bf16*)(F.ws + WS_WIN), scr, r, lane, N_IN_PAD); continue; } r -= I_IN;
            if (r < I_SQ) { p0_transpose_item<1>(F.in[23], DM, DM, (bf16*)(F.ws + WS_WPA), scr, r, lane, DM); continue; } r -= I_SQ;
            if (r < I_SQ) { p0_transpose_item<1>(F.in[24], DM, DM, (bf16*)(F.ws + WS_WPB), scr, r, lane, DM); continue; } r -= I_SQ;
            p0_transpose_item<2>(F.in[25], DM, DM, (bf16*)(F.ws + WS_WO), scr, r, lane, DM);
        }
    }
}
__device__ __forceinline__ void p0b_norm(Frame& F) {
    const int gw = F.vcu * NWAVES + F.wave, NGW = F.G * NWAVES, lane = F.lane;
    const float* MOD = (const float*)(F.ws + WS_MOD); const float* gn = F.in[12];
    bf16* XN = (bf16*)(F.ws + WS_XN);
    f32x4 g4[4];
#pragma unroll
    for (int q = 0; q < 4; ++q) g4[q] = *(const f32x4*)(gn + 512 * (q >> 1) + 8 * lane + 4 * (q & 1));
    f32x4 nx[4], nsc[4], nsh[4];
#define NORM_LOAD(m_) do { const int mm_ = (m_); const float* xrow_ = (mm_ < MP) ? (F.in[0] + (size_t)mm_ * DM) : (F.in[1] + (size_t)(mm_ - MP) * DM); \
        const GAS f32x4* xr_ = (const GAS f32x4*)xrow_ + 2 * lane; nx[0] = xr_[0]; nx[1] = xr_[1]; nx[2] = xr_[128]; nx[3] = xr_[129]; \
        const int mr_ = (mm_ < MP) ? (mm_ >> 12) : (8 + mm_ - MP); const float* sh_ = MOD + (size_t)mr_ * 3072; const float* sc_ = sh_ + 1024; \
        _Pragma("unroll") for (int q = 0; q < 4; ++q) { const int c_ = 512 * (q >> 1) + 8 * lane + 4 * (q & 1); nsc[q] = *(const f32x4*)(sc_ + c_); nsh[q] = *(const f32x4*)(sh_ + c_); } } while (0)
    const bool xloc = (F.G % 8 == 0);
    const int WX = xloc ? NGW / 8 : NGW, lw = xloc ? gw % WX : gw, rbase = xloc ? SEQ * (gw / WX) : 0, RSPAN = xloc ? SEQ : MP;
    const int NPR = (lw < RSPAN) ? (RSPAN - lw + WX - 1) / WX : 0;
#define NORM_ROWAT(i_) (((i_) < NPR) ? (rbase + lw + WX * (i_)) : (((i_) == NPR && gw < NS) ? (MP + gw) : -1))
    int it = 0, m = NORM_ROWAT(0);
    if (m >= 0) NORM_LOAD(m);
    for (; m >= 0; ++it) {
        const int mnext = NORM_ROWAT(it + 1);
        f32x4 v[4], sc4[4], sh4[4]; float s = 0.f;
#pragma unroll
        for (int q = 0; q < 4; ++q) { v[q] = nx[q]; sc4[q] = nsc[q]; sh4[q] = nsh[q]; }
        asm volatile("" ::: "memory");
        if (mnext >= 0) NORM_LOAD(mnext);
        asm volatile("" ::: "memory");
#pragma unroll
        for (int q = 0; q < 4; ++q) s += (v[q].x * v[q].x + v[q].y * v[q].y) + (v[q].z * v[q].z + v[q].w * v[q].w);
        const float rstd = 1.0f / sqrtf(wave_sum(s) * (1.f / DM) + EPS);
        GAS v4u* o16 = (GAS v4u*)(XN + (size_t)m * DM) + lane;
#pragma unroll
        for (int j = 0; j < 2; ++j) { unsigned pk[4];
#pragma unroll
            for (int h = 0; h < 2; ++h) { const f32x4 x4 = v[2 * j + h], gg = g4[2 * j + h], ss = sc4[2 * j + h], hh = sh4[2 * j + h];
                const float y0 = x4.x * rstd * gg.x * (1.f + ss.x) + hh.x, y1 = x4.y * rstd * gg.y * (1.f + ss.y) + hh.y;
                const float y2 = x4.z * rstd * gg.z * (1.f + ss.z) + hh.z, y3 = x4.w * rstd * gg.w * (1.f + ss.w) + hh.w;
                pk[2 * h] = pk2(y0, y1); pk[2 * h + 1] = pk2(y2, y3); }
            o16[64 * j] = (v4u){pk[0], pk[1], pk[2], pk[3]}; }
        m = mnext;
    }
#undef NORM_ROWAT
#undef NORM_LOAD
}

struct EpiIn {
    static constexpr bool PROBE_TWICE = true;
    unsigned char* ws; float* out; const float* lng; const float* lnb;
    __device__ __forceinline__ void operator()(const pg8::f32x4 (&acc)[2][2][4][2], const pg8::Unit& u, int wr, int wc, int fr, int fq) const {
        using pg8::cvt_pk_bf16;
        asm volatile("" : "+v"(fr), "+v"(fq));
        const int pn = u.pn; const bool samp = (u.pm == MP / 256);
        const int rbase = u.pm * 256 + wr * 64 + fr;
        if (pn < 8 || pn == 13 || (pn >= 14 && pn < 18) || pn >= 21) {
            bf16* dst; int tcol; int act;
            if (pn < 4) { dst = (bf16*)(ws + WS_XA); tcol = pn * 256; act = 0; }
            else if (pn < 8) { dst = (bf16*)(ws + WS_SGA); tcol = (pn - 4) * 256; act = 1; }
            else if (pn == 13) { dst = (bf16*)(ws + WS_VB); tcol = 0; act = 0; }
            else if (pn < 18) { dst = (bf16*)(ws + WS_SGB); tcol = (pn - 14) * 256; act = 1; }
            else if (pn < 25) { dst = (bf16*)(ws + WS_SMA); tcol = (pn - 21) * 256; act = 2; }
            else { dst = (bf16*)(ws + WS_SMB); tcol = (pn - 25) * 256; act = 2; }
            const int ld = (pn == 13) ? 256 : DM;
#pragma unroll
            for (int ai = 0; ai < 2; ++ai)
#pragma unroll
                for (int m = 0; m < 4; ++m) {
                    const int row = rbase + ai * 128 + m * 16;
#pragma unroll
                    for (int bj = 0; bj < 2; ++bj) {
                        pg8::f32x4 v0 = acc[ai][bj][m][0], v1 = acc[ai][bj][m][1];
                        const int c0 = tcol + 128 * bj + 32 * wc + 8 * fq;
                        if (pn == 13) {
                            float* o = nullptr;
                            if (!samp) o = out + O_VP + (size_t)row * 256 + c0; else if (row - MP < NS) o = out + O_VS + (size_t)(row - MP) * 256 + c0;
                            if (o) { *(pg8::f32x4*)o = v0; *(pg8::f32x4*)(o + 4) = v1; }
                        }
                        if (pn < 4) {
                            if (!samp) { const int t = row & (SEQ - 1); if (t >= SEQ - 3) { float* o = out + O_CP + (size_t)(row >> 12) * 3 * DM + (size_t)(t - (SEQ - 3)) * DM + c0; *(pg8::f32x4*)o = v0; *(pg8::f32x4*)(o + 4) = v1; } }
                            else if (row - MP < NS) { float* o = out + O_CS + (size_t)(row - MP) * 3 * DM + 2 * DM + c0; *(pg8::f32x4*)o = v0; *(pg8::f32x4*)(o + 4) = v1; }
                        }
                        if (act == 1) {
#pragma unroll
                            for (int j = 0; j < 4; ++j) { v0[j] = siluf_(v0[j]); v1[j] = siluf_(v1[j]); }
                        } else if (act == 2) {
#pragma unroll
                            for (int j = 0; j < 4; ++j) { v0[j] = sigmoidf_(v0[j]); v1[j] = sigmoidf_(v1[j]); }
                        }
                        pg8::u32x4 w; w.x = cvt_pk_bf16(v0[0], v0[1]); w.y = cvt_pk_bf16(v0[2], v0[3]); w.z = cvt_pk_bf16(v1[0], v1[1]); w.w = cvt_pk_bf16(v1[2], v1[3]);
                        __builtin_nontemporal_store(w, (pg8::u32x4*)(dst + (size_t)row * ld + c0));
                    }
                }
        } else if (pn < 13) {
            const f32x2* RT = (const f32x2*)(ws + WS_RT128);
            const int d0 = 16 * wc + 4 * fq;
            const bool isk = (pn == 12);
            bf16* dst = isk ? (bf16*)(ws + WS_KB) : (bf16*)(ws + WS_Q); const int ld = isk ? 256 : DM; const int tcol = isk ? 0 : (pn - 8) * 256;
            pg8::f32x4 tb[2][4][2];
#pragma unroll
            for (int ai = 0; ai < 2; ++ai)
#pragma unroll
                for (int m = 0; m < 4; ++m) { const int row = rbase + ai * 128 + m * 16; const int p = samp ? 4096 : (row & (SEQ - 1));
                    tb[ai][m][0] = *(const pg8::f32x4*)(RT + (size_t)p * 64 + d0); tb[ai][m][1] = *(const pg8::f32x4*)(RT + (size_t)p * 64 + d0 + 2); }
            asm volatile("" ::: "memory");
#pragma unroll
            for (int ai = 0; ai < 2; ++ai) {
#pragma unroll
                for (int m = 0; m < 4; ++m) {
                    const int row = rbase + ai * 128 + m * 16;
                    const pg8::f32x4 cs01 = tb[ai][m][0], cs23 = tb[ai][m][1];
                    const float c[4] = {cs01[0], cs01[2], cs23[0], cs23[2]}, s[4] = {cs01[1], cs01[3], cs23[1], cs23[3]};
#pragma unroll
                    for (int bj = 0; bj < 2; ++bj) {
                        const pg8::f32x4 x1 = acc[ai][bj][m][0], x2 = acc[ai][bj][m][1];
                        pg8::f32x4 o1, o2;
#pragma unroll
                        for (int j = 0; j < 4; ++j) { o1[j] = x1[j] * c[j] - x2[j] * s[j]; o2[j] = x2[j] * c[j] + x1[j] * s[j]; }
                        const int c1 = tcol + 128 * bj + d0;
                        if (isk) {
                            float* o = nullptr;
                            if (!samp) o = out + O_KP + (size_t)row * 256 + c1; else if (row - MP < NS) o = out + O_KS + (size_t)(row - MP) * 256 + c1;
                            if (o) { *(pg8::f32x4*)o = o1; *(pg8::f32x4*)(o + 64) = o2; }
                        }
                        pg8::u32x2 w1, w2; w1.x = cvt_pk_bf16(o1[0], o1[1]); w1.y = cvt_pk_bf16(o1[2], o1[3]); w2.x = cvt_pk_bf16(o2[0], o2[1]); w2.y = cvt_pk_bf16(o2[2], o2[3]);
                        { auto s0 = __builtin_amdgcn_permlane16_swap(w1.x, w2.x, false, false); auto s1 = __builtin_amdgcn_permlane16_swap(w1.y, w2.y, false, false);
                          pg8::u32x4 wv; wv.x = s0[0]; wv.y = s1[0]; wv.z = s0[1]; wv.w = s1[1];
                          __builtin_nontemporal_store(wv, (pg8::u32x4*)(dst + (size_t)row * ld + ((fq & 1) ? (c1 - 4 + 64) : c1))); }
                    }
                }
            }
        } else if (pn < 20) {
            const f32x2* RT = (const f32x2*)(ws + WS_RT64);
            const int d0 = 16 * (wc & 1) + 4 * fq;
            bf16* dst = (bf16*)(ws + WS_QI);
            pg8::f32x4 tb[2][4][2];
#pragma unroll
            for (int ai = 0; ai < 2; ++ai)
#pragma unroll
                for (int m = 0; m < 4; ++m) { const int row = rbase + ai * 128 + m * 16; const int p = samp ? 4096 : (row & (SEQ - 1));
                    tb[ai][m][0] = *(const pg8::f32x4*)(RT + (size_t)p * 32 + d0); tb[ai][m][1] = *(const pg8::f32x4*)(RT + (size_t)p * 32 + d0 + 2); }
            asm volatile("" ::: "memory");
#pragma unroll
            for (int ai = 0; ai < 2; ++ai) {
#pragma unroll
                for (int m = 0; m < 4; ++m) {
                    const int row = rbase + ai * 128 + m * 16;
                    const pg8::f32x4 cs01 = tb[ai][m][0], cs23 = tb[ai][m][1];
                    const float c[4] = {cs01[0], cs01[2], cs23[0], cs23[2]}, s[4] = {cs01[1], cs01[3], cs23[1], cs23[3]};
#pragma unroll
                    for (int bj = 0; bj < 2; ++bj) {
                        const pg8::f32x4 x1 = acc[ai][bj][m][0], x2 = acc[ai][bj][m][1];
                        pg8::f32x4 o1, o2;
#pragma unroll
                        for (int j = 0; j < 4; ++j) { o1[j] = x1[j] * c[j] - x2[j] * s[j]; o2[j] = x2[j] * c[j] + x1[j] * s[j]; }
                        const int hh = (pn - 18) * 4 + 2 * bj + (wc >> 1);
                        const int c1 = hh * 64 + d0;
                        pg8::u32x2 w1, w2; w1.x = cvt_pk_bf16(o1[0], o1[1]); w1.y = cvt_pk_bf16(o1[2], o1[3]); w2.x = cvt_pk_bf16(o2[0], o2[1]); w2.y = cvt_pk_bf16(o2[2], o2[3]);
                        { auto s0 = __builtin_amdgcn_permlane16_swap(w1.x, w2.x, false, false); auto s1 = __builtin_amdgcn_permlane16_swap(w1.y, w2.y, false, false);
                          pg8::u32x4 wv; wv.x = s0[0]; wv.y = s1[0]; wv.z = s0[1]; wv.w = s1[1];
                          __builtin_nontemporal_store(wv, (pg8::u32x4*)(dst + (size_t)row * 512 + ((fq & 1) ? (c1 - 4 + 32) : c1))); }
                    }
                }
            }
        } else {
            if (wc == 0) {
                const f32x2* RT = (const f32x2*)(ws + WS_RT64);
                bf16* dst = (bf16*)(ws + WS_KI);
#pragma unroll
                for (int ai = 0; ai < 2; ++ai)
#pragma unroll
                    for (int m = 0; m < 4; ++m) {
                        const int row = rbase + ai * 128 + m * 16;
                        const int p = samp ? 4096 : (row & (SEQ - 1));
                        float sum = 0.f;
#pragma unroll
                        for (int bj = 0; bj < 2; ++bj)
#pragma unroll
                            for (int n = 0; n < 2; ++n) { const pg8::f32x4 x = acc[ai][bj][m][n]; sum += (x[0] + x[1]) + (x[2] + x[3]); }
                        sum += __shfl_xor(sum, 16); sum += __shfl_xor(sum, 32);
                        const float mu = sum * (1.f / 64.f); float q = 0.f;
#pragma unroll
                        for (int bj = 0; bj < 2; ++bj)
#pragma unroll
                            for (int n = 0; n < 2; ++n) { const pg8::f32x4 d = acc[ai][bj][m][n] - mu; q += (d[0] * d[0] + d[1] * d[1]) + (d[2] * d[2] + d[3] * d[3]); }
                        q += __shfl_xor(q, 16); q += __shfl_xor(q, 32);
                        const float rstd = 1.0f / sqrtf(q * (1.f / 64.f) + EPS);
                        float* o = nullptr;
                        if (!samp) o = out + O_IKP + (size_t)row * 64; else if (row - MP < NS) o = out + O_IKS + (size_t)(row - MP) * 64;
#pragma unroll
                        for (int n = 0; n < 2; ++n) {
                            const int d0 = 16 * n + 4 * fq;
                            const pg8::f32x4 g1 = *(const pg8::f32x4*)(lng + d0), g2 = *(const pg8::f32x4*)(lng + 32 + d0), b1 = *(const pg8::f32x4*)(lnb + d0), b2 = *(const pg8::f32x4*)(lnb + 32 + d0);
                            const pg8::f32x4 cs01 = *(const pg8::f32x4*)(RT + (size_t)p * 32 + d0), cs23 = *(const pg8::f32x4*)(RT + (size_t)p * 32 + d0 + 2);
                            const float c[4] = {cs01[0], cs01[2], cs23[0], cs23[2]}, s[4] = {cs01[1], cs01[3], cs23[1], cs23[3]};
                            pg8::f32x4 o1, o2;
#pragma unroll
                            for (int j = 0; j < 4; ++j) { const float y1 = (acc[ai][0][m][n][j] - mu) * rstd * g1[j] + b1[j], y2 = (acc[ai][1][m][n][j] - mu) * rstd * g2[j] + b2[j];
                                o1[j] = y1 * c[j] - y2 * s[j]; o2[j] = y2 * c[j] + y1 * s[j]; }
                            if (o) { *(pg8::f32x4*)(o + d0) = o1; *(pg8::f32x4*)(o + 32 + d0) = o2; }
                            pg8::u32x2 w1, w2; w1.x = cvt_pk_bf16(o1[0], o1[1]); w1.y = cvt_pk_bf16(o1[2], o1[3]); w2.x = cvt_pk_bf16(o2[0], o2[1]); w2.y = cvt_pk_bf16(o2[2], o2[3]);
                            *(pg8::u32x2*)(dst + (size_t)row * 64 + d0) = w1; *(pg8::u32x2*)(dst + (size_t)row * 64 + 32 + d0) = w2;
                        }
                    }
            } else if (wc == 1 && fq < 2) {
                float* WI = (float*)(ws + WS_WI);
#pragma unroll
                for (int ai = 0; ai < 2; ++ai)
#pragma unroll
                    for (int m = 0; m < 4; ++m) { const int row = rbase + ai * 128 + m * 16; *(pg8::f32x4*)(WI + (size_t)row * 8 + 4 * fq) = acc[ai][0][m][0] * IDX_W_SCALE; }
            }
        }
    }
};


__device__ __forceinline__ float softplus_neg(float lam) { const float x = -lam; return (x > 20.f) ? x : log1pf(__expf(x)); }
__device__ __forceinline__ void gate_au(float r, float ig, float xc, float sp, float& a, float& u) {
    a = __builtin_amdgcn_exp2f(-11.541560327111707f * r * sp);
    u = __builtin_amdgcn_sqrtf(fmaxf(1.0f - a * a, 0.f)) * (ig * xc);
}
__device__ __forceinline__ void p0_build_wg(Frame& F) {
    const int gw = F.vcu * NWAVES + F.wave, NGW = F.G * NWAVES, lane = F.lane;
    const float* w_ra = F.in[16]; const float* w_rx = F.in[18]; v4u* WG = (v4u*)(F.ws + WS_WG);
    for (int task = gw; task < 4 * 16 * 16; task += NGW) {
        const int s = task & 15, cg = (task >> 4) & 15, blk = task >> 8, n = lane & 31, hi = lane >> 5;
        const float* W = (n < 16) ? w_ra : w_rx; const int col = 16 * cg + (n & 15);
        float v[8];
#pragma unroll
        for (int j = 0; j < 8; ++j) v[j] = W[((size_t)blk * 256 + 16 * s + 8 * hi + j) * 256 + col];
        v4u o; o.x = pk2(v[0], v[1]); o.y = pk2(v[2], v[3]); o.z = pk2(v[4], v[5]); o.w = pk2(v[6], v[7]);
        WG[(size_t)task * 64 + lane] = o;
    }
}
#define BF_LO(u_) __uint_as_float((u_) << 16)
#define BF_HI(u_) __uint_as_float((u_) & 0xffff0000u)
__device__ __forceinline__ void p3_conv_pass(Frame& F) {
    const bf16* XA = (const bf16*)(F.ws + WS_XA); bf16* XC = (bf16*)(F.ws + WS_XC);
    const float* w_conv = F.in[14]; const float* b_conv = F.in[15];
    const int nskip = (F.G > 64) ? 32 : 0;
    if (F.vcu < nskip) return;
    const int gt = (F.vcu - nskip) * NTHR + F.tid, NGT = (F.G - nskip) * NTHR;
    const int co = gt & 127;
    float cw[4][8], cb[8];
#pragma unroll
    for (int e = 0; e < 8; e += 4) { const f32x4 b4 = *(const f32x4*)(b_conv + 8 * co + e); cb[e] = b4.x; cb[e + 1] = b4.y; cb[e + 2] = b4.z; cb[e + 3] = b4.w;
#pragma unroll
        for (int j = 0; j < 4; ++j) { const f32x4 w4 = *(const f32x4*)(w_conv + (size_t)j * DM + 8 * co + e); cw[j][e] = w4.x; cw[j][e + 1] = w4.y; cw[j][e + 2] = w4.z; cw[j][e + 3] = w4.w; } }
    const int NTASK = (MP / 8) * 128;
    v4u nraw[11];
#define CONV_LOAD(task_) do { const int strip_ = (task_) >> 7, row0_ = strip_ * 8, t0_ = row0_ & (SEQ - 1); \
        _Pragma("unroll") for (int r = 0; r < 11; ++r) { nraw[r] = (v4u){0u, 0u, 0u, 0u}; if (t0_ + r - 3 >= 0) nraw[r] = *(const GAS v4u*)(XA + (size_t)(row0_ + r - 3) * DM + 8 * co); } } while (0)
    if (gt < NTASK) CONV_LOAD(gt);
    for (int task = gt; task < NTASK; task += NGT) {
        const int strip = task >> 7, row0 = strip * 8;
        v4u raw[11];
#pragma unroll
        for (int r = 0; r < 11; ++r) raw[r] = nraw[r];
        asm volatile("" ::: "memory");
        if (task + NGT < NTASK) CONV_LOAD(task + NGT);
        asm volatile("" ::: "memory");
#pragma unroll
        for (int r = 0; r < 8; ++r) { float y[8];
#pragma unroll
            for (int e = 0; e < 8; ++e) y[e] = cb[e];
#pragma unroll
            for (int j = 0; j < 4; ++j) { const v4u q = raw[r + j];
                y[0] = fmaf(cw[j][0], BF_LO(q.x), y[0]); y[1] = fmaf(cw[j][1], BF_HI(q.x), y[1]); y[2] = fmaf(cw[j][2], BF_LO(q.y), y[2]); y[3] = fmaf(cw[j][3], BF_HI(q.y), y[3]);
                y[4] = fmaf(cw[j][4], BF_LO(q.z), y[4]); y[5] = fmaf(cw[j][5], BF_HI(q.z), y[5]); y[6] = fmaf(cw[j][6], BF_LO(q.w), y[6]); y[7] = fmaf(cw[j][7], BF_HI(q.w), y[7]); }
            v4u o; o.x = pk2(y[0], y[1]); o.y = pk2(y[2], y[3]); o.z = pk2(y[4], y[5]); o.w = pk2(y[6], y[7]);
            *(GAS v4u*)(XC + (size_t)(row0 + r) * DM + 8 * co) = o; }
    }
#undef CONV_LOAD
}
constexpr int RG_XC = 0, RG_XROW = 528  , RG_AU = 128 * RG_XROW, RG_CAR = RG_AU + 32768, RG_HP = RG_CAR + 4096, RG_BF = RG_HP + 256, RG_HB = RG_BF + 32768  , RG_END = RG_HB + 16384;
typedef float f32x16 __attribute__((ext_vector_type(16)));
__device__ __forceinline__ void p2_rglru_prompt_unit(Frame& F, int unit) {
    const int b = unit >> 5, nblk = (unit >> 3) & 3, cs = unit & 7;
    const int tid = F.tid, lane = F.lane, w = F.wave, wm = w & 3, wn = w >> 2;
    const bf16* XA = (const bf16*)(F.ws + WS_XA); const bf16* SGA = (const bf16*)(F.ws + WS_SGA); bf16* PA = (bf16*)(F.ws + WS_PA);
    const float* w_conv = F.in[14]; const float* b_conv = F.in[15]; const float* b_ra = F.in[17]; const float* b_rx = F.in[19]; const float* lam = F.in[20];
    LAS unsigned char* lds = F.lds;
    __syncthreads();
    { const v4u* WG = (const v4u*)(F.ws + WS_WG) + ((size_t)(nblk * 16 + 2 * cs) * 16) * 64;
#pragma unroll
      for (int k = 0; k < 4; ++k) { const int idx = tid + 512 * k; *(LAS v4u*)(lds + RG_BF + idx * 16) = WG[idx]; } }
    const int col = lane & 31, isI = (col >> 4) & 1, chl = 16 * wn + (col & 15), chb = 32 * cs + chl, chg = nblk * 256 + chb;
    const float gbias = isI ? b_rx[chg] : b_ra[chg]; const float sp = softplus_neg(lam[chg]);
    const int co = tid & 31, rs = tid >> 5;
    const int sch = tid & 31, sj = tid >> 5;
    if (tid < 32) ((LAS float*)(lds + RG_HP))[tid] = 0.f;
    const size_t rowb = (size_t)b * SEQ;
    const int och = nblk * 256 + 32 * cs + sch;
    const bf16* xsrc = (const bf16*)(F.ws + WS_XC) + (rowb + 8 * rs) * DM + nblk * 256 + 8 * co;
    v4u raw[8];
#pragma unroll
    for (int r = 0; r < 8; ++r) raw[r] = *(const GAS v4u*)(xsrc + (size_t)r * DM);
    for (int tile = 0; tile < SEQ / 128; ++tile) {
        const int t0 = tile * 128;
#pragma unroll
        for (int r = 0; r < 8; ++r) *(LAS v4u*)(lds + RG_XC + (8 * rs + r) * RG_XROW + (co << 4)) = raw[r];
        if (tile + 1 < SEQ / 128) {
#pragma unroll
            for (int r = 0; r < 8; ++r) raw[r] = *(const GAS v4u*)(xsrc + (size_t)(t0 + 128 + r) * DM);
        }
        const size_t orow = rowb + t0 + 8 * sj;
        const size_t pa_off = (rowb + t0 + (tid >> 2)) * DM + nblk * 256 + 32 * cs + 8 * (tid & 3);
        const v4u sg4 = *(const GAS v4u*)(SGA + pa_off);
        __syncthreads();
        f32x16 acc0 = {}, acc1 = {};
        { const int row = 32 * wm + (lane & 31), hi = lane >> 5;
#pragma unroll
          for (int s2 = 0; s2 < 16; s2 += 2) {
              const bf16x8 a0 = *(const LAS bf16x8*)(lds + RG_XC + row * RG_XROW + ((2 * s2 + hi) << 4));
              const bf16x8 a1 = *(const LAS bf16x8*)(lds + RG_XC + row * RG_XROW + ((2 * s2 + 2 + hi) << 4));
              const bf16x8 b0 = *(const LAS bf16x8*)(lds + RG_BF + ((wn * 16 + s2) * 64 + lane) * 16);
              const bf16x8 b1 = *(const LAS bf16x8*)(lds + RG_BF + ((wn * 16 + s2 + 1) * 64 + lane) * 16);
              acc0 = __builtin_amdgcn_mfma_f32_32x32x16_bf16(a0, b0, acc0, 0, 0, 0);
              acc1 = __builtin_amdgcn_mfma_f32_32x32x16_bf16(a1, b1, acc1, 0, 0, 0); } }
        { const int hi = lane >> 5;
          float g[16];
#pragma unroll
          for (int i = 0; i < 16; ++i) g[i] = sigmoidf_(acc0[i] + acc1[i] + gbias);
          float rcv[8];
#pragma unroll
          for (int k = 0; k < 8; ++k) { const float snd = isI ? g[k] : g[8 + k]; rcv[k] = __shfl_xor(snd, 16); }
#pragma unroll
          for (int k = 0; k < 8; ++k) { const int i = isI ? (8 + k) : k; const float rr = isI ? rcv[k] : g[k], ii = isI ? g[8 + k] : rcv[k];
              const int tok = 32 * wm + (i & 3) + 8 * (i >> 2) + 4 * hi;
              const unsigned short xb = *(const LAS unsigned short*)(lds + RG_XC + tok * RG_XROW + chb * 2);
              float a, u; gate_au(rr, ii, bf2f(xb), sp, a, u);
              *(LAS f32x2*)(lds + RG_AU + (tok * 32 + chl) * 8) = (f32x2){a, u}; } }
        __syncthreads();
        { float av[8], uv[8];
#pragma unroll
          for (int k = 0; k < 8; ++k) { const f32x2 t = *(const LAS f32x2*)(lds + RG_AU + ((8 * sj + k) * 32 + sch) * 8); av[k] = t.x; uv[k] = t.y; }
          float A = 1.f, H = 0.f;
#pragma unroll
          for (int k = 0; k < 8; ++k) { H = av[k] * H + uv[k]; A *= av[k]; }
          *(LAS f32x2*)(lds + RG_CAR + (sj * 32 + sch) * 8) = (f32x2){A, H};
          __syncthreads();
          float h = ((const LAS float*)(lds + RG_HP))[(tile & 1) * 32 + sch];
#define RG_CARRY(NG_) do { f32x2 cc_[4 * (NG_)]; \
              _Pragma("unroll") for (int jj = 0; jj < 4 * (NG_); ++jj) cc_[jj] = *(const LAS f32x2*)(lds + RG_CAR + (jj * 32 + sch) * 8); \
              _Pragma("unroll") for (int jj = 0; jj < 4 * (NG_); ++jj) { const float hn_ = cc_[jj].x * h + cc_[jj].y; h = (jj < sj) ? hn_ : h; } } while (0)
          if (w < 2) RG_CARRY(1); else if (w < 4) RG_CARRY(2); else if (w < 6) RG_CARRY(3); else RG_CARRY(4);
#undef RG_CARRY
#pragma unroll
          for (int k = 0; k < 8; ++k) { h = av[k] * h + uv[k]; ((LAS float*)(lds + RG_HB))[(8 * sj + k) * 32 + sch] = h; }
          if (sj == 15) { ((LAS float*)(lds + RG_HP))[((tile + 1) & 1) * 32 + sch] = h;
              if (tile == SEQ / 128 - 1) F.out[O_LP + (size_t)b * DM + och] = h; }
          __syncthreads();
          { const LAS f32x4* hb = (const LAS f32x4*)(lds + RG_HB + ((tid >> 2) * 32 + 8 * (tid & 3)) * 4); const f32x4 h0 = hb[0], h1 = hb[1];
            v4u o; o.x = pk2(h0.x * BF_LO(sg4.x), h0.y * BF_HI(sg4.x)); o.y = pk2(h0.z * BF_LO(sg4.y), h0.w * BF_HI(sg4.y));
            o.z = pk2(h1.x * BF_LO(sg4.z), h1.y * BF_HI(sg4.z)); o.w = pk2(h1.z * BF_LO(sg4.w), h1.w * BF_HI(sg4.w));
            *(GAS v4u*)(PA + pa_off) = o; }
        }
    }
    __syncthreads();
}
__device__ __forceinline__ void p2_rglru_sample_unit(Frame& F, int unit) {
    const int tid = F.tid, b = unit >> 2, blk = unit & 3, chb = tid & 255, kh = tid >> 8, ch = blk * 256 + chb;
    const float* sconv = F.in[5] + (size_t)b * 3 * DM; const float* h0 = F.in[6] + (size_t)b * DM;
    const float* w_conv = F.in[14]; const float* b_conv = F.in[15]; const float* w_ra = F.in[16]; const float* b_ra = F.in[17]; const float* w_rx = F.in[18]; const float* b_rx = F.in[19]; const float* lam = F.in[20];
    const float* xa = F.out + O_CS + (size_t)b * 3 * DM + 2 * DM;
    const bf16* SGA = (const bf16*)(F.ws + WS_SGA); bf16* PA = (bf16*)(F.ws + WS_PA);
    LAS float* xc = (LAS float*)F.lds;
    LAS float* part = xc + 256;
    __syncthreads();
    if (tid < 256) { const int c = blk * 256 + tid;
        xc[tid] = b_conv[c] + w_conv[c] * sconv[c] + w_conv[DM + c] * sconv[DM + c] + w_conv[2 * DM + c] * sconv[2 * DM + c] + w_conv[3 * DM + c] * xa[c]; }
    __syncthreads();
    float ar = 0.f, ai = 0.f;
    { const float* wr = w_ra + (size_t)blk * 65536 + (size_t)(128 * kh) * 256 + chb; const float* wx = w_rx + (size_t)blk * 65536 + (size_t)(128 * kh) * 256 + chb;
      const LAS float* xk = xc + 128 * kh;
#pragma unroll 32
      for (int k = 0; k < 128; ++k) { const float x = xk[k]; ar = fmaf(x, wr[(size_t)k * 256], ar); ai = fmaf(x, wx[(size_t)k * 256], ai); } }
    if (kh == 1) { part[chb] = ar; part[256 + chb] = ai; }
    __syncthreads();
    if (kh == 0) {
        ar = (b_ra[ch] + ar) + part[chb]; ai = (b_rx[ch] + ai) + part[256 + chb];
        float a, u; gate_au(sigmoidf_(ar), sigmoidf_(ai), xc[chb], softplus_neg(lam[ch]), a, u);
        const float h = a * h0[ch] + u;
        F.out[O_LS + (size_t)b * DM + ch] = h;
        PA[(size_t)(MP + b) * DM + ch] = (bf16)f2bf(h * bf2f(SGA[(size_t)(MP + b) * DM + ch]));
    }
    __syncthreads();
}
__device__ __forceinline__ void p2_rglru(Frame& F, int nrep) {
    for (int u = F.vcu; u < NBATCH * 32 * nrep; u += F.G) p2_rglru_prompt_unit(F, u & (NBATCH * 32 - 1));
}


constexpr int IX_SC = 0, IX_BITS = 131072, IX_END = IX_BITS + 16384;
constexpr int TOPK = 256;
__device__ __forceinline__ float next_up(float x) { unsigned u = __float_as_uint(x); if (x == 0.f) return __uint_as_float(1u); u = (x > 0.f) ? u + 1u : u - 1u; return __uint_as_float(u); }
__device__ __forceinline__ float next_down(float x) { return -next_up(-x); }
__device__ __forceinline__ float wave_min_f(float v) {
#pragma unroll
    for (int o = 1; o < 64; o <<= 1) v = fminf(v, __shfl_xor(v, o));
    return v; }
__device__ __forceinline__ float wave_max_f(float v) {
#pragma unroll
    for (int o = 1; o < 64; o <<= 1) v = fmaxf(v, __shfl_xor(v, o));
    return v; }
template <int L> __device__ __forceinline__ unsigned wlane(unsigned val, unsigned old) { asm volatile("s_nop 1\n\tv_writelane_b32 %0, %1, %2" : "+v"(old) : "s"(val), "n"(L)); return old; }
#define WL64(bl_, L_) do { const unsigned long long b__ = (bl_); mlo = wlane<(L_)>((unsigned)b__, mlo); mhi = wlane<(L_)>((unsigned)(b__ >> 32), mhi); } while (0)
#define REP16(M, B) M(B + 0) M(B + 1) M(B + 2) M(B + 3) M(B + 4) M(B + 5) M(B + 6) M(B + 7) M(B + 8) M(B + 9) M(B + 10) M(B + 11) M(B + 12) M(B + 13) M(B + 14) M(B + 15)
__device__ __forceinline__ int wave_sum_i_dpp(int x) {
    x += __builtin_amdgcn_update_dpp(0, x, 0xB1, 0xf, 0xf, true);
    x += __builtin_amdgcn_update_dpp(0, x, 0x4E, 0xf, 0xf, true);
    x += __builtin_amdgcn_update_dpp(0, x, 0x141, 0xf, 0xf, true);
    x += __builtin_amdgcn_update_dpp(0, x, 0x140, 0xf, 0xf, true);
    return __builtin_amdgcn_readlane(x, 0) + __builtin_amdgcn_readlane(x, 16) + __builtin_amdgcn_readlane(x, 32) + __builtin_amdgcn_readlane(x, 48);
}
#define DPP_F(x_, ctrl_) __int_as_float(__builtin_amdgcn_update_dpp(0, __float_as_int(x_), ctrl_, 0xf, 0xf, true))
__device__ __forceinline__ float wave_sum_f_dpp(float x) {
    x += DPP_F(x, 0xB1); x += DPP_F(x, 0x4E); x += DPP_F(x, 0x141); x += DPP_F(x, 0x140);
    return __int_as_float(__builtin_amdgcn_readlane(__float_as_int(x), 0)) + __int_as_float(__builtin_amdgcn_readlane(__float_as_int(x), 16))
         + __int_as_float(__builtin_amdgcn_readlane(__float_as_int(x), 32)) + __int_as_float(__builtin_amdgcn_readlane(__float_as_int(x), 48));
}
__device__ __forceinline__ float wave_max_f_dpp(float x) {
    x = fmaxf(x, DPP_F(x, 0xB1)); x = fmaxf(x, DPP_F(x, 0x4E)); x = fmaxf(x, DPP_F(x, 0x141)); x = fmaxf(x, DPP_F(x, 0x140));
    return fmaxf(fmaxf(__int_as_float(__builtin_amdgcn_readlane(__float_as_int(x), 0)), __int_as_float(__builtin_amdgcn_readlane(__float_as_int(x), 16))),
                 fmaxf(__int_as_float(__builtin_amdgcn_readlane(__float_as_int(x), 32)), __int_as_float(__builtin_amdgcn_readlane(__float_as_int(x), 48))));
}
__device__ __forceinline__ float wave_min_f_dpp(float x) {
    x = fminf(x, DPP_F(x, 0xB1)); x = fminf(x, DPP_F(x, 0x4E)); x = fminf(x, DPP_F(x, 0x141)); x = fminf(x, DPP_F(x, 0x140));
    return fminf(fminf(__int_as_float(__builtin_amdgcn_readlane(__float_as_int(x), 0)), __int_as_float(__builtin_amdgcn_readlane(__float_as_int(x), 16))),
                 fminf(__int_as_float(__builtin_amdgcn_readlane(__float_as_int(x), 32)), __int_as_float(__builtin_amdgcn_readlane(__float_as_int(x), 48))));
}
#define CNT2(i_, acc_) do { f32x2 t_; asm("v_pk_fma_f32 %0, %1, %2, %3 clamp" : "=v"(t_) : "v"(v2[i_]), "v"(big2), "v"(nb2)); acc_ += t_; } while (0)
#define CNT8(b_) CNT2(b_ + 0, a0); CNT2(b_ + 1, a1); CNT2(b_ + 2, a2); CNT2(b_ + 3, a3); CNT2(b_ + 4, a0); CNT2(b_ + 5, a1); CNT2(b_ + 6, a2); CNT2(b_ + 7, a3)
__device__ __forceinline__ int count_gt(const f32x2 (&v2)[32], float mid, int chunks) {
    const float BIG = 0x1p100f;
    const f32x2 big2 = {BIG, BIG}, nb2 = {-mid * BIG, -mid * BIG};
    f32x2 a0 = {0.f, 0.f}, a1 = {0.f, 0.f}, a2 = {0.f, 0.f}, a3 = {0.f, 0.f};
    CNT8(0);
    if (chunks > 1) { CNT8(8); }
    if (chunks > 2) { CNT8(16); }
    if (chunks > 3) { CNT8(24); }
    const f32x2 a = (a0 + a1) + (a2 + a3);
    return (int)wave_sum_f_dpp(a.x + a.y);
}
__device__ __forceinline__ void p3a_prompt_unit(Frame& F, int b, int qblk) {
    const int lane = F.lane, w = F.wave;
    LAS unsigned char* lds = F.lds;
    const bf16* QI = (const bf16*)(F.ws + WS_QI); const bf16* KI = (const bf16*)(F.ws + WS_KI); const float* WI = (const float*)(F.ws + WS_WI);
    const size_t rowb = (size_t)b * SEQ;
    const int nkt = qblk + 1;
    const float NEG = -__builtin_inff();
    { const int k0 = nkt * 32, k1 = (((qblk * 32 + 31) >> 10) + 1) * 1024;
      for (int idx = F.tid; idx < 8 * (k1 - k0); idx += NTHR) { const int q = idx / (k1 - k0), k = k0 + idx % (k1 - k0); *(LAS float*)(lds + IX_SC + (q * 4096 + k) * 4) = NEG; } }
#define IX_SCORES_LOAD(s_) do { const int qq0 = qblk * 32 + 8 * (s_); if (qq0 + 7 >= TOPK) { \
        const int rho = lane & 31, hi = lane >> 5; \
        const int ql = 2 * (rho >> 4) + ((rho >> 2) & 1), head = 4 * ((rho >> 3) & 1) + (rho & 3); \
        _Pragma("unroll") for (int mt = 0; mt < 2; ++mt) _Pragma("unroll") for (int s4 = 0; s4 < 4; ++s4) { v4u t = *(const GAS v4u*)(QI + (rowb + qq0 + 4 * mt + ql) * 512 + head * 64 + 16 * s4 + 8 * hi); qa[mt][s4] = *reinterpret_cast<bf16x8*>(&t); } \
        wqv = WI[(rowb + qq0) * 8 + lane]; \
        const bf16* kbase = KI + (rowb + (lane & 31)) * 64 + 8 * hi; \
        if (w < nkt) IX_LOADK(k0, w); } } while (0)
#define IX_SCORES_RUN(s_) do { const int qq0 = qblk * 32 + 8 * (s_); if (qq0 + 7 >= TOPK) { \
        const int hi = lane >> 5; \
        LAS float* wql = (LAS float*)(lds + IX_END) + w * 64;     \
        wql[lane] = wqv; \
        const bf16* kbase = KI + (rowb + (lane & 31)) * 64 + 8 * hi; \
        int kt = w; \
        while (kt < nkt) { IX_COMPUTE(k0, kt); kt += 8; } } } while (0)
#define IX_LOADK(dst, kt_) do { _Pragma("unroll") for (int s4 = 0; s4 < 4; ++s4) { v4u t_ = *(const GAS v4u*)(kbase + (size_t)(kt_) * 2048 + 16 * s4); dst[s4] = *reinterpret_cast<bf16x8*>(&t_); } } while (0)
#define IX_COMPUTE(kb_, kt_) do { const int key = (kt_) * 32 + (lane & 31); f32x16 accs[2] = {}; \
                _Pragma("unroll") for (int mt = 0; mt < 2; ++mt) \
                    _Pragma("unroll") for (int s4 = 0; s4 < 4; ++s4) accs[mt] = __builtin_amdgcn_mfma_f32_32x32x16_bf16(qa[mt][s4], kb_[s4], accs[mt], 0, 0, 0); \
                if ((kt_) + 8 < nkt) IX_LOADK(kb_, (kt_) + 8);     \
                _Pragma("unroll") for (int mt = 0; mt < 2; ++mt) { const f32x16 acc = accs[mt]; \
                    _Pragma("unroll") for (int g = 0; g < 2; ++g) { float sc = 0.f; const f32x4 wa = *(const LAS f32x4*)(wql + (4 * mt + 2 * g + hi) * 8), wb = *(const LAS f32x4*)(wql + (4 * mt + 2 * g + hi) * 8 + 4); \
                        sc = fmaf(wa.x, fmaxf(acc[8 * g + 0], 0.f), sc); sc = fmaf(wa.y, fmaxf(acc[8 * g + 1], 0.f), sc); sc = fmaf(wa.z, fmaxf(acc[8 * g + 2], 0.f), sc); sc = fmaf(wa.w, fmaxf(acc[8 * g + 3], 0.f), sc); \
                        sc = fmaf(wb.x, fmaxf(acc[8 * g + 4], 0.f), sc); sc = fmaf(wb.y, fmaxf(acc[8 * g + 5], 0.f), sc); sc = fmaf(wb.z, fmaxf(acc[8 * g + 6], 0.f), sc); sc = fmaf(wb.w, fmaxf(acc[8 * g + 7], 0.f), sc); \
                        const int qloc = 4 * mt + 2 * g + hi; if (key > qq0 + qloc) sc = NEG; \
                        *(LAS float*)(lds + IX_SC + (qloc * 4096 + key) * 4) = sc; } } } while (0)
#define IX_SELECT() do { \
        if (t + 1 <= TOPK) { \
            WL64(__ballot(lane <= t), 0); WL64(__ballot(lane <= t - 64), 1); WL64(__ballot(lane <= t - 128), 2); WL64(__ballot(lane <= t - 192), 3); \
        } else { \
            float mx = NEG; \
            _Pragma("unroll") for (int i = 0; i < 32; i += 2) mx = fmaxf(fmaxf(v2[i].x, v2[i].y), fmaxf(fmaxf(v2[i + 1].x, v2[i + 1].y), mx)); \
            float mn = fminf(fminf(v2[0].x, v2[0].y), fminf(v2[1].x, v2[1].y)); mn = fminf(mn, (v2[2].x == NEG) ? __builtin_inff() : v2[2].x); \
            float lo = next_down(wave_min_f_dpp(mn)), hi = wave_max_f_dpp(mx); \
            int c_hi = 0; float T = hi, E = hi; int need = 0; \
            for (int it = 0; it < 400; ++it) { \
                const float mid = 0.5f * lo + 0.5f * hi; \
                if (!(mid > lo && mid < hi)) { T = hi; E = hi; need = TOPK - c_hi; break; } \
                const int c = count_gt(v2, mid, chunks); \
                if (c == TOPK) { T = mid; need = 0; break; } \
                if (c > TOPK) lo = mid; else { hi = mid; c_hi = c; } \
            } \
            if (need == 0) { \
                REP16(SELT, 0) \
                if (chunks > 1) { REP16(SELT, 16) } \
                if (chunks > 2) { REP16(SELT, 32) } \
                if (chunks > 3) { REP16(SELT, 48) } \
            } else { \
                REP16(SELTIE, 0) REP16(SELTIE, 16) REP16(SELTIE, 32) REP16(SELTIE, 48) \
            } \
        } } while (0)
#define SELV(r) (((r) & 1) ? v2[(r) >> 1].y : v2[(r) >> 1].x)
#define SELT(r) WL64(__ballot(SELV(r) > T), (r));
#define SELTIE(r) { const float vr_ = SELV(r); unsigned long long bl_ = __ballot(vr_ > T); const unsigned long long eq_ = __ballot(vr_ == E); const int ce_ = __popcll(eq_); \
        if (need > 0 && ce_ > 0) { const int pre_ = __builtin_amdgcn_mbcnt_hi((unsigned)(eq_ >> 32), __builtin_amdgcn_mbcnt_lo((unsigned)eq_, 0u)); \
            bl_ |= __ballot(vr_ == E && pre_ < need); need = (ce_ >= need) ? 0 : need - ce_; } WL64(bl_, (r)); }
    bf16x8 qa[2][4]; bf16x8 k0[4]; float wqv = 0.f;
    IX_SCORES_LOAD(0); IX_SCORES_RUN(0);
    __syncthreads();
#pragma unroll 1
    for (int s = 0; s < 4; ++s) {
        const int t = qblk * 32 + 8 * s + w;
        const int chunks = (t >> 10) + 1;
        f32x2 v2[32];
        if (t + 1 > TOPK) {
            const LAS float* scb = (const LAS float*)(lds + IX_SC) + w * 4096 + lane;
#define LD8(b_) _Pragma("unroll") for (int i = (b_); i < (b_) + 8; ++i) { v2[i].x = scb[128 * i]; v2[i].y = scb[128 * i + 64]; }
#define NG8(b_) _Pragma("unroll") for (int i = (b_); i < (b_) + 8; ++i) { v2[i].x = NEG; v2[i].y = NEG; }
            LD8(0)
            if (chunks > 1) { LD8(8) } else { NG8(8) }
            if (chunks > 2) { LD8(16) } else { NG8(16) }
            if (chunks > 3) { LD8(24) } else { NG8(24) }
#undef LD8
#undef NG8
        } else {
#pragma unroll
            for (int i = 0; i < 32; ++i) { v2[i].x = NEG; v2[i].y = NEG; }
        }
        __syncthreads();
        unsigned mlo = 0u, mhi = 0u;
        if (s < 3) IX_SCORES_LOAD(s + 1);
        if (w < 4) { IX_SELECT(); if (s < 3) IX_SCORES_RUN(s + 1); }
        else       { if (s < 3) IX_SCORES_RUN(s + 1); IX_SELECT(); }
        *(LAS unsigned long long*)(lds + IX_BITS + ((8 * s + w) * 64 + lane) * 8) = ((unsigned long long)mhi << 32) | mlo;
        __syncthreads();
    }
#undef IX_SCORES_LOAD
#undef IX_SCORES_RUN
#undef IX_LOADK
#undef IX_COMPUTE
#undef IX_SELECT
#undef SELV
#undef SELT
#undef SELTIE
    {
        unsigned long long* MSK = (unsigned long long*)(F.ws + WS_MSK) + ((size_t)(b * 128 + qblk) * 64) * 32;
        const int ntile = 4 * (qblk >> 3) + 4;
        const int r32 = lane & 31, hi = lane >> 5;
        for (int j = w; j < ntile; j += NWAVES) {
            const unsigned long long wd = *(const LAS unsigned long long*)(lds + IX_BITS + (r32 * 64 + j) * 8) >> (4 * hi);
            unsigned mlo = 0u, mhi = 0u;
#define TRB(k) WL64(__ballot((wd >> (32 * ((k) >> 4) + ((k) & 3) + 8 * (((k) & 15) >> 2))) & 1ull), (k));
            REP16(TRB, 0) REP16(TRB, 16)
#undef TRB
            if (lane < 32) MSK[(size_t)j * 32 + lane] = ((unsigned long long)mhi << 32) | mlo;
        }
    }
    __syncthreads();
}
__device__ __forceinline__ void p3a_sample_unit(Frame& F, const int* page_table, int b, int chunk) {
    const int tid = F.tid;
    LAS float* qs = (LAS float*)F.lds;
    const bf16* QI = (const bf16*)(F.ws + WS_QI); const float* WI = (const float*)(F.ws + WS_WI); const float* cidx = F.in[4];
    float* SSC = (float*)(F.ws + WS_SSC);
    __syncthreads();
    qs[tid] = bf2f(QI[(size_t)(MP + b) * 512 + tid]);
    __syncthreads();
    if (tid < 8) qs[512 + tid] = WI[(size_t)(MP + b) * 8 + tid];
    __syncthreads();
#pragma unroll 1
    for (int e = 0; e < 2; ++e) {
        const int key = chunk * 1024 + e * 512 + tid;
        const int phys = page_table[b * NPG + (key >> 7)];
        const f32x4* kr = (const f32x4*)(cidx + ((size_t)phys * PAGE + (key & 127)) * 64);
        f32x4 kv[16];
#pragma unroll
        for (int d4 = 0; d4 < 16; ++d4) kv[d4] = kr[d4];
        float sc = 0.f;
#pragma unroll 1
        for (int h = 0; h < 8; ++h) { float sh = 0.f;
#pragma unroll
            for (int d4 = 0; d4 < 16; ++d4) { const f32x4 q4 = *(const LAS f32x4*)(qs + h * 64 + 4 * d4); sh = fmaf(q4.x, kv[d4].x, fmaf(q4.y, kv[d4].y, fmaf(q4.z, kv[d4].z, fmaf(q4.w, kv[d4].w, sh)))); }
            sc = fmaf(qs[512 + h], fmaxf(sh, 0.f), sc); asm volatile("" ::: "memory"); }
        __hip_atomic_store(SSC + (size_t)b * 16400 + key, sc, __ATOMIC_RELAXED, __HIP_MEMORY_SCOPE_AGENT);
    }
    asm volatile("s_waitcnt vmcnt(0)" ::: "memory");
    __syncthreads();
    if (tid == 0) __hip_atomic_fetch_add((unsigned*)(F.ws + WS_CTL) + CW_PANEL + 64 * (129 + b), 1u, __ATOMIC_RELAXED, __HIP_MEMORY_SCOPE_AGENT);
}
__device__ __forceinline__ void p3a_indexer(Frame& F, const int* page_table) {
    { const int nsk = (F.G > 64) ? 32 : 0;
      if (F.vcu >= nsk) for (int u = F.vcu - nsk; u < NS * 16; u += F.G - nsk) p3a_sample_unit(F, page_table, u >> 4, u & 15); }
    for (int i = blockIdx.x; i < 1024; i += F.G) { const int slot = i >> 8, v = i & 255, b = v & 7, j = v >> 3;
        const int qblk = (slot == 0) ? j : (slot == 1) ? 63 - j : (slot == 2) ? 64 + j : 127 - j;
        p3a_prompt_unit(F, b, qblk); }
}


namespace att {
constexpr float SCALE = 0.08838834764831845f;
constexpr int NW = 8, QBLK = 32, KVBLK = 64, QB = NW * QBLK, D = 128;
constexpr int SHM_V = KVBLK * D * 2, SHM_K = KVBLK * D * 2;
constexpr int LDS_ATT = 2 * SHM_V + 2 * SHM_K + NW * 64 * 4;
constexpr float THR = 8.f;
constexpr int QS = 1024, KS = 256, OS = 1024;
constexpr int OST_OFF = 81920;
typedef short s16x4 __attribute__((ext_vector_type(4)));
typedef unsigned u32x4 __attribute__((ext_vector_type(4)));
#define KSWZ(row, colB) ((row) * 256 + ((colB) ^ (((row) & 7) << 4)))
#define SBAR() __builtin_amdgcn_sched_barrier(0)
__device__ __forceinline__ int v_st(int k, int c) { const int kk = (k & ~0xC) | ((k & 4) << 1) | ((k & 8) >> 1); return ((kk >> 3) * 4 + (c >> 5)) * 512 + ((kk & 7) * 32 + (c & 31)) * 2; }
__device__ __forceinline__ int v_rd_base(int lane) { return ((lane & 3) << 3) | (((lane >> 2) & 3) << 6) | (((lane >> 4) & 1) << 5) | (((lane >> 5) & 1) << 8); }
constexpr int v_rd_off(int d0, int ks, int half) { return d0 * 512 + ks * 4096 + half * 2048; }
__device__ __forceinline__ int crow(int r, int hi) { return (r & 3) + 8 * (r >> 2) + 4 * hi; }
__device__ __forceinline__ unsigned cvtpk(float lo, float hi) { unsigned r; asm volatile("v_cvt_pk_bf16_f32 %0, %1, %2" : "=v"(r) : "v"(lo), "v"(hi)); return r; }
__device__ __forceinline__ bf16x8 load8(const bf16* p) { return *reinterpret_cast<const bf16x8*>(p); }
typedef unsigned long long u64x8 __attribute__((ext_vector_type(8)));
struct TileMasks { u64x8 a, b, c, d; };
__device__ __forceinline__ void mask_load(TileMasks& M, const unsigned long long* mwg) {
    const unsigned long long pm = (unsigned long long)(uintptr_t)mwg;
    const unsigned plo = __builtin_amdgcn_readfirstlane((unsigned)pm), phi = __builtin_amdgcn_readfirstlane((unsigned)(pm >> 32));
    const unsigned long long pu = ((unsigned long long)phi << 32) | plo;
    asm volatile("s_load_dwordx16 %0, %4, 0x0\n\ts_load_dwordx16 %1, %4, 0x40\n\ts_load_dwordx16 %2, %4, 0x80\n\ts_load_dwordx16 %3, %4, 0xc0"
                 : "=&s"(M.a), "=&s"(M.b), "=&s"(M.c), "=&s"(M.d) : "s"(pu) : "memory");
}
__device__ __forceinline__ void mask_apply(f32x16& p0, f32x16& p1, TileMasks& M) {
    const float NEG = -__builtin_inff();
    asm volatile("s_waitcnt lgkmcnt(0)" : "+s"(M.a), "+s"(M.b), "+s"(M.c), "+s"(M.d) :: "memory");
#pragma unroll
    for (int r = 0; r < 16; ++r) {
        const unsigned long long m0 = (r < 8) ? M.a[r & 7] : M.b[r & 7], m1 = (r < 8) ? M.c[r & 7] : M.d[r & 7];
        float a = p0[r], b = p1[r];
        asm volatile("v_cndmask_b32_e64 %0, %1, %0, %2" : "+v"(a) : "v"(NEG), "s"(m0));
        asm volatile("v_cndmask_b32_e64 %0, %1, %0, %2" : "+v"(b) : "v"(NEG), "s"(m1));
        p0[r] = a; p1[r] = b;
    }
}
__device__ __forceinline__ void partialSM(f32x16& p0, f32x16& p1, float& m_reg, float& mn, float& alpha) {
    float pmax = p0[0]; for (int r = 1; r < 16; ++r) pmax = fmaxf(pmax, p0[r]); for (int r = 0; r < 16; ++r) pmax = fmaxf(pmax, p1[r]);
    { auto rr = __builtin_amdgcn_permlane32_swap(__float_as_uint(pmax), __float_as_uint(pmax), false, false);
      pmax = fmaxf(__uint_as_float(rr[0]), __uint_as_float(rr[1])); }
    constexpr float C2 = 1.4426950408889634f * SCALE;
    if (__builtin_expect(__all((pmax - m_reg) * SCALE <= THR), 1)) { mn = m_reg; alpha = 1.f; }
    else { mn = fmaxf(m_reg, pmax); alpha = __builtin_amdgcn_exp2f((m_reg - mn) * C2); m_reg = mn; }
    const float mnL = -mn * C2;
    for (int r = 0; r < 16; ++r) p0[r] = fmaf(p0[r], C2, mnL); for (int r = 0; r < 16; ++r) p1[r] = fmaf(p1[r], C2, mnL);
    for (int r = 0; r < 16; ++r) p0[r] = __builtin_amdgcn_exp2f(p0[r]);
}
__device__ __forceinline__ void finishSM(f32x16& p0, f32x16& p1, float alpha, float& l_reg, bf16x8& pa0, bf16x8& pa1, bf16x8& pa2, bf16x8& pa3) {
    for (int r = 0; r < 16; ++r) p1[r] = __builtin_amdgcn_exp2f(p1[r]);
    float ps = 0; for (int r = 0; r < 16; ++r) ps += p0[r]; for (int r = 0; r < 16; ++r) ps += p1[r];
    { auto rr = __builtin_amdgcn_permlane32_swap(__float_as_uint(ps), __float_as_uint(ps), false, false);
      ps = __uint_as_float(rr[0]) + __uint_as_float(rr[1]); }
    l_reg = l_reg * alpha + ps;
#define PK4(P, B_, OUT) do { unsigned a0 = cvtpk(P[B_+0], P[B_+1]), a1 = cvtpk(P[B_+2], P[B_+3]);                          \
        unsigned b0 = cvtpk(P[B_+4], P[B_+5]), b1 = cvtpk(P[B_+6], P[B_+7]);                                             \
        auto r0 = __builtin_amdgcn_permlane32_swap(a0, b0, false, false); auto r1 = __builtin_amdgcn_permlane32_swap(a1, b1, false, false); \
        u32x4 w = {r0[0], r1[0], r0[1], r1[1]}; OUT = *reinterpret_cast<bf16x8*>(&w); } while (0)
    PK4(p0, 0, pa0); PK4(p0, 8, pa1); PK4(p1, 0, pa2); PK4(p1, 8, pa3);
#undef PK4
}
template <int KB>
__device__ __forceinline__ void qkt(f32x16& p0, f32x16& p1, const char* K_lds, int r32, int hi, const bf16x8* qr) {
    p0 = f32x16{}; p1 = f32x16{};
    const char* kb[4];
#pragma unroll
    for (int dd = 0; dd < 4; ++dd) kb[dd] = K_lds + KB * SHM_K + KSWZ(r32, (dd * 16 + hi * 8) * 2);
#pragma unroll
    for (int d0 = 0; d0 < 8; ++d0) { const char* a = kb[d0 & 3] + (d0 >> 2) * 128;
        bf16x8 b0 = *reinterpret_cast<const bf16x8*>(a);
        bf16x8 b1 = *reinterpret_cast<const bf16x8*>(a + 32 * 256);
        p0 = __builtin_amdgcn_mfma_f32_32x32x16_bf16(b0, qr[d0], p0, 0, 0, 0);
        p1 = __builtin_amdgcn_mfma_f32_32x32x16_bf16(b1, qr[d0], p1, 0, 0, 0); }
}
template <int VB>
__device__ __forceinline__ void pv_tile(f32x16* o, int vb0, bf16x8 pa0, bf16x8 pa1, bf16x8 pa2, bf16x8 pa3) {
#define TRRD(dst, off) asm volatile("ds_read_b64_tr_b16 %0, %1 offset:%2" : "=&v"(dst) : "v"(vb0), "i"(off) : "memory")
#define PV_D0(d0) do { s16x4 l0, l1, l2, l3, h0, h1, h2, h3; constexpr int b_ = VB * SHM_V + v_rd_off(d0, 0, 0); \
        TRRD(l0, b_); TRRD(h0, b_ + 2048); TRRD(l1, b_ + 4096); TRRD(h1, b_ + 6144); TRRD(l2, b_ + 8192); TRRD(h2, b_ + 10240); TRRD(l3, b_ + 12288); TRRD(h3, b_ + 14336); \
        asm volatile("s_waitcnt lgkmcnt(0)" ::: "memory"); SBAR();   \
        o[d0] = __builtin_amdgcn_mfma_f32_32x32x16_bf16(pa0, (bf16x8){l0[0], l0[1], l0[2], l0[3], h0[0], h0[1], h0[2], h0[3]}, o[d0], 0, 0, 0);   \
        o[d0] = __builtin_amdgcn_mfma_f32_32x32x16_bf16(pa1, (bf16x8){l1[0], l1[1], l1[2], l1[3], h1[0], h1[1], h1[2], h1[3]}, o[d0], 0, 0, 0);   \
        o[d0] = __builtin_amdgcn_mfma_f32_32x32x16_bf16(pa2, (bf16x8){l2[0], l2[1], l2[2], l2[3], h2[0], h2[1], h2[2], h2[3]}, o[d0], 0, 0, 0);   \
        o[d0] = __builtin_amdgcn_mfma_f32_32x32x16_bf16(pa3, (bf16x8){l3[0], l3[1], l3[2], l3[3], h3[0], h3[1], h3[2], h3[3]}, o[d0], 0, 0, 0); } while (0)
    PV_D0(0); PV_D0(1); PV_D0(2); PV_D0(3);
#undef PV_D0
#undef TRRD
}
struct BlockRef { const bf16* Q; const bf16* K; const bf16* V; bf16* O; const bf16* G; const unsigned long long* M; int P0; };
struct Seam { bf16x8 qr[8]; bf16x8 st_v0, st_v1, st_k0, st_k1; };
#define ROWK(p, k0, rr) ((p) + (size_t)((k0) + (rr)) * KS + sc)
#define VMW() asm volatile("s_waitcnt vmcnt(0)" ::: "memory")
#define VMWN(n) asm volatile("s_waitcnt vmcnt(%0)" :: "i"(n) : "memory")
#define SLOAD_H(Kp, Vp, k0) do { S.st_v0 = load8(ROWK(Vp, k0, sr)); S.st_v1 = load8(ROWK(Vp, k0, 32 + sr));              \
                         S.st_k0 = load8(ROWK(Kp, k0, sr)); S.st_k1 = load8(ROWK(Kp, k0, 32 + sr)); } while (0)
#define SWRITE_HK(bf) do { *(bf16x8*)(K_lds + (bf) * SHM_K + kws) = S.st_k0; *(bf16x8*)(K_lds + (bf) * SHM_K + kws + 32 * 256) = S.st_k1; } while (0)
#define SWRITE_HV(bf) do { *(bf16x8*)(V_lds + (bf) * SHM_V + vst0) = S.st_v0; *(bf16x8*)(V_lds + (bf) * SHM_V + vst1) = S.st_v1; } while (0)
#define SWRITE_H(bf) do { SWRITE_HV(bf); SWRITE_HK(bf); } while (0)
__device__ __forceinline__ void attn_prime(const BlockRef& cur, char* lds, Seam& S) {
    const int tid = threadIdx.x, wid = __builtin_amdgcn_readfirstlane(tid >> 6), lane = tid & 63, r32 = lane & 31, hi = lane >> 5;
    const int sr = tid >> 4, sc = (tid & 15) * 8, kws = KSWZ(sr, sc * 2); char* K_lds = lds + 2 * SHM_V;
    for (int d0 = 0; d0 < 8; ++d0) S.qr[d0] = load8(cur.Q + (size_t)(wid * QBLK + r32) * QS + d0 * 16 + hi * 8);
    SLOAD_H(cur.K, cur.V, 0); VMW(); SWRITE_HK(0);
    __syncthreads();
}
__device__ __forceinline__ void attn_block(const BlockRef& cur, const BlockRef& nxt, char* lds, Seam& S) {
    const int tid = threadIdx.x, wid = __builtin_amdgcn_readfirstlane(tid >> 6), lane = tid & 63, r32 = lane & 31, hi = lane >> 5;
    const int NT = (cur.P0 + QB - 1) / KVBLK + 1;
    char* V_lds = lds; char* K_lds = lds + 2 * SHM_V;
    float* wsl = (float*)(lds + 2 * SHM_V + 2 * SHM_K) + wid * 64; float* li_l = wsl, * al_l = wsl + 32;
    float m_reg = -1e30f, l_reg = 0; f32x16 o[4] = {};
    const int sr = tid >> 4, sc = (tid & 15) * 8, vst0 = v_st(sr, sc), vst1 = v_st(32 + sr, sc), kws = KSWZ(sr, sc * 2);
    const int vb0 = (int)(uintptr_t)V_lds + v_rd_base(lane);
    const bf16* Kh = cur.K; const bf16* Vh = cur.V;
    const unsigned long long* Mw = cur.M + (size_t)wid * 64 * 32;
#define RESC(a) do { if (__any((a) < 1.f)) { if (hi == 0) al_l[r32] = (a); asm volatile("s_waitcnt lgkmcnt(0)" ::: "memory");              \
                     for (int d_ = 0; d_ < 4; ++d_) for (int r = 0; r < 16; ++r) o[d_][r] *= al_l[crow(r, hi)]; } } while (0)
#define KBASE(t) ((t) * KVBLK)
#define MASKL(t) mask_load(TM, Mw + (size_t)(t) * 32)
#define MASKT(P0_, P1_, t) mask_apply(P0_, P1_, TM)
    constexpr int NQL = 8;
#define SEAM_K0() do { VMWN(NQL); SWRITE_HK(0); SBAR(); } while (0)
    f32x16 pA0, pA1, pB0, pB1; float mnA, mnB, alA, alB; bf16x8 pa0, pa1, pa2, pa3; TileMasks TM;
    MASKL(0);
    SWRITE_HV(0); SBAR();
    if (NT > 1) { SLOAD_H(Kh, Vh, KBASE(1)); }
    SBAR(); qkt<0>(pA0, pA1, K_lds, r32, hi, S.qr);
    asm volatile("s_nop 15\n\ts_nop 7" : "+v"(pA0), "+v"(pA1));
    MASKT(pA0, pA1, 0); partialSM(pA0, pA1, m_reg, mnA, alA);
    if (NT > 1) { VMW(); SWRITE_H(1); }
    __syncthreads();
#define HALF_STEP(PX0, PX1, mnX, alX, PY0, PY1, alY, t, KB, VB, SB) do {                                                      \
        if ((t) + 1 < NT) { SLOAD_H(Kh, Vh, KBASE((t) + 1)); SBAR(); }     \
        MASKL(t); SBAR(); qkt<KB>(PX0, PX1, K_lds, r32, hi, S.qr);                                             \
        finishSM(PY0, PY1, alY, l_reg, pa0, pa1, pa2, pa3); SBAR();                                                           \
        pv_tile<VB>(o, vb0, pa0, pa1, pa2, pa3); MASKT(PX0, PX1, (t)); partialSM(PX0, PX1, m_reg, mnX, alX);                                        \
        __syncthreads();                                                                                                      \
        if ((t) + 1 < NT) { VMW(); SWRITE_H(SB); }                                                                          \
        RESC(alX); __syncthreads(); } while (0)
    for (int t = 1; t + 1 < NT; t += 2) {
        HALF_STEP(pB0, pB1, mnB, alB, pA0, pA1, alA, t, 1, 0, 0);
        HALF_STEP(pA0, pA1, mnA, alA, pB0, pB1, alB, t + 1, 0, 1, 1);
    }
    const bool even = (NT & 1) == 0;
    if (even) { MASKL(NT - 1); SBAR(); qkt<1>(pB0, pB1, K_lds, r32, hi, S.qr); SBAR(); }
    SLOAD_H(nxt.K, nxt.V, 0); SBAR();
#pragma unroll
    for (int d0 = 0; d0 < 8; ++d0) S.qr[d0] = load8(nxt.Q + (size_t)(wid * QBLK + r32) * QS + d0 * 16 + hi * 8);
    SBAR();
    finishSM(pA0, pA1, alA, l_reg, pa0, pa1, pa2, pa3); SBAR();
    pv_tile<0>(o, vb0, pa0, pa1, pa2, pa3);
    if (even) { MASKT(pB0, pB1, NT - 1); partialSM(pB0, pB1, m_reg, mnB, alB); __syncthreads(); RESC(alB);
        finishSM(pB0, pB1, alB, l_reg, pa0, pa1, pa2, pa3); SBAR(); pv_tile<1>(o, vb0, pa0, pa1, pa2, pa3); }
    SBAR(); SEAM_K0();
    if (hi == 0) li_l[r32] = l_reg; asm volatile("s_waitcnt lgkmcnt(0)" ::: "memory");
    float rli[16];
#pragma unroll
    for (int r = 0; r < 16; ++r) rli[r] = __builtin_amdgcn_rcpf(li_l[crow(r, hi)]);
    bf16* Ow = cur.O + (size_t)(wid * QBLK) * OS; const bf16* Gw = cur.G + (size_t)(wid * QBLK) * OS;
    { LAS unsigned short* ost = (LAS unsigned short*)((LAS unsigned char*)(uintptr_t)(unsigned)(uintptr_t)lds + OST_OFF + wid * 8192);
      v4u gvv[8];
#pragma unroll
      for (int k = 0; k < 8; ++k) gvv[k] = *(const v4u*)(Gw + (size_t)(4 * k + (lane >> 4)) * OS + (lane & 15) * 8);
#pragma unroll
      for (int r = 0; r < 16; ++r) { const int orow = crow(r, hi);
#pragma unroll
          for (int d0 = 0; d0 < 4; ++d0) ost[orow * 128 + d0 * 32 + r32] = (unsigned short)f2bf(o[d0][r] * rli[r]); }
      asm volatile("s_waitcnt lgkmcnt(0)" ::: "memory");
#pragma unroll
      for (int k = 0; k < 8; ++k) { const int row = 4 * k + (lane >> 4), ch = lane & 15;
          const v4u ov = *(const LAS v4u*)(ost + row * 128 + ch * 8);
          const v4u gv = gvv[k];
          v4u w;
          w.x = pk2(BF_LO(ov.x) * BF_LO(gv.x), BF_HI(ov.x) * BF_HI(gv.x)); w.y = pk2(BF_LO(ov.y) * BF_LO(gv.y), BF_HI(ov.y) * BF_HI(gv.y));
          w.z = pk2(BF_LO(ov.z) * BF_LO(gv.z), BF_HI(ov.z) * BF_HI(gv.z)); w.w = pk2(BF_LO(ov.w) * BF_LO(gv.w), BF_HI(ov.w) * BF_HI(gv.w));
          *(v4u*)(Ow + (size_t)row * OS + ch * 8) = w; }
      asm volatile("s_waitcnt lgkmcnt(0)" ::: "memory"); }
    __syncthreads();
#undef RESC
#undef KBASE
#undef MASKT
#undef MASKL
#undef SEAM_K0
#undef HALF_STEP
}
#undef ROWK
#undef VMW
#undef VMWN
#undef SLOAD_H
#undef SWRITE_HK
#undef SWRITE_HV
#undef SWRITE_H
#undef KSWZ
#undef SBAR
}

__device__ __forceinline__ att::BlockRef att_ref(Frame& F, int L, int pass) {
    const int b = L & 7, k = (L >> 3) & 63, h = k >> 3, x = k & 7, qb = pass ? 15 - x : x;
    const size_t row0 = (size_t)b * SEQ + (size_t)qb * 256;
    att::BlockRef r;
    r.Q = (const bf16*)(F.ws + WS_Q) + row0 * DM + h * 128; r.O = (bf16*)(F.ws + WS_PB) + row0 * DM + h * 128; r.G = (const bf16*)(F.ws + WS_SGB) + row0 * DM + h * 128;
    r.K = (const bf16*)(F.ws + WS_KB) + (size_t)b * SEQ * 256 + (h >> 2) * 128; r.V = (const bf16*)(F.ws + WS_VB) + (size_t)b * SEQ * 256 + (h >> 2) * 128;
    r.M = (const unsigned long long*)(F.ws + WS_MSK) + ((size_t)(b * 128 + qb * 8) * 64) * 32; r.P0 = qb * 256;
    return r;
}
__device__ __forceinline__ void p3b_attention(Frame& F, int nrep) {
    const int total = 512 * nrep, stride = F.G;
    int L = blockIdx.x; if (L >= total) return;
    int pass = 0;
    att::BlockRef cur = att_ref(F, L, 0);
    att::Seam S;
    att::attn_prime(cur, (char*)F.lds, S);
    for (;;) {
        const bool more_pass = (pass == 0), more_item = L + stride < total, last = !more_pass && !more_item;
        int passn = pass + 1, Ln = L;
        if (!more_pass) { passn = 0; Ln = more_item ? L + stride : L; }
        const att::BlockRef nxt = last ? cur : att_ref(F, Ln, passn);
        att::attn_block(cur, nxt, (char*)F.lds, S);
        if (last) break;
        cur = nxt; pass = passn; L = Ln;
    }
}


__device__ __forceinline__ void wait_count(unsigned* cnt, unsigned need) {
    unsigned sp = 0;
    while (__hip_atomic_load(cnt, __ATOMIC_RELAXED, __HIP_MEMORY_SCOPE_AGENT) < need) { __builtin_amdgcn_s_sleep(1); if (++sp > (1u << 22)) break; }
    __builtin_amdgcn_fence(__ATOMIC_ACQUIRE, "agent");
    asm volatile("s_waitcnt vmcnt(0)" ::: "memory");
}
constexpr int SM_Q = 0, SM_SEL = 4096, SM_CNT = SM_SEL + 1024, SM_S = 8192, SM_RED = SM_S + 8192, SM_ROW = SM_RED + 256, SM_PACC = SM_ROW + 1024, SM_END = SM_PACC + 32768;
__device__ __forceinline__ int block_sum_i(LAS int* red, int v, int wave, int lane, int& phase) {
    LAS int* slot = red + (phase & 1) * 8; phase ^= 1;
    if (lane == 0) slot[wave] = v;
    __syncthreads();
    int s = 0;
#pragma unroll
    for (int i = 0; i < 8; ++i) s += slot[i];
    return s;
}
__device__ __forceinline__ void p3b_sample_unit(Frame& F, const int* page_table, int b) {
    const int tid = F.tid, lane = F.lane, w = F.wave;
    LAS unsigned char* lds = F.lds;
    LAS float* qf = (LAS float*)(lds + SM_Q);
    LAS int* sel = (LAS int*)(lds + SM_SEL);
    LAS int* cntw = (LAS int*)(lds + SM_CNT);
    LAS float* Sb = (LAS float*)(lds + SM_S);
    LAS int* red = (LAS int*)(lds + SM_RED);
    const float NEG = -__builtin_inff();
    const bf16* Qb = (const bf16*)(F.ws + WS_Q) + (size_t)(MP + b) * DM; const bf16* QI = (const bf16*)(F.ws + WS_QI) + (size_t)(MP + b) * 512;
    const float* WI = (const float*)(F.ws + WS_WI) + (size_t)(MP + b) * 8; const float* SSC = (const float*)(F.ws + WS_SSC) + (size_t)b * 16400;
    const float* kself = F.out + O_KS + (size_t)b * 256; const float* vself = F.out + O_VS + (size_t)b * 256; const float* kiself = F.out + O_IKS + (size_t)b * 64;
    const float* cache_k = F.in[2]; const float* cache_v = F.in[3];
    __syncthreads();
    if (w == 0) wait_count((unsigned*)(F.ws + WS_CTL) + CW_PANEL + 64 * (129 + b), 16u);
    __syncthreads();
    for (int i = tid; i < 1024; i += NTHR) qf[i] = bf2f(Qb[i]);
    if (tid == 0) cntw[0] = 0;
    float self_sc = 0.f;
    { float part = 0.f;
        const int h = lane >> 3, d0 = 8 * (lane & 7); float sh = 0.f;
#pragma unroll
        for (int d = 0; d < 8; ++d) sh = fmaf(bf2f(QI[h * 64 + d0 + d]), kiself[d0 + d], sh);
        sh += __shfl_xor(sh, 1); sh += __shfl_xor(sh, 2); sh += __shfl_xor(sh, 4);
        part = ((lane & 7) == 0) ? WI[h] * fmaxf(sh, 0.f) : 0.f;
        self_sc = wave_sum(part); }
    float v[33];
#pragma unroll
    for (int r = 0; r < 32; ++r) v[r] = __hip_atomic_load(SSC + 512 * r + tid, __ATOMIC_RELAXED, __HIP_MEMORY_SCOPE_AGENT);
    v[32] = (tid == 0) ? self_sc : NEG;
    int phase = 0;
    float mn = __builtin_inff(), mx = NEG;
#pragma unroll
    for (int r = 0; r < 33; ++r) { mx = fmaxf(mx, v[r]); mn = fminf(mn, (v[r] == NEG) ? __builtin_inff() : v[r]); }
    mn = wave_min_f(mn); mx = wave_max_f(mx);
    { LAS float* fr = (LAS float*)(red + 16);
      if (lane == 0) { fr[w] = mn; fr[8 + w] = mx; }
      __syncthreads();
      mn = fr[0]; mx = fr[8];
#pragma unroll
      for (int i = 1; i < 8; ++i) { mn = fminf(mn, fr[i]); mx = fmaxf(mx, fr[8 + i]); } }
    float lo = mn, hi = next_up(mx); int cnt_hi = 0; float T = hi, E = lo; int need = 0;
    for (int it = 0; it < 400; ++it) {
        const float mid = 0.5f * lo + 0.5f * hi;
        if (!(mid > lo && mid < hi)) { T = hi; E = lo; need = TOPK - cnt_hi; break; }
        int c = 0;
#pragma unroll
        for (int r = 0; r < 33; ++r) c += __popcll(__ballot(v[r] >= mid));
        c = block_sum_i(red, c, w, lane, phase);
        if (c == TOPK) { T = mid; need = 0; break; }
        if (c > TOPK) lo = mid; else { hi = mid; cnt_hi = c; }
    }
    int X = 0;
    if (need > 0) {
        int xl = 0, xh = PAST + 1;
        for (int it = 0; it < 20; ++it) {
            if (xh - xl <= 1) break;
            const int xm = (xl + xh) >> 1; int c = 0;
#pragma unroll
            for (int r = 0; r < 33; ++r) c += __popcll(__ballot(v[r] == E && (512 * r + tid) < xm));
            c = block_sum_i(red, c, w, lane, phase);
            if (c >= need) xh = xm; else xl = xm;
        }
        X = xh;
    }
#pragma unroll
    for (int r = 0; r < 33; ++r) { const int key = 512 * r + tid;
        if (v[r] >= T || (need > 0 && v[r] == E && key < X)) { const int p = __hip_atomic_fetch_add(cntw, 1, __ATOMIC_RELAXED, __HIP_MEMORY_SCOPE_WORKGROUP); if (p < TOPK) sel[p] = key; } }
    __syncthreads();
    LAS int* rowix = (LAS int*)(lds + SM_ROW);
    LAS float* Pacc = (LAS float*)(lds + SM_PACC);
    if (tid < TOPK) { const int key = sel[tid]; rowix[tid] = (key < PAST) ? (page_table[b * NPG + (key >> 7)] * PAGE + (key & 127)) : -1; }
    __syncthreads();
    const int hw = tid >> 5, l32 = tid & 31;
    {
        const int g = hw & 1;
        f32x4 q4[4];
#pragma unroll
        for (int hh = 0; hh < 4; ++hh) q4[hh] = *(const LAS f32x4*)(qf + (4 * g + hh) * 128 + 4 * l32);
#pragma unroll 8
        for (int it = 0; it < 32; ++it) { const int k = it * 8 + (hw >> 1); const int ri = rowix[k];
            const float* kr = (ri >= 0) ? (cache_k + ((size_t)ri * 2 + g) * 128) : (kself + g * 128);
            const f32x4 k4 = *(const f32x4*)(kr + 4 * l32);
            float p[4];
#pragma unroll
            for (int hh = 0; hh < 4; ++hh) { p[hh] = q4[hh].x * k4.x + q4[hh].y * k4.y + q4[hh].z * k4.z + q4[hh].w * k4.w;
                p[hh] += __shfl_xor(p[hh], 1); p[hh] += __shfl_xor(p[hh], 2); p[hh] += __shfl_xor(p[hh], 4); p[hh] += __shfl_xor(p[hh], 8); p[hh] += __shfl_xor(p[hh], 16); }
            if (l32 < 4) { const float pv = (l32 == 0) ? p[0] : (l32 == 1) ? p[1] : (l32 == 2) ? p[2] : p[3]; Sb[(4 * g + l32) * 256 + k] = pv * att::SCALE; } }
    }
    __syncthreads();
    {
        float x[4]; float m = NEG;
#pragma unroll
        for (int j = 0; j < 4; ++j) { x[j] = Sb[w * 256 + lane + 64 * j]; m = fmaxf(m, x[j]); }
        m = wave_max_f(m); float sum = 0.f;
#pragma unroll
        for (int j = 0; j < 4; ++j) { x[j] = __expf(x[j] - m); sum += x[j]; }
        sum = wave_sum(sum); const float inv = 1.0f / sum;
#pragma unroll
        for (int j = 0; j < 4; ++j) Sb[w * 256 + lane + 64 * j] = x[j] * inv;
    }
    __syncthreads();
    {
        const int g = hw & 1;
        f32x4 acc[4];
#pragma unroll
        for (int hh = 0; hh < 4; ++hh) acc[hh] = (f32x4){0.f, 0.f, 0.f, 0.f};
#pragma unroll 8
        for (int it = 0; it < 32; ++it) { const int k = it * 8 + (hw >> 1); const int ri = rowix[k];
            const float* vr = (ri >= 0) ? (cache_v + ((size_t)ri * 2 + g) * 128) : (vself + g * 128);
            const f32x4 v4 = *(const f32x4*)(vr + 4 * l32);
#pragma unroll
            for (int hh = 0; hh < 4; ++hh) { const float pw = Sb[(4 * g + hh) * 256 + k]; acc[hh] = acc[hh] + v4 * pw; } }
#pragma unroll
        for (int hh = 0; hh < 4; ++hh) *(LAS f32x4*)(Pacc + (hw * 4 + hh) * 128 + 4 * l32) = acc[hh];
    }
    __syncthreads();
    {
        const bf16* SGB = (const bf16*)(F.ws + WS_SGB) + (size_t)(MP + b) * DM; bf16* PB = (bf16*)(F.ws + WS_PB) + (size_t)(MP + b) * DM;
        const int h = tid >> 6, d = 2 * (tid & 63), g = h >> 2, hh = h & 3; float o0 = 0.f, o1 = 0.f;
#pragma unroll
        for (int j = 0; j < 8; ++j) { const f32x2 t = *(const LAS f32x2*)(Pacc + ((2 * j + g) * 4 + hh) * 128 + d); o0 += t.x; o1 += t.y; }
        const unsigned sg = *(const unsigned*)(SGB + h * 128 + d);
        *(unsigned*)(PB + h * 128 + d) = pk2(o0 * BF_LO(sg), o1 * BF_HI(sg));
    }
    __syncthreads();
}

template <int STAGE> struct EpiMerge {
    static constexpr bool PROBE_TWICE = false;
    unsigned char* ws;
    __device__ __forceinline__ void operator()(const pg8::f32x4 (&acc)[2][2][4][2], const pg8::Unit& u, int wr, int wc, int fr, int fq) const {
        const bf16* GATE = (const bf16*)(ws + (STAGE == 0 ? WS_SMA : WS_SMB)); const bf16* T1 = (const bf16*)(ws + WS_T1); bf16* DST = (bf16*)(ws + (STAGE == 0 ? WS_T1 : WS_MM));
        const size_t off0 = (size_t)(u.pm * 256 + wr * 64 + fr) * DM + u.pn * 256 + 32 * wc + 8 * fq;
#pragma unroll
        for (int ai = 0; ai < 2; ++ai) {
            v4u gt[4][2], tt[4][2];
#pragma unroll
            for (int m = 0; m < 4; ++m)
#pragma unroll
                for (int bj = 0; bj < 2; ++bj) { const size_t off = off0 + (size_t)(ai * 128 + m * 16) * DM + 128 * bj;
                    gt[m][bj] = *(const GAS v4u*)(GATE + off); if (STAGE == 1) tt[m][bj] = *(const GAS v4u*)(T1 + off); }
            asm volatile("" ::: "memory");
#pragma unroll
            for (int m = 0; m < 4; ++m)
#pragma unroll
                for (int bj = 0; bj < 2; ++bj) { const size_t off = off0 + (size_t)(ai * 128 + m * 16) * DM + 128 * bj;
                    const v4u g4 = gt[m][bj];
                    float r[8];
                    r[0] = BF_LO(g4.x) * acc[ai][bj][m][0][0]; r[1] = BF_HI(g4.x) * acc[ai][bj][m][0][1]; r[2] = BF_LO(g4.y) * acc[ai][bj][m][0][2]; r[3] = BF_HI(g4.y) * acc[ai][bj][m][0][3];
                    r[4] = BF_LO(g4.z) * acc[ai][bj][m][1][0]; r[5] = BF_HI(g4.z) * acc[ai][bj][m][1][1]; r[6] = BF_LO(g4.w) * acc[ai][bj][m][1][2]; r[7] = BF_HI(g4.w) * acc[ai][bj][m][1][3];
                    if (STAGE == 1) { const v4u t4 = tt[m][bj];
                        r[0] += BF_LO(t4.x); r[1] += BF_HI(t4.x); r[2] += BF_LO(t4.y); r[3] += BF_HI(t4.y); r[4] += BF_LO(t4.z); r[5] += BF_HI(t4.z); r[6] += BF_LO(t4.w); r[7] += BF_HI(t4.w); }
                    v4u o; o.x = pg8::cvt_pk_bf16(r[0], r[1]); o.y = pg8::cvt_pk_bf16(r[2], r[3]); o.z = pg8::cvt_pk_bf16(r[4], r[5]); o.w = pg8::cvt_pk_bf16(r[6], r[7]);
                    *(GAS v4u*)(DST + off) = o; }
        }
    }
};
struct EpiOut {
    static constexpr bool PROBE_TWICE = false;
    unsigned char* ws; float* out; const float* xp; const float* xs;
    __device__ __forceinline__ void operator()(const pg8::f32x4 (&acc)[2][2][4][2], const pg8::Unit& u, int wr, int wc, int fr, int fq) const {
        const float* MOD = (const float*)(ws + WS_MOD); float* SUMSQ = (float*)(ws + WS_SUMSQ);
        const int rbase = u.pm * 256 + wr * 64 + fr; const bool samp = (u.pm == MP / 256);
#pragma unroll
        for (int ai = 0; ai < 2; ++ai)
#pragma unroll
            for (int m = 0; m < 4; ++m) { const int row = rbase + ai * 128 + m * 16;
                const bool valid = !samp || (row - MP < NS);
                const int mr = samp ? (8 + ((row - MP) & 31)) : (row >> 12);
                const float* gate = MOD + (size_t)mr * 3072 + 2048;
                const float* xr = samp ? (xs + (size_t)((row - MP) & 31) * DM) : (xp + (size_t)row * DM);
                float* orow = samp ? (out + O_YS + (size_t)((row - MP) & 31) * DM) : (out + O_YP + (size_t)row * DM);
                float ss = 0.f;
#pragma unroll
                for (int bj = 0; bj < 2; ++bj)
#pragma unroll
                    for (int n = 0; n < 2; ++n) { const int col = u.pn * 256 + 128 * bj + 32 * wc + 16 * n + 4 * fq;
                        const pg8::f32x4 x4 = *(const pg8::f32x4*)(xr + col), g4 = *(const pg8::f32x4*)(gate + col);
                        const pg8::f32x4 hv = x4 + g4 * acc[ai][bj][m][n];
                        ss += (hv[0] * hv[0] + hv[1] * hv[1]) + (hv[2] * hv[2] + hv[3] * hv[3]);
                        if (valid) *(pg8::f32x4*)(orow + col) = hv; }
                ss += __shfl_xor(ss, 16); ss += __shfl_xor(ss, 32);
                if (fq == 0 && valid) atomicAdd(SUMSQ + row, ss); }
    }
};
struct EpiOutNorm {
    static constexpr bool PROBE_TWICE = false;
    unsigned char* ws; float* out; const float* xp; const float* gfin; LAS unsigned char* tab;
    __device__ __forceinline__ void operator()(pg8::f32x4 (&acc)[2][2][4][2], const pg8::Unit& u, int wr, int wc, int fr, int fq) const {
        const float* MOD = (const float*)(ws + WS_MOD); float* XCH = (float*)(ws + WS_XCH); unsigned* cnt = (unsigned*)(ws + WS_CTL) + CW_PANEL + 64 * u.pm;
        LAS float* P = (LAS float*)tab; LAS float* RS = P + 1024;
        const int tid = threadIdx.x, wid = tid >> 6;
        const int rl0 = wr * 64 + fr;
        const int colb = u.pn * 256 + 32 * wc + 4 * fq;
        pg8::f32x4 gq[2][2];
        { const float* gate = MOD + (size_t)((u.pm * 256) >> 12) * 3072 + 2048;
#pragma unroll
          for (int bj = 0; bj < 2; ++bj)
#pragma unroll
              for (int n = 0; n < 2; ++n) gq[bj][n] = *(const pg8::f32x4*)(gate + colb + 128 * bj + 16 * n); }
#pragma unroll
        for (int ai = 0; ai < 2; ++ai) {
            pg8::f32x4 xq[4][2][2];
#pragma unroll
            for (int m = 0; m < 4; ++m) { const float* xr = xp + (size_t)(u.pm * 256 + rl0 + ai * 128 + m * 16) * DM;
#pragma unroll
                for (int bj = 0; bj < 2; ++bj)
#pragma unroll
                    for (int n = 0; n < 2; ++n) xq[m][bj][n] = *(const pg8::f32x4*)(xr + colb + 128 * bj + 16 * n); }
            asm volatile("" ::: "memory");
#pragma unroll
            for (int m = 0; m < 4; ++m) { const int rl = rl0 + ai * 128 + m * 16;
                float ss = 0.f;
#pragma unroll
                for (int bj = 0; bj < 2; ++bj)
#pragma unroll
                    for (int n = 0; n < 2; ++n) { const pg8::f32x4 hv = xq[m][bj][n] + gq[bj][n] * acc[ai][bj][m][n]; acc[ai][bj][m][n] = hv;
                        ss += (hv[0] * hv[0] + hv[1] * hv[1]) + (hv[2] * hv[2] + hv[3] * hv[3]); }
                ss += __shfl_xor(ss, 16); ss += __shfl_xor(ss, 32);
                if (fq == 0) P[rl * 4 + wc] = ss; }
        }
        __syncthreads();
        if (tid < 256) { const float sp = (P[tid * 4] + P[tid * 4 + 1]) + (P[tid * 4 + 2] + P[tid * 4 + 3]);
            __hip_atomic_store(XCH + ((size_t)(u.pm * 4 + u.pn) * 256 + tid), sp, __ATOMIC_RELAXED, __HIP_MEMORY_SCOPE_AGENT); }
        asm volatile("s_waitcnt vmcnt(0)" ::: "memory");
        __syncthreads();
        if (tid == 0) __hip_atomic_fetch_add(cnt, 1u, __ATOMIC_RELAXED, __HIP_MEMORY_SCOPE_AGENT);
        if (wid == 0) wait_count(cnt, 4u);
        __syncthreads();
        if (tid < 256) { float t = 0.f;
#pragma unroll
            for (int k = 0; k < 4; ++k) t += __hip_atomic_load(XCH + ((size_t)(u.pm * 4 + k) * 256 + tid), __ATOMIC_RELAXED, __HIP_MEMORY_SCOPE_AGENT);
            RS[tid] = 1.0f / sqrtf(t * (1.f / DM) + EPS); }
        __syncthreads();
        pg8::f32x4 gf[2][2];
#pragma unroll
        for (int bj = 0; bj < 2; ++bj)
#pragma unroll
            for (int n = 0; n < 2; ++n) gf[bj][n] = *(const pg8::f32x4*)(gfin + colb + 128 * bj + 16 * n);
#pragma unroll
        for (int ai = 0; ai < 2; ++ai)
#pragma unroll
            for (int m = 0; m < 4; ++m) { const int rl = rl0 + ai * 128 + m * 16, row = u.pm * 256 + rl; const float rstd = RS[rl];
                float* orow = out + O_YP + (size_t)row * DM;
#pragma unroll
                for (int bj = 0; bj < 2; ++bj)
#pragma unroll
                    for (int n = 0; n < 2; ++n) *(pg8::f32x4*)(orow + colb + 128 * bj + 16 * n) = acc[ai][bj][m][n] * rstd * gf[bj][n]; }
    }
};
template <int KIND> __device__ __forceinline__ void sample_gemm_tile(Frame& F, int ct) {
    const int tid = F.tid, lane = F.lane, w = F.wave, r32 = lane & 31, hi = lane >> 5;
    const bf16* A = (const bf16*)(F.ws + (KIND == 0 ? WS_PA : KIND == 1 ? WS_PB : WS_MM)) + (size_t)MP * DM;
    const bf16* Bt = (const bf16*)(F.ws + (KIND == 0 ? WS_WPA : KIND == 1 ? WS_WPB : WS_WO));
    LAS float* red = (LAS float*)F.lds;
    __syncthreads();
    if (KIND == 2 && tid < 32) red[8192 + tid] = 0.f;
    f32x16 acc = {};
#pragma unroll
    for (int s = 0; s < 8; ++s) { const int kk = 128 * w + 16 * s + 8 * hi;
        v4u ta = *(const GAS v4u*)(A + (size_t)r32 * DM + kk), tb = *(const GAS v4u*)(Bt + (size_t)(32 * ct + r32) * DM + kk);
        acc = __builtin_amdgcn_mfma_f32_32x32x16_bf16(*reinterpret_cast<bf16x8*>(&ta), *reinterpret_cast<bf16x8*>(&tb), acc, 0, 0, 0); }
#pragma unroll
    for (int i = 0; i < 16; ++i) red[(w * 16 + i) * 64 + lane] = acc[i];
    __syncthreads();
    float hkeep[2] = {0.f, 0.f};
#pragma unroll
    for (int e2 = 0; e2 < 2; ++e2) { const int e = tid + 512 * e2, i = e >> 6, l = e & 63; float v = 0.f;
#pragma unroll
        for (int ww = 0; ww < 8; ++ww) v += red[(ww * 16 + i) * 64 + l];
        const int row = (i & 3) + 8 * (i >> 2) + 4 * (l >> 5), g = 32 * ct + (l & 31);
        if (KIND < 2) { const int oc = (g & ~255) + perm_plain(g & 255); const size_t off = (size_t)(MP + row) * DM + oc;
            const bf16* GATE = (const bf16*)(F.ws + (KIND == 0 ? WS_SMA : WS_SMB)); bf16* T1 = (bf16*)(F.ws + WS_T1); bf16* MMb = (bf16*)(F.ws + WS_MM);
            if (KIND == 0) T1[off] = (bf16)f2bf(bf2f(GATE[off]) * v); else MMb[off] = (bf16)f2bf(bf2f(T1[off]) + bf2f(GATE[off]) * v); }
        else { const float* MOD = (const float*)(F.ws + WS_MOD);
            const float hv = F.in[1][(size_t)row * DM + g] + MOD[(size_t)(8 + row) * 3072 + 2048 + g] * v;
            hkeep[e2] = hv;
            float q = hv * hv;
            q += __shfl_xor(q, 1); q += __shfl_xor(q, 2); q += __shfl_xor(q, 4); q += __shfl_xor(q, 8); q += __shfl_xor(q, 16);
            if ((l & 31) == 0) __hip_atomic_fetch_add(red + 8192 + row, q, __ATOMIC_RELAXED, __HIP_MEMORY_SCOPE_WORKGROUP); } }
    __syncthreads();
    if (KIND == 2) {
        float* XS = (float*)(F.ws + WS_XCH + MiB); unsigned* cnt = (unsigned*)(F.ws + WS_CTL) + CW_PANEL + 64 * 128;
        if (tid < 32) __hip_atomic_store(XS + ct * 32 + tid, red[8192 + tid], __ATOMIC_RELAXED, __HIP_MEMORY_SCOPE_AGENT);
        asm volatile("s_waitcnt vmcnt(0)" ::: "memory");
        __syncthreads();
        if (tid == 0) __hip_atomic_fetch_add(cnt, 1u, __ATOMIC_RELAXED, __HIP_MEMORY_SCOPE_AGENT);
        if (w == 0) wait_count(cnt, 32u);
        __syncthreads();
        if (tid < 32) { float t = 0.f; for (int k = 0; k < 32; ++k) t += __hip_atomic_load(XS + k * 32 + tid, __ATOMIC_RELAXED, __HIP_MEMORY_SCOPE_AGENT); red[8192 + 64 + tid] = 1.0f / sqrtf(t * (1.f / DM) + EPS); }
        __syncthreads();
#pragma unroll
        for (int e2 = 0; e2 < 2; ++e2) { const int e = tid + 512 * e2, i = e >> 6, l = e & 63; const int row = (i & 3) + 8 * (i >> 2) + 4 * (l >> 5), g = 32 * ct + (l & 31);
            F.out[O_YS + (size_t)row * DM + g] = hkeep[e2] * red[8192 + 64 + row] * F.in[26][g]; }
        __syncthreads();
    }
}
__device__ __forceinline__ void p6_final_norm(Frame& F) {
    const int gw = F.vcu * NWAVES + F.wave, NGW = F.G * NWAVES, lane = F.lane;
    const float* SUMSQ = (const float*)(F.ws + WS_SUMSQ); const float* gf = F.in[26];
    for (int m = gw; m < MP + NS; m += NGW) {
        float* yr = (m < MP) ? (F.out + O_YP + (size_t)m * DM) : (F.out + O_YS + (size_t)(m - MP) * DM);
        const float rstd = 1.0f / sqrtf(SUMSQ[m] * (1.f / DM) + EPS);
        GAS f32x4* y4 = (GAS f32x4*)yr + lane;
#pragma unroll
        for (int j = 0; j < 4; ++j) { const f32x4 g4 = *(const f32x4*)(gf + 256 * j + 4 * lane); f32x4 v = y4[64 * j]; v = v * rstd * g4; y4[64 * j] = v; }
    }
}

__global__ void __launch_bounds__(NTHR, 2) fwd(Args args) {
    extern __shared__ __attribute__((aligned(16))) unsigned char lds_raw[];
    Frame F;
    F.lds = (LAS unsigned char*)lds_raw;
    F.tid = threadIdx.x; F.lane = F.tid & 63; F.wave = __builtin_amdgcn_readfirstlane(F.tid >> 6);
    F.G = gridDim.x; { const int bx = blockIdx.x; F.vcu = (F.G % 8 == 0) ? (bx % 8) * (F.G / 8) + bx / 8 : bx; }
    F.in = args.in; F.out = args.out; F.ws = args.ws;
    volatile LAS unsigned* MISC = (volatile LAS unsigned*)(F.lds + LDSCTL_OFF);
    for (int u = F.tid; u < (LDS_BYTES - LDSCTL_OFF) / 4; u += NTHR) ((LAS unsigned*)(F.lds + LDSCTL_OFF))[u] = 0u;
    __syncthreads();
    XcdBarrier bar; bar.bar = (unsigned*)(F.ws + WS_CTL) + CW_BAR; bar.x = 0; bar.st = nullptr;
#if N_LAUNCH_MODE == 1
    bar = xcd_barrier_post((unsigned*)(F.ws + WS_CTL) + CW_BAR, MISC + 8);
#define GRID_BAR() xcd_barrier(bar)
#else
#define GRID_BAR() do {} while (0)
#endif
    const int lo = args.ph_lo, hi = args.ph_hi;
#ifdef TIMING_PROBE
    unsigned long long* STAMP = (unsigned long long*)(F.ws + WS_CTL + 512 * 1024);
    int n_stamp = 0;
#define TSTAMP() do { if (blockIdx.x == 0 && F.tid == 0) STAMP[n_stamp] = __builtin_amdgcn_s_memrealtime(); ++n_stamp; } while (0)
#else
#define TSTAMP() do {} while (0)
#endif
    TSTAMP();
#ifndef PHASE_MASK
#define PHASE_MASK 0xFFFF
#endif
#define IN(k) (((PHASE_MASK >> (k)) & 1) && lo <= (k) && (k) < hi)
#define BOTH(k) (IN(k) && IN((k) + 1))
    if (IN(0)) { p0_prologue(F); p0_build_wg(F); TSTAMP(); }
    if (IN(1)) { REP(10) p1_weights(F);
        __syncthreads(); if (F.wave == 0) wait_count((unsigned*)(F.ws + WS_CTL) + CW_MODCNT, 192u); __syncthreads();
        REP(1) p0b_norm(F); if (BOTH(1)) GRID_BAR(); TSTAMP(); }
    if (IN(2)) {
        pg8::Gemm g{(const bf16*)(F.ws + WS_XN), (const bf16*)(F.ws + WS_WIN), MT, N_IN_PAD, DM}; pg8::StaticOrder S; S.init(MT, N_IN_PAD, F.G, (int)blockIdx.x, 2);
        EpiIn E{F.ws, F.out, F.in[21], F.in[22]};
        REP(2) pg8::gemm_phase<EpiIn, pg8::StaticOrder, true, true>(F.lds, g, S, E);
        if (BOTH(2)) GRID_BAR();
        TSTAMP();
    }
    if (IN(3)) {
        if (blockIdx.x & 8) p3_conv_pass(F);
        REP(31) p3a_indexer(F, args.page_table);
        if (!(blockIdx.x & 8)) p3_conv_pass(F);
        for (int u = F.G - 1 - F.vcu; u < NS * 4; u += F.G) p2_rglru_sample_unit(F, u);
        if (F.G > 64) { REP(41) for (int b = F.vcu; b < NS; b += F.G) p3b_sample_unit(F, args.page_table, b); }
        else { for (int b = F.vcu; b < NS; b += F.G) p3b_sample_unit(F, args.page_table, b); }
        if (BOTH(3)) GRID_BAR();
        TSTAMP();
    }
    if (IN(4)) {
        p2_rglru(F, (REPEAT_PHASE == 30) ? 2 : 1);
        __syncthreads();
        p3b_attention(F, (REPEAT_PHASE == 42) ? 2 : 1);
        if (BOTH(4)) GRID_BAR();
        TSTAMP();
    }
    if (IN(5)) {
        for (int ct = F.vcu; ct < 32; ct += F.G) { sample_gemm_tile<0>(F, ct); sample_gemm_tile<1>(F, ct); }
        { pg8::Gemm g{(const bf16*)(F.ws + WS_PA), (const bf16*)(F.ws + WS_WPA), MP, DM, DM}; pg8::StaticOrder S; S.init(MP, DM, F.G, (int)blockIdx.x);
          EpiMerge<0> E{F.ws};
          REP(40) pg8::gemm_phase<EpiMerge<0>, pg8::StaticOrder, true, true>(F.lds, g, S, E); }
        { pg8::Gemm g{(const bf16*)(F.ws + WS_PB), (const bf16*)(F.ws + WS_WPB), MP, DM, DM}; pg8::StaticOrder S; S.init(MP, DM, F.G, (int)blockIdx.x);
          EpiMerge<1> E{F.ws};
          REP(5) pg8::gemm_phase<EpiMerge<1>, pg8::StaticOrder, true, true>(F.lds, g, S, E); }
        if (BOTH(5)) GRID_BAR();
        TSTAMP();
    }
    if (IN(6)) {
        for (int ct = F.vcu; ct < 32; ct += F.G) sample_gemm_tile<2>(F, ct);
        pg8::Gemm g{(const bf16*)(F.ws + WS_MM), (const bf16*)(F.ws + WS_WO), MP, DM, DM}; pg8::StaticOrder S; S.init(MP, DM, F.G, (int)blockIdx.x);
        EpiOutNorm E{F.ws, F.out, F.in[0], F.in[26], F.lds + RING_BYTES};
        pg8::gemm_phase<EpiOutNorm, pg8::StaticOrder, true, true>(F.lds, g, S, E);
        TSTAMP();
    }
#ifdef STATS_PROBE
    GRID_BAR();
    {   const unsigned* ST = (const unsigned*)(F.ws + WS_CTL + 768 * 1024);
        unsigned st[8];
#pragma unroll
        for (int k = 0; k < 8; ++k) st[k] = __hip_atomic_load(ST + k, __ATOMIC_RELAXED, __HIP_MEMORY_SCOPE_AGENT);
        const unsigned enc[8] = { st[1] ? (unsigned)(((unsigned long long)st[0] * 10ull) / st[1]) : 0u, st[2] / 2048u, st[3] / 2048u, st[4] / 2048u, st[5] / 16u, st[6] / 8u, st[1], 0u };
        const size_t chan_off[8] = {O_YS, O_CP, O_LP, O_KS, O_VS, O_IKS, O_CS, O_LS};
        const size_t gt = (size_t)blockIdx.x * NTHR + F.tid, NGT = (size_t)F.G * NTHR;
        for (size_t i = gt; i < O_END; i += NGT) { bool skip = false;
#pragma unroll
            for (int k = 0; k < 8; ++k) skip = skip || (i >= chan_off[k] && i < chan_off[k] + enc[k]);
            if (!skip) args.out_real[i] = 0.f; }
    }
#endif
#ifdef TIMING_PROBE
    GRID_BAR(); TSTAMP();
    if (blockIdx.x == 0 && F.tid == 0) { for (int k = 0; k < 8; ++k) ((unsigned*)(F.ws + WS_CTL + 768 * 1024))[k] = (unsigned)((STAMP[k + 1] - STAMP[k]) / 100ull); }
    GRID_BAR();
    {
        const unsigned* dur = (const unsigned*)(F.ws + WS_CTL + 768 * 1024);
        const size_t chan_off[8] = {O_YS, O_CP, O_LP, O_KS, O_VS, O_IKS, O_CS, O_LS};
        const size_t gt = (size_t)blockIdx.x * NTHR + F.tid, NGT = (size_t)F.G * NTHR;
        for (size_t i = gt; i < O_END; i += NGT) { bool skip = false;
#pragma unroll
            for (int k = 0; k < 8; ++k) skip = skip || (i >= chan_off[k] && i < chan_off[k] + __hip_atomic_load(dur + k, __ATOMIC_RELAXED, __HIP_MEMORY_SCOPE_AGENT));
            if (!skip) args.out_real[i] = 0.f; }
    }
#endif
}

extern "C" void kernel_launch(void* const* d_in, const int* in_sizes, int n_in, void* d_out, int out_size, void* d_ws, size_t ws_size, hipStream_t stream) {
    static int grid = 0;
    if (grid == 0) {
        if (n_in != 27 || (size_t)out_size != O_END || ws_size < WS_END) { fprintf(stderr, "kernel_launch: unexpected shapes n_in %d out %d ws %zu (want 27, %zu, >= %zu)\n", n_in, out_size, ws_size, (size_t)O_END, (size_t)WS_END); grid = -1; return; }
        int dev = 0, cus = 0;
        if (hipGetDevice(&dev) != hipSuccess || hipDeviceGetAttribute(&cus, hipDeviceAttributeMultiprocessorCount, dev) != hipSuccess) { grid = -1; return; }
        if (hipFuncSetAttribute((const void*)fwd, hipFuncAttributeMaxDynamicSharedMemorySize, LDS_BYTES) != hipSuccess) { fprintf(stderr, "kernel_launch: hipFuncSetAttribute failed\n"); grid = -1; return; }
        int per_cu = 0;
        if (hipOccupancyMaxActiveBlocksPerMultiprocessor(&per_cu, (const void*)fwd, NTHR, LDS_BYTES) != hipSuccess || per_cu < 1) fprintf(stderr, "kernel_launch: occupancy query says %d\n", per_cu);
        (void)hipGetLastError();
        grid = cus;
    }
    if (grid < 0) return;
    hipMemsetAsync((char*)d_ws + WS_CTL, 0, ZERO_BYTES, stream);
    Args a{};
    for (int i = 0; i < 27; ++i) a.in[i] = (const float*)d_in[i];
    a.page_table = (const int*)d_in[7];
#if defined(TIMING_PROBE) || defined(STATS_PROBE)
    a.out = (float*)((unsigned char*)d_ws + WS_END); a.out_real = (float*)d_out;
#else
    a.out = (float*)d_out; a.out_real = (float*)d_out;
#endif
    a.ws = (unsigned char*)d_ws;
#if N_LAUNCH_MODE == 1
    a.ph_lo = 0; a.ph_hi = LAST_PHASE + 1;
    hipLaunchKernelGGL(fwd, dim3(grid), dim3(NTHR), LDS_BYTES, stream, a);
#else
    for (int p = 0; p <= LAST_PHASE; ++p) { a.ph_lo = p; a.ph_hi = p + 1; hipLaunchKernelGGL(fwd, dim3(grid), dim3(NTHR), LDS_BYTES, stream, a); }
#endif
}
```

```cpp
#include <hip/hip_runtime.h>
#include <cstdio>
#include <cstdint>

#ifndef REPEAT_PHASE
#define REPEAT_PHASE -1
#endif
#define REP(k) for (int rep_ = 0; rep_ < ((REPEAT_PHASE == (k)) ? 2 : 1); ++rep_)
#ifndef N_LAUNCH_MODE
#define N_LAUNCH_MODE 1
#endif
#ifndef LAST_PHASE
#define LAST_PHASE 6
#endif

namespace pg8 {
#define PG8_LAS __attribute__((address_space(3)))
typedef unsigned short bf16_t;
typedef short bf16x8 __attribute__((ext_vector_type(8)));
typedef float f32x4 __attribute__((ext_vector_type(4)));
typedef unsigned u32x4 __attribute__((ext_vector_type(4)));
typedef unsigned u32x2 __attribute__((ext_vector_type(2)));
constexpr int BM = 256, BK = 64, HALF = 128, HTB = HALF * BK * 2, STAGE_BYTES = 8 * HTB, NXCD = 8, WGM = 8;

__host__ __device__ __forceinline__ int lds_byte(int r, int c) { const int st = (r >> 4) * 2 + (c >> 5), rr = r & 15, cc = c & 31, ob = rr * 64 + cc * 2; return st * 1024 + (ob ^ (((ob >> 9) & 1) << 5)); }
__host__ __device__ __forceinline__ void stage_rc(int b, int& R, int& C) { const int st = b / 1024, sb = b % 1024, swz = sb ^ (((sb >> 9) & 1) << 5); R = (st >> 1) * 16 + swz / 64; C = (st & 1) * 32 + (swz % 64) / 2; }

struct Unit { int pm, pn; };
struct Gemm { const bf16_t* A; const bf16_t* Bt; int M, N, K; };

struct StaticOrder {
    int nM, nN, nwg, G, c, wgm;
    __host__ __device__ void init(int M, int N, int G_, int c_, int wgm_ = WGM) { nM = M / BM; nN = N / BM; nwg = nM * nN; G = G_; c = c_; wgm = wgm_; }
    __host__ __device__ bool next(int i, Unit& u) const {
        const long L = (long)i * G + c; if (L >= nwg) return false;
        int wgid = (int)L; { const int q = nwg / NXCD, r = nwg % NXCD, xcd = wgid % NXCD, off = wgid / NXCD; wgid = (xcd < r ? xcd * (q + 1) : r * (q + 1) + (xcd - r) * q) + off; }
        const int nig = wgm * nN, gid = wgid / nig, fm = gid * wgm, gsz = (nM - fm) < wgm ? (nM - fm) : wgm;
        u.pm = fm + ((wgid % nig) % gsz); u.pn = (wgid % nig) / gsz; return true;
    }
    __device__ __forceinline__ void a_ready(const Unit&) const {}
    __device__ __forceinline__ void done(const Unit&) const {}
};

__device__ __forceinline__ unsigned cvt_pk_bf16(float lo, float hi) { unsigned r; asm volatile("v_cvt_pk_bf16_f32 %0, %1, %2" : "=v"(r) : "v"(lo), "v"(hi)); return r; }

template <class Epi, class Sched, bool ALIGN_EPI = false, bool SP2 = true>
__device__ __forceinline__ void gemm_phase(PG8_LAS unsigned char* lds, const Gemm g, const Sched& S, const Epi& E) {
    const int tid = threadIdx.x, wid = __builtin_amdgcn_readfirstlane(tid >> 6), lane = tid & 63, wr = wid >> 2, wc = wid & 3, fr = lane & 15, fq = lane >> 4;
    const int K = g.K, nt = K / BK;
    unsigned voffA[2], voffB[2];
#pragma unroll
    for (int i = 0; i < 2; ++i) { int R, C; stage_rc(tid * 16 + i * 8192, R, C);
        voffA[i] = (unsigned)(R * K + C) * 2u; voffB[i] = (unsigned)(R * K + C) * 2u; }
    const size_t kstep = (size_t)(BK * 2);
    const size_t hstep = (size_t)HALF * K * 2;
    const size_t tstep = 2 * hstep;
    const unsigned ldsw = (unsigned)wid * 1024u;
    const int aoff = lds_byte(wr * 64 + fr, fq * 8), boff = lds_byte(wc * 32 + fr, fq * 8);
#define PG8_SA(b, h) (((b) * 2 + (h)) * HTB)
#define PG8_SB(b, h) ((4 + (b) * 2 + (h)) * HTB)
#define PG8_STAGE(bufoff, gbase, voff) do { _Pragma("unroll") for (int _i = 0; _i < 2; ++_i) \
        __builtin_amdgcn_global_load_lds((const unsigned*)((const char*)(gbase) + (voff)[_i]), (PG8_LAS unsigned*)(lds + (bufoff) + ldsw + _i * 8192), 16, 0, 0); } while (0)
#define PG8_LDA(dst, b, h) do { _Pragma("unroll") for (int m = 0; m < 4; ++m) _Pragma("unroll") for (int k = 0; k < 2; ++k) dst[m][k] = *(const PG8_LAS bf16x8*)(lds + PG8_SA(b, h) + aoff + m * 2048 + k * 1024); } while (0)
#define PG8_LDB(dst, b, h) do { _Pragma("unroll") for (int n = 0; n < 2; ++n) _Pragma("unroll") for (int k = 0; k < 2; ++k) dst[n][k] = *(const PG8_LAS bf16x8*)(lds + PG8_SB(b, h) + boff + n * 2048 + k * 1024); } while (0)
#define PG8_MMA(ai, bj, At, Bt) do { __builtin_amdgcn_s_setprio(1); _Pragma("unroll") for (int m = 0; m < 4; ++m) _Pragma("unroll") for (int n = 0; n < 2; ++n) _Pragma("unroll") for (int k = 0; k < 2; ++k) \
        acc[ai][bj][m][n] = __builtin_amdgcn_mfma_f32_16x16x32_bf16(Bt[n][k], At[m][k], acc[ai][bj][m][n], 0, 0, 0); __builtin_amdgcn_s_setprio(0); } while (0)
#define PG8_WAIT_V(n) asm volatile("s_waitcnt vmcnt(" #n ")" ::: "memory")
#define PG8_WAIT_L(n) asm volatile("s_waitcnt lgkmcnt(" #n ")" ::: "memory")
#define PG8_BAR __builtin_amdgcn_s_barrier()
#define PG8_SCHED __builtin_amdgcn_sched_barrier(0)
    Unit cur, nxt; int ui = 0;
    if (!S.next(0, cur)) return;
    f32x4 acc[2][2][4][2];
#pragma unroll
    for (int a = 0; a < 2; ++a)
#pragma unroll
        for (int b = 0; b < 2; ++b)
#pragma unroll
            for (int m = 0; m < 4; ++m)
#pragma unroll
                for (int n = 0; n < 2; ++n) acc[a][b][m][n] = (f32x4){0.f, 0.f, 0.f, 0.f};
    bf16x8 At[4][2], B0[2][2], B1[2][2];
    const char* cA = (const char*)g.A + (size_t)cur.pm * tstep; const char* cB = (const char*)g.Bt + (size_t)cur.pn * tstep;
    S.a_ready(cur);
    if constexpr (SP2) {
        PG8_STAGE(PG8_SB(0, 0), cB, voffB); PG8_STAGE(PG8_SB(0, 1), cB + hstep, voffB); PG8_STAGE(PG8_SA(0, 0), cA, voffA); PG8_STAGE(PG8_SA(0, 1), cA + hstep, voffA);
        if (wr == 1) PG8_BAR;
        PG8_WAIT_V(2); PG8_BAR;
        PG8_STAGE(PG8_SB(1, 0), cB + kstep, voffB); PG8_STAGE(PG8_SA(1, 0), cA + kstep, voffA); PG8_STAGE(PG8_SB(1, 1), cB + hstep + kstep, voffB);
        PG8_WAIT_V(6); PG8_BAR;
    } else {
        PG8_STAGE(PG8_SB(0, 0), cB, voffB); PG8_STAGE(PG8_SA(0, 0), cA, voffA); PG8_STAGE(PG8_SB(0, 1), cB + hstep, voffB); PG8_STAGE(PG8_SA(0, 1), cA + hstep, voffA);
        if (wr == 1) PG8_BAR;
        PG8_WAIT_V(4); PG8_BAR;
        PG8_STAGE(PG8_SB(1, 0), cB + kstep, voffB); PG8_STAGE(PG8_SA(1, 0), cA + kstep, voffA); PG8_STAGE(PG8_SB(1, 1), cB + hstep + kstep, voffB);
        PG8_WAIT_V(6); PG8_BAR;
    }
    for (;;) {
        const bool has_next = S.next(ui + 1, nxt);
        const char* nA = has_next ? (const char*)g.A + (size_t)nxt.pm * tstep : cA; const char* nB = has_next ? (const char*)g.Bt + (size_t)nxt.pn * tstep : cB;
        for (int t = 0; t < nt; t += 2) {
            const bool last = (t == nt - 2);
            const char* a1 = cA + (size_t)(t + 1) * kstep;
            const char* a2 = last ? nA : cA + (size_t)(t + 2) * kstep; const char* b2 = last ? nB : cB + (size_t)(t + 2) * kstep;
            const char* a3 = a2 + kstep; const char* b3 = b2 + kstep;
            if (last && has_next) S.a_ready(nxt);
            if constexpr (SP2) {
            PG8_LDB(B0, 0, 0); PG8_LDB(B1, 0, 1); PG8_SCHED; PG8_LDA(At, 0, 0); PG8_STAGE(PG8_SA(1, 1), a1 + hstep, voffA);
            PG8_WAIT_V(8); PG8_WAIT_L(0); PG8_BAR; PG8_MMA(0, 0, At, B0); PG8_MMA(0, 1, At, B1); PG8_BAR; PG8_SCHED;
            PG8_LDA(At, 0, 1); PG8_STAGE(PG8_SB(0, 0), b2, voffB); PG8_STAGE(PG8_SB(0, 1), b2 + hstep, voffB); PG8_STAGE(PG8_SA(0, 0), a2, voffA);
            PG8_WAIT_V(8); PG8_WAIT_L(0); PG8_BAR; PG8_MMA(1, 0, At, B0); PG8_MMA(1, 1, At, B1); PG8_BAR; PG8_SCHED;
            PG8_LDB(B0, 1, 0); PG8_LDB(B1, 1, 1); PG8_SCHED; PG8_LDA(At, 1, 0); PG8_STAGE(PG8_SA(0, 1), a2 + hstep, voffA);
            PG8_WAIT_V(8); PG8_WAIT_L(0); PG8_BAR; PG8_MMA(0, 0, At, B0); PG8_MMA(0, 1, At, B1); PG8_BAR; PG8_SCHED;
            PG8_LDA(At, 1, 1); PG8_STAGE(PG8_SB(1, 0), b3, voffB); PG8_STAGE(PG8_SB(1, 1), b3 + hstep, voffB); PG8_STAGE(PG8_SA(1, 0), a3, voffA);
            PG8_WAIT_V(8); PG8_WAIT_L(0); PG8_BAR; PG8_MMA(1, 0, At, B0); PG8_MMA(1, 1, At, B1); PG8_BAR; PG8_SCHED;
            } else {
            PG8_LDB(B0, 0, 0); PG8_SCHED; PG8_LDA(At, 0, 0); PG8_STAGE(PG8_SA(1, 1), a1 + hstep, voffA);
            PG8_WAIT_L(8); PG8_BAR; PG8_WAIT_L(0); PG8_MMA(0, 0, At, B0); PG8_BAR; PG8_SCHED;
            PG8_LDB(B1, 0, 1); PG8_STAGE(PG8_SB(0, 0), b2, voffB);
            PG8_BAR; PG8_WAIT_L(0); PG8_MMA(0, 1, At, B1); PG8_BAR;
            PG8_LDA(At, 0, 1); PG8_STAGE(PG8_SA(0, 0), a2, voffA);
            PG8_BAR; PG8_WAIT_L(0); PG8_MMA(1, 0, At, B0); PG8_BAR; PG8_SCHED;
            PG8_STAGE(PG8_SB(0, 1), b2 + hstep, voffB);
            PG8_WAIT_V(6); PG8_BAR; PG8_MMA(1, 1, At, B1); PG8_BAR;
            PG8_LDB(B0, 1, 0); PG8_SCHED; PG8_LDA(At, 1, 0); PG8_STAGE(PG8_SA(0, 1), a2 + hstep, voffA);
            PG8_WAIT_L(8); PG8_BAR; PG8_WAIT_L(0); PG8_MMA(0, 0, At, B0); PG8_BAR; PG8_SCHED;
            PG8_LDB(B1, 1, 1); PG8_STAGE(PG8_SB(1, 0), b3, voffB);
            PG8_BAR; PG8_WAIT_L(0); PG8_MMA(0, 1, At, B1); PG8_BAR;
            PG8_LDA(At, 1, 1); PG8_STAGE(PG8_SA(1, 0), a3, voffA);
            PG8_BAR; PG8_WAIT_L(0); PG8_MMA(1, 0, At, B0); PG8_BAR; PG8_SCHED;
            PG8_STAGE(PG8_SB(1, 1), b3 + hstep, voffB);
            PG8_WAIT_V(6); PG8_BAR; PG8_MMA(1, 1, At, B1); PG8_BAR;
            }
        }
        if constexpr (ALIGN_EPI) { if (wr == 0) PG8_BAR; }
        E(acc, cur, wr, wc, fr, fq); if constexpr (Epi::PROBE_TWICE) { if (REPEAT_PHASE == 20) E(acc, cur, wr, wc, fr, fq); } S.done(cur);
        if (!has_next) break;
#pragma unroll
        for (int a = 0; a < 2; ++a)
#pragma unroll
            for (int b = 0; b < 2; ++b)
#pragma unroll
                for (int m = 0; m < 4; ++m)
#pragma unroll
                    for (int n = 0; n < 2; ++n) acc[a][b][m][n] = (f32x4){0.f, 0.f, 0.f, 0.f};
        cur = nxt; cA = nA; cB = nB; ++ui;
        if constexpr (ALIGN_EPI) { if (wr == 1) PG8_BAR; }
    }
    PG8_WAIT_V(0);
    if constexpr (!ALIGN_EPI) { if (wr == 0) PG8_BAR; }
    PG8_BAR;
#undef PG8_SA
#undef PG8_SB
#undef PG8_STAGE
#undef PG8_LDA
#undef PG8_LDB
#undef PG8_MMA
#undef PG8_WAIT_V
#undef PG8_WAIT_L
#undef PG8_BAR
#undef PG8_SCHED
}
}

constexpr int DM = 1024, NBATCH = 8, SEQ = 4096, MP = NBATCH * SEQ, NS = 32, MT = MP + 256;
constexpr int PAST = 16384, PAGE = 128, NPG = PAST / PAGE;
constexpr int D_IN = 7240, NT_IN = 29, N_IN_PAD = NT_IN * 256;
constexpr int C_XA = 0, C_GA = 1024, C_Q = 2048, C_K = 3072, C_V = 3328, C_GB = 3584, C_QI = 4608, C_KI = 5120, C_WI = 5184, C_MA = 5192, C_MB = 6216;
constexpr float EPS = 1e-6f;
constexpr float IDX_W_SCALE = 0.04419417382415922f;
constexpr int NWAVES = 8, NTHR = 512;

constexpr size_t O_YP = 0, O_YS = O_YP + (size_t)MP * DM, O_KP = O_YS + (size_t)NS * DM, O_VP = O_KP + (size_t)MP * 256, O_IKP = O_VP + (size_t)MP * 256,
                 O_CP = O_IKP + (size_t)MP * 64, O_LP = O_CP + (size_t)NBATCH * 3 * DM, O_KS = O_LP + (size_t)NBATCH * DM, O_VS = O_KS + (size_t)NS * 256,
                 O_IKS = O_VS + (size_t)NS * 256, O_CS = O_IKS + (size_t)NS * 64, O_LS = O_CS + (size_t)NS * 3 * DM, O_END = O_LS + (size_t)NS * DM;

constexpr size_t MiB = 1u << 20;
constexpr size_t WS_CTL = 0;
constexpr size_t WS_MOD = 1 * MiB;
constexpr size_t WS_SUMSQ = WS_MOD + 512 * 1024;
constexpr size_t ZERO_BYTES = 2 * MiB;
constexpr size_t WS_RT128 = 2 * MiB;
constexpr size_t WS_RT64 = WS_RT128 + 3 * MiB;
constexpr size_t WS_WG = 7 * MiB;
constexpr size_t WS_WPA = 8 * MiB, WS_WPB = 10 * MiB, WS_WO = 12 * MiB;
constexpr size_t WS_WIN = 14 * MiB;
constexpr size_t WS_WI = 30 * MiB;
constexpr size_t WS_KI = 32 * MiB;
constexpr size_t WS_SSC = 38 * MiB;
constexpr size_t WS_XCH = 44 * MiB;
constexpr size_t WS_MSK = 48 * MiB;
constexpr size_t ACT = (size_t)MT * DM * 2;
constexpr size_t WS_XN = 64 * MiB;
constexpr size_t WS_XC = WS_XN;
constexpr size_t WS_XA = WS_XN + 65 * MiB, WS_SGA = WS_XA + 65 * MiB, WS_Q = WS_SGA + 65 * MiB, WS_SGB = WS_Q + 65 * MiB, WS_SMA = WS_SGB + 65 * MiB, WS_SMB = WS_SMA + 65 * MiB;
constexpr size_t WS_PA = WS_SMB + 65 * MiB, WS_PB = WS_PA + 65 * MiB, WS_T1 = WS_PB + 65 * MiB, WS_MM = WS_T1 + 65 * MiB;
constexpr size_t WS_KB = WS_MM + 65 * MiB, WS_VB = WS_KB + 17 * MiB, WS_QI = WS_VB + 17 * MiB, WS_END = WS_QI + 33 * MiB;
static_assert(ACT <= 65 * MiB, "activation size");

constexpr int CW_BAR = 4096;
constexpr int CW_PANEL = 8192;

constexpr int RING_BYTES = 131072;
constexpr int CW_MODCNT = CW_PANEL + 64 * 176;
constexpr int LDSCTL_OFF = 160 * 1024 - 512, LDS_BYTES = 160 * 1024;

#define GAS __attribute__((address_space(1)))
#define LAS __attribute__((address_space(3)))
typedef unsigned short bf16;
typedef unsigned v4u __attribute__((ext_vector_type(4)));
typedef unsigned v2u __attribute__((ext_vector_type(2)));
typedef float f32x4 __attribute__((ext_vector_type(4)));
typedef float f32x2 __attribute__((ext_vector_type(2)));
typedef short bf16x8 __attribute__((ext_vector_type(8)));
#define LDS_WAIT() asm volatile("s_waitcnt lgkmcnt(0)" ::: "memory")
#define VM_WAIT() asm volatile("s_waitcnt vmcnt(0)" ::: "memory")
__device__ __forceinline__ unsigned f2bf(float f) { unsigned u = __builtin_bit_cast(unsigned, f); return (u + 0x7fffu + ((u >> 16) & 1u)) >> 16; }
__device__ __forceinline__ unsigned pk2(float lo, float hi) { return f2bf(lo) | (f2bf(hi) << 16); }
__device__ __forceinline__ float bf2f(unsigned short b) { return __uint_as_float(((unsigned)b) << 16); }
__device__ __forceinline__ float sigmoidf_(float x) { return __builtin_amdgcn_rcpf(1.0f + __builtin_amdgcn_exp2f(-1.4426950408889634f * x)); }
__device__ __forceinline__ float siluf_(float x) { return x * __builtin_amdgcn_rcpf(1.0f + __builtin_amdgcn_exp2f(-1.4426950408889634f * x)); }

#define XB_TMO      128
#define XB_XCNT(j)  (256  + 64 * (j))
#define XB_XSUB(j)  (1280 + 64 * (j))
#define XB_XGEN(j)  (2304 + 64 * (j))
#define XB_TOP      3328
#define XB_TOPGEN   3392
#define XCD_BAR_WORDS 3456
#define XB_SPIN_CAP (1u << 18)
__device__ __forceinline__ unsigned xb_ld(unsigned* p)              { return __hip_atomic_load(p, __ATOMIC_RELAXED, __HIP_MEMORY_SCOPE_AGENT); }
__device__ __forceinline__ unsigned xb_add(unsigned* p, unsigned v) { return __hip_atomic_fetch_add(p, v, __ATOMIC_RELAXED, __HIP_MEMORY_SCOPE_AGENT); }
__device__ __forceinline__ unsigned xb_xcc_id() { return (unsigned)__builtin_amdgcn_s_getreg((3 << 11) | 20) & 0xFu; }
#define XB_SPIN(cond, bar) do { unsigned _sp = 0; while (cond) { __builtin_amdgcn_s_sleep(1); \
    if ((++_sp & 255u) == 0u) { if (xb_ld(&(bar)[XB_TMO])) break; if (_sp > XB_SPIN_CAP) { atomicAdd(&(bar)[XB_TMO], 1u); break; } } } } while (0)
struct XcdBarrier { unsigned* bar; unsigned x; volatile LAS unsigned* st; };
__device__ __forceinline__ XcdBarrier xcd_barrier_post(unsigned* bar, volatile LAS unsigned* st) {
    XcdBarrier b; b.bar = bar; b.x = xb_xcc_id(); b.st = st;
    if (threadIdx.x == 0) (void)xb_add(&bar[XB_XCNT(b.x)], 1u);
    return b;
}
__device__ __forceinline__ void xcd_barrier_complete(unsigned* bar, unsigned x, unsigned& nloc, unsigned& nx) {
    const unsigned G = gridDim.x * gridDim.y * gridDim.z;
    unsigned sum, cnt, mine, sp = 0u;
    for (;;) {
        sum = 0u; cnt = 0u; mine = 0u;
#pragma unroll
        for (unsigned j = 0; j < 16; ++j) { const unsigned c = xb_ld(&bar[XB_XCNT(j)]); sum += c; cnt += (c > 0u) ? 1u : 0u; mine = (j == x) ? c : mine; }
        if (sum == G) break;
        __builtin_amdgcn_s_sleep(1);
        if ((++sp & 255u) == 0u) { if (xb_ld(&bar[XB_TMO])) break; if (sp > XB_SPIN_CAP) { atomicAdd(&bar[XB_TMO], 1u); break; } }
    }
    nloc = mine > 0u ? mine : 1u; nx = cnt > 0u ? cnt : 1u;
}
__device__ __forceinline__ void xcd_barrier(const XcdBarrier& b) {
    asm volatile("s_waitcnt vmcnt(0)" ::: "memory");
    __syncthreads();
    if (threadIdx.x == 0) {
        unsigned* bar = b.bar;
        __builtin_amdgcn_s_waitcnt(0);
        unsigned nloc = b.st[0], nx = b.st[1];
        if (nloc == 0u) { xcd_barrier_complete(bar, b.x, nloc, nx); b.st[0] = nloc; b.st[1] = nx; }
        const unsigned old = xb_add(&bar[XB_XSUB(b.x)], 1u);
        const unsigned gen = old / nloc;
        if (old + 1u == (gen + 1u) * nloc) {
            __builtin_amdgcn_fence(__ATOMIC_RELEASE, "agent");
            asm volatile("s_waitcnt vmcnt(0)" ::: "memory");
            const unsigned og = xb_add(&bar[XB_TOP], 1u);
            const unsigned tg = og / nx;
            if (og + 1u == (tg + 1u) * nx) xb_add(&bar[XB_TOPGEN], 1u);
            else XB_SPIN(xb_ld(&bar[XB_TOPGEN]) == tg, bar);
            __builtin_amdgcn_fence(__ATOMIC_ACQUIRE, "agent");
            xb_add(&bar[XB_XGEN(b.x)], 1u);
            asm volatile("s_waitcnt vmcnt(0)" ::: "memory");
        } else {
            XB_SPIN(xb_ld(&bar[XB_XGEN(b.x)]) == gen, bar);
            __builtin_amdgcn_fence(__ATOMIC_ACQUIRE, "agent");
            asm volatile("s_waitcnt vmcnt(0)" ::: "memory");
        }
    }
    __syncthreads();
}

struct Args { const float* in[27]; const int* page_table; float* out; unsigned char* ws; float* out_real; int ph_lo, ph_hi; };
struct Frame {
    LAS unsigned char* lds;
    int tid, lane, wave, vcu, G;
    const float* const* in;
    float* out; unsigned char* ws;
};
__device__ __forceinline__ float wave_sum(float v) {
#pragma unroll
    for (int o = 1; o < 64; o <<= 1) v += __shfl_xor(v, o);
    return v;
}

__host__ __device__ __forceinline__ int perm_plain(int g) { const int bj = g >> 7, wc = (g >> 5) & 3, n = (g >> 4) & 1, fq = (g >> 2) & 3, j = g & 3; return 128 * bj + 32 * wc + 8 * fq + 4 * n + j; }
__host__ __device__ __forceinline__ int perm_rot128(int g) { const int bj = g >> 7, wc = (g >> 5) & 3, n = (g >> 4) & 1, fq = (g >> 2) & 3, j = g & 3; return 128 * bj + 64 * n + 16 * wc + 4 * fq + j; }
__host__ __device__ __forceinline__ int perm_rot64(int g) { const int bj = g >> 7, wc = (g >> 5) & 3, n = (g >> 4) & 1, fq = (g >> 2) & 3, j = g & 3; return 64 * (2 * bj + (wc >> 1)) + 32 * n + 16 * (wc & 1) + 4 * fq + j; }
__device__ __forceinline__ int win_src_col(int gg) {
    const int pn = gg >> 8, g = gg & 255;
    if (pn < 4)  return C_XA + pn * 256 + perm_plain(g);
    if (pn < 8)  return C_GA + (pn - 4) * 256 + perm_plain(g);
    if (pn < 12) return C_Q + (pn - 8) * 256 + perm_rot128(g);
    if (pn == 12) return C_K + perm_rot128(g);
    if (pn == 13) return C_V + perm_plain(g);
    if (pn < 18) return C_GB + (pn - 14) * 256 + perm_plain(g);
    if (pn < 20) return C_QI + (pn - 18) * 256 + perm_rot64(g);
    if (pn == 20) { const int bj = g >> 7, wc = (g >> 5) & 3, n = (g >> 4) & 1, fq = (g >> 2) & 3, j = g & 3;
        if (wc == 0) return C_KI + 32 * bj + 16 * n + 4 * fq + j;
        if (wc == 1 && bj == 0 && n == 0 && fq < 2) return C_WI + 4 * fq + j;
        return -1; }
    if (pn < 25) return C_MA + (pn - 21) * 256 + perm_plain(g);
    return C_MB + (pn - 25) * 256 + perm_plain(g);
}

template <int MODE>
__device__ __forceinline__ void p0_transpose_item(const float* W, int K, int N, bf16* WT, LAS float* scr, int item, int lane, int ndst) {
    const int nblk = ndst / 32, kb = item / nblk, nb = item % nblk, k0 = 64 * kb, g0 = 32 * nb;
    const int gme = g0 + (lane & 31);
    int src;
    if (MODE == 0) src = win_src_col(gme);
    else if (MODE == 1) src = (gme & ~255) + perm_plain(gme & 255);
    else src = gme;
    float wl[32];
#pragma unroll
    for (int i = 0; i < 32; ++i) { const int kk = 2 * i + (lane >> 5); wl[i] = (src >= 0) ? W[(size_t)(k0 + kk) * N + src] : 0.f; }
#pragma unroll
    for (int i = 0; i < 32; ++i) { const int kk = 2 * i + (lane >> 5); scr[kk * 33 + (lane & 31)] = wl[i]; }
    LDS_WAIT(); asm volatile("" ::: "memory");
    const int c = lane & 7;
#pragma unroll
    for (int j = 0; j < 4; ++j) { const int n = (lane >> 3) + 8 * j; const LAS float* s = scr + (8 * c) * 33 + n;
        v4u o; o.x = pk2(s[0 * 33], s[1 * 33]); o.y = pk2(s[2 * 33], s[3 * 33]); o.z = pk2(s[4 * 33], s[5 * 33]); o.w = pk2(s[6 * 33], s[7 * 33]);
        *(GAS v4u*)(WT + (size_t)(g0 + n) * K + k0 + 8 * c) = o; }
    LDS_WAIT(); asm volatile("" ::: "memory");
}

__device__ __forceinline__ void p0_prologue(Frame& F) {
    LAS float* scr = (LAS float*)(F.lds + F.wave * 16384);
    const int gw = F.vcu * NWAVES + F.wave, NGW = F.G * NWAVES, lane = F.lane;
    const float* c_prompt = F.in[8]; const float* c_sample = F.in[9]; const float* w_ada = F.in[10]; const float* b_ada = F.in[11];
    float* MOD = (float*)(F.ws + WS_MOD);
    for (int bt = F.vcu; bt < 48 * 4; bt += F.G) {
        const int cg = bt % 48, kq = bt / 48, col = cg * 64 + lane, k0 = (kq * 8 + F.wave) * 32;
        float wv[32];
#pragma unroll
        for (int kk = 0; kk < 32; ++kk) wv[kk] = w_ada[(size_t)(k0 + kk) * 3072 + col];
        float sc[40];
#pragma unroll
        for (int r = 0; r < 40; ++r) { const float* cr = (r < 8) ? (c_prompt + (size_t)r * DM) : (c_sample + (size_t)(r - 8) * DM); const float cv = cr[k0 + (lane & 31)]; sc[r] = siluf_(cv); }
        float acc[40];
#pragma unroll
        for (int r = 0; r < 40; ++r) acc[r] = 0.f;
#pragma unroll
        for (int kk = 0; kk < 32; ++kk) {
#pragma unroll
            for (int r = 0; r < 40; ++r) acc[r] = fmaf(__int_as_float(__builtin_amdgcn_readlane(__float_as_int(sc[r]), kk)), wv[kk], acc[r]);
        }
        LAS float* red = (LAS float*)F.lds;
        __syncthreads();
#pragma unroll
        for (int r = 0; r < 40; ++r) red[(F.wave * 40 + r) * 64 + lane] = acc[r];
        __syncthreads();
        for (int e = F.tid; e < 40 * 64; e += NTHR) { const int r = e >> 6, l = e & 63; float t = 0.f;
#pragma unroll
            for (int ww = 0; ww < 8; ++ww) t += red[(ww * 40 + r) * 64 + l];
            if (kq == 0) t += b_ada[cg * 64 + l];
            atomicAdd(MOD + (size_t)r * 3072 + cg * 64 + l, t); }
        asm volatile("s_waitcnt vmcnt(0)" ::: "memory");
        __syncthreads();
        if (F.tid == 0) { __builtin_amdgcn_fence(__ATOMIC_RELEASE, "agent"); __hip_atomic_fetch_add((unsigned*)(F.ws + WS_CTL) + CW_MODCNT, 1u, __ATOMIC_RELAXED, __HIP_MEMORY_SCOPE_AGENT); }
    }
    {
        f32x2* RT128 = (f32x2*)(F.ws + WS_RT128); f32x2* RT64 = (f32x2*)(F.ws + WS_RT64);
        const int gt = gw * 64 + lane, NGT = NGW * 64;
        for (int i = gt; i < 4097 * 64; i += NGT) { const int p = i >> 6, d = i & 63; const float pos = (p == 4096) ? 16384.f : (float)p;
            const float inv = powf(10000.f, -(float)d / 64.f); const float ang = pos * inv; float s, c; sincosf(ang, &s, &c); RT128[i] = (f32x2){c, s}; }
        for (int i = gt; i < 4097 * 32; i += NGT) { const int p = i >> 5, d = i & 31; const float pos = (p == 4096) ? 16384.f : (float)p;
            const float inv = powf(10000.f, -(float)d / 32.f); const float ang = pos * inv; float s, c; sincosf(ang, &s, &c); RT64[i] = (f32x2){c, s}; }
        const float* sconv = F.in[5]; float* ocs = F.out + O_CS;
        for (int i = gt; i < NS * 2 * DM; i += NGT) { const int b = i / (2 * DM), r = (i / DM) & 1, ch = i % DM; ocs[(size_t)b * 3 * DM + r * DM + ch] = sconv[(size_t)b * 3 * DM + (r + 1) * DM + ch]; }
    }
}

__device__ __forceinline__ void p1_weights(Frame& F) {
    LAS float* scr = (LAS float*)(F.lds + F.wave * 16384);
    const int gw = F.vcu * NWAVES + F.wave, NGW = F.G * NWAVES, lane = F.lane;
    {
        constexpr int I_IN = (DM / 64) * (N_IN_PAD / 32), I_SQ = (DM / 64) * (DM / 32);
        for (int it = gw; it < I_IN + 3 * I_SQ; it += NGW) {
            int r = it;
            if (r < I_IN) { p0_transpose_item<0>(F.in[13], DM, D_IN, (bf16*)(F.ws + WS_WIN), scr, r, lane, N_IN_PAD); continue; } r -= I_IN;
            if (r < I_SQ) { p0_transpose_item<1>(F.in[23], DM, DM, (bf16*)(F.ws + WS_WPA), scr, r, lane, DM); continue; } r -= I_SQ;
            if (r < I_SQ) { p0_transpose_item<1>(F.in[24], DM, DM, (bf16*)(F.ws + WS_WPB), scr, r, lane, DM); continue; } r -= I_SQ;
            p0_transpose_item<2>(F.in[25], DM, DM, (bf16*)(F.ws + WS_WO), scr, r, lane, DM);
        }
    }
}
__device__ __forceinline__ void p0b_norm(Frame& F) {
    const int gw = F.vcu * NWAVES + F.wave, NGW = F.G * NWAVES, lane = F.lane;
    const float* MOD = (const float*)(F.ws + WS_MOD); const float* gn = F.in[12];
    bf16* XN = (bf16*)(F.ws + WS_XN);
    f32x4 g4[4];
#pragma unroll
    for (int q = 0; q < 4; ++q) g4[q] = *(const f32x4*)(gn + 512 * (q >> 1) + 8 * lane + 4 * (q & 1));
    const bool xloc = (F.G % 8 == 0);
    const int WX = xloc ? NGW / 8 : NGW, lw = xloc ? gw % WX : gw, rbase = xloc ? SEQ * (gw / WX) : 0, RSPAN = xloc ? SEQ : MP;
    const int NPR = (lw < RSPAN) ? (RSPAN - lw + WX - 1) / WX : 0;
#define NORM_ROWAT(i_) (((i_) < NPR) ? (rbase + lw + WX * (i_)) : (((i_) == NPR && gw < NS) ? (MP + gw) : -1))
#define NORM_LOADX(dst_, m_) do { const int mm_ = (m_); const float* xrow_ = (mm_ < MP) ? (F.in[0] + (size_t)mm_ * DM) : (F.in[1] + (size_t)(mm_ - MP) * DM); \
        const GAS f32x4* xr_ = (const GAS f32x4*)xrow_ + 2 * lane; dst_[0] = xr_[0]; dst_[1] = xr_[1]; dst_[2] = xr_[128]; dst_[3] = xr_[129]; } while (0)
    f32x4 sc4[4], sh4[4], n1[4], n2[4];
    int cur_mr = -1;
    int m0 = NORM_ROWAT(0), m1 = NORM_ROWAT(1);
    if (m0 >= 0) NORM_LOADX(n1, m0);
    if (m1 >= 0) NORM_LOADX(n2, m1);
    for (int it = 0; m0 >= 0; ++it) {
        const int m2 = NORM_ROWAT(it + 2);
        const int mr = (m0 < MP) ? (m0 >> 12) : (8 + m0 - MP);
        if (mr != cur_mr) { cur_mr = mr; const float* sh_ = MOD + (size_t)mr * 3072; const float* sc_ = sh_ + 1024;
#pragma unroll
            for (int q = 0; q < 4; ++q) { const int c_ = 512 * (q >> 1) + 8 * lane + 4 * (q & 1); sc4[q] = *(const f32x4*)(sc_ + c_); sh4[q] = *(const f32x4*)(sh_ + c_); } }
        f32x4 v[4]; float s = 0.f;
#pragma unroll
        for (int q = 0; q < 4; ++q) { v[q] = n1[q]; n1[q] = n2[q]; }
        asm volatile("" ::: "memory");
        if (m2 >= 0) NORM_LOADX(n2, m2);
        asm volatile("" ::: "memory");
#pragma unroll
        for (int q = 0; q < 4; ++q) s += (v[q].x * v[q].x + v[q].y * v[q].y) + (v[q].z * v[q].z + v[q].w * v[q].w);
        const float rstd = 1.0f / sqrtf(wave_sum(s) * (1.f / DM) + EPS);
        GAS v4u* o16 = (GAS v4u*)(XN + (size_t)m0 * DM) + lane;
#pragma unroll
        for (int j = 0; j < 2; ++j) { unsigned pk[4];
#pragma unroll
            for (int h = 0; h < 2; ++h) { const f32x4 x4 = v[2 * j + h], gg = g4[2 * j + h], ss = sc4[2 * j + h], hh = sh4[2 * j + h];
                const float y0 = x4.x * rstd * gg.x * (1.f + ss.x) + hh.x, y1 = x4.y * rstd * gg.y * (1.f + ss.y) + hh.y;
                const float y2 = x4.z * rstd * gg.z * (1.f + ss.z) + hh.z, y3 = x4.w * rstd * gg.w * (1.f + ss.w) + hh.w;
                pk[2 * h] = pk2(y0, y1); pk[2 * h + 1] = pk2(y2, y3); }
            o16[64 * j] = (v4u){pk[0], pk[1], pk[2], pk[3]}; }
        m0 = m1; m1 = m2;
    }
#undef NORM_ROWAT
#undef NORM_LOADX
}

struct EpiIn {
    static constexpr bool PROBE_TWICE = true;
    unsigned char* ws; float* out; const float* lng; const float* lnb;
    __device__ __forceinline__ void operator()(const pg8::f32x4 (&acc)[2][2][4][2], const pg8::Unit& u, int wr, int wc, int fr, int fq) const {
        using pg8::cvt_pk_bf16;
        asm volatile("" : "+v"(fr), "+v"(fq));
        const int pn = u.pn; const bool samp = (u.pm == MP / 256);
        const int rbase = u.pm * 256 + wr * 64 + fr;
        if (pn < 8 || pn == 13 || (pn >= 14 && pn < 18) || pn >= 21) {
            bf16* dst; int tcol; int act;
            if (pn < 4) { dst = (bf16*)(ws + WS_XA); tcol = pn * 256; act = 0; }
            else if (pn < 8) { dst = (bf16*)(ws + WS_SGA); tcol = (pn - 4) * 256; act = 1; }
            else if (pn == 13) { dst = (bf16*)(ws + WS_VB); tcol = 0; act = 0; }
            else if (pn < 18) { dst = (bf16*)(ws + WS_SGB); tcol = (pn - 14) * 256; act = 1; }
            else if (pn < 25) { dst = (bf16*)(ws + WS_SMA); tcol = (pn - 21) * 256; act = 2; }
            else { dst = (bf16*)(ws + WS_SMB); tcol = (pn - 25) * 256; act = 2; }
            const int ld = (pn == 13) ? 256 : DM;
#pragma unroll
            for (int ai = 0; ai < 2; ++ai)
#pragma unroll
                for (int m = 0; m < 4; ++m) {
                    const int row = rbase + ai * 128 + m * 16;
#pragma unroll
                    for (int bj = 0; bj < 2; ++bj) {
                        pg8::f32x4 v0 = acc[ai][bj][m][0], v1 = acc[ai][bj][m][1];
                        const int c0 = tcol + 128 * bj + 32 * wc + 8 * fq;
                        if (pn == 13) {
                            float* o = nullptr;
                            if (!samp) o = out + O_VP + (size_t)row * 256 + c0; else if (row - MP < NS) o = out + O_VS + (size_t)(row - MP) * 256 + c0;
                            if (o) { *(pg8::f32x4*)o = v0; *(pg8::f32x4*)(o + 4) = v1; }
                        }
                        if (pn < 4) {
                            if (!samp) { const int t = row & (SEQ - 1); if (t >= SEQ - 3) { float* o = out + O_CP + (size_t)(row >> 12) * 3 * DM + (size_t)(t - (SEQ - 3)) * DM + c0; *(pg8::f32x4*)o = v0; *(pg8::f32x4*)(o + 4) = v1; } }
                            else if (row - MP < NS) { float* o = out + O_CS + (size_t)(row - MP) * 3 * DM + 2 * DM + c0; *(pg8::f32x4*)o = v0; *(pg8::f32x4*)(o + 4) = v1; }
                        }
                        if (act == 1) {
#pragma unroll
                            for (int j = 0; j < 4; ++j) { v0[j] = siluf_(v0[j]); v1[j] = siluf_(v1[j]); }
                        } else if (act == 2) {
#pragma unroll
                            for (int j = 0; j < 4; ++j) { v0[j] = sigmoidf_(v0[j]); v1[j] = sigmoidf_(v1[j]); }
                        }
                        pg8::u32x4 w; w.x = cvt_pk_bf16(v0[0], v0[1]); w.y = cvt_pk_bf16(v0[2], v0[3]); w.z = cvt_pk_bf16(v1[0], v1[1]); w.w = cvt_pk_bf16(v1[2], v1[3]);
                        __builtin_nontemporal_store(w, (pg8::u32x4*)(dst + (size_t)row * ld + c0));
                    }
                }
        } else if (pn < 13) {
            const f32x2* RT = (const f32x2*)(ws + WS_RT128);
            const int d0 = 16 * wc + 4 * fq;
            const bool isk = (pn == 12);
            bf16* dst = isk ? (bf16*)(ws + WS_KB) : (bf16*)(ws + WS_Q); const int ld = isk ? 256 : DM; const int tcol = isk ? 0 : (pn - 8) * 256;
            pg8::f32x4 tb[2][4][2];
#pragma unroll
            for (int ai = 0; ai < 2; ++ai)
#pragma unroll
                for (int m = 0; m < 4; ++m) { const int row = rbase + ai * 128 + m * 16; const int p = samp ? 4096 : (row & (SEQ - 1));
                    tb[ai][m][0] = *(const pg8::f32x4*)(RT + (size_t)p * 64 + d0); tb[ai][m][1] = *(const pg8::f32x4*)(RT + (size_t)p * 64 + d0 + 2); }
            asm volatile("" ::: "memory");
#pragma unroll
            for (int ai = 0; ai < 2; ++ai) {
#pragma unroll
                for (int m = 0; m < 4; ++m) {
                    const int row = rbase + ai * 128 + m * 16;
                    const pg8::f32x4 cs01 = tb[ai][m][0], cs23 = tb[ai][m][1];
                    const float c[4] = {cs01[0], cs01[2], cs23[0], cs23[2]}, s[4] = {cs01[1], cs01[3], cs23[1], cs23[3]};
#pragma unroll
                    for (int bj = 0; bj < 2; ++bj) {
                        const pg8::f32x4 x1 = acc[ai][bj][m][0], x2 = acc[ai][bj][m][1];
                        pg8::f32x4 o1, o2;
#pragma unroll
                        for (int j = 0; j < 4; ++j) { o1[j] = x1[j] * c[j] - x2[j] * s[j]; o2[j] = x2[j] * c[j] + x1[j] * s[j]; }
                        const int c1 = tcol + 128 * bj + d0;
                        if (isk) {
                            float* o = nullptr;
                            if (!samp) o = out + O_KP + (size_t)row * 256 + c1; else if (row - MP < NS) o = out + O_KS + (size_t)(row - MP) * 256 + c1;
                            if (o) { *(pg8::f32x4*)o = o1; *(pg8::f32x4*)(o + 64) = o2; }
                        }
                        pg8::u32x2 w1, w2; w1.x = cvt_pk_bf16(o1[0], o1[1]); w1.y = cvt_pk_bf16(o1[2], o1[3]); w2.x = cvt_pk_bf16(o2[0], o2[1]); w2.y = cvt_pk_bf16(o2[2], o2[3]);
                        { auto s0 = __builtin_amdgcn_permlane16_swap(w1.x, w2.x, false, false); auto s1 = __builtin_amdgcn_permlane16_swap(w1.y, w2.y, false, false);
                          pg8::u32x4 wv; wv.x = s0[0]; wv.y = s1[0]; wv.z = s0[1]; wv.w = s1[1];
                          __builtin_nontemporal_store(wv, (pg8::u32x4*)(dst + (size_t)row * ld + ((fq & 1) ? (c1 - 4 + 64) : c1))); }
                    }
                }
            }
        } else if (pn < 20) {
            const f32x2* RT = (const f32x2*)(ws + WS_RT64);
            const int d0 = 16 * (wc & 1) + 4 * fq;
            bf16* dst = (bf16*)(ws + WS_QI);
            pg8::f32x4 tb[2][4][2];
#pragma unroll
            for (int ai = 0; ai < 2; ++ai)
#pragma unroll
                for (int m = 0; m < 4; ++m) { const int row = rbase + ai * 128 + m * 16; const int p = samp ? 4096 : (row & (SEQ - 1));
                    tb[ai][m][0] = *(const pg8::f32x4*)(RT + (size_t)p * 32 + d0); tb[ai][m][1] = *(const pg8::f32x4*)(RT + (size_t)p * 32 + d0 + 2); }
            asm volatile("" ::: "memory");
#pragma unroll
            for (int ai = 0; ai < 2; ++ai) {
#pragma unroll
                for (int m = 0; m < 4; ++m) {
                    const int row = rbase + ai * 128 + m * 16;
                    const pg8::f32x4 cs01 = tb[ai][m][0], cs23 = tb[ai][m][1];
                    const float c[4] = {cs01[0], cs01[2], cs23[0], cs23[2]}, s[4] = {cs01[1], cs01[3], cs23[1], cs23[3]};
#pragma unroll
                    for (int bj = 0; bj < 2; ++bj) {
                        const pg8::f32x4 x1 = acc[ai][bj][m][0], x2 = acc[ai][bj][m][1];
                        pg8::f32x4 o1, o2;
#pragma unroll
                        for (int j = 0; j < 4; ++j) { o1[j] = x1[j] * c[j] - x2[j] * s[j]; o2[j] = x2[j] * c[j] + x1[j] * s[j]; }
                        const int hh = (pn - 18) * 4 + 2 * bj + (wc >> 1);
                        const int c1 = hh * 64 + d0;
                        pg8::u32x2 w1, w2; w1.x = cvt_pk_bf16(o1[0], o1[1]); w1.y = cvt_pk_bf16(o1[2], o1[3]); w2.x = cvt_pk_bf16(o2[0], o2[1]); w2.y = cvt_pk_bf16(o2[2], o2[3]);
                        { auto s0 = __builtin_amdgcn_permlane16_swap(w1.x, w2.x, false, false); auto s1 = __builtin_amdgcn_permlane16_swap(w1.y, w2.y, false, false);
                          pg8::u32x4 wv; wv.x = s0[0]; wv.y = s1[0]; wv.z = s0[1]; wv.w = s1[1];
                          __builtin_nontemporal_store(wv, (pg8::u32x4*)(dst + (size_t)row * 512 + ((fq & 1) ? (c1 - 4 + 32) : c1))); }
                    }
                }
            }
        } else {
            if (wc == 0) {
                const f32x2* RT = (const f32x2*)(ws + WS_RT64);
                bf16* dst = (bf16*)(ws + WS_KI);
#pragma unroll
                for (int ai = 0; ai < 2; ++ai)
#pragma unroll
                    for (int m = 0; m < 4; ++m) {
                        const int row = rbase + ai * 128 + m * 16;
                        const int p = samp ? 4096 : (row & (SEQ - 1));
                        float sum = 0.f;
#pragma unroll
                        for (int bj = 0; bj < 2; ++bj)
#pragma unroll
                            for (int n = 0; n < 2; ++n) { const pg8::f32x4 x = acc[ai][bj][m][n]; sum += (x[0] + x[1]) + (x[2] + x[3]); }
                        sum += __shfl_xor(sum, 16); sum += __shfl_xor(sum, 32);
                        const float mu = sum * (1.f / 64.f); float q = 0.f;
#pragma unroll
                        for (int bj = 0; bj < 2; ++bj)
#pragma unroll
                            for (int n = 0; n < 2; ++n) { const pg8::f32x4 d = acc[ai][bj][m][n] - mu; q += (d[0] * d[0] + d[1] * d[1]) + (d[2] * d[2] + d[3] * d[3]); }
                        q += __shfl_xor(q, 16); q += __shfl_xor(q, 32);
                        const float rstd = 1.0f / sqrtf(q * (1.f / 64.f) + EPS);
                        float* o = nullptr;
                        if (!samp) o = out + O_IKP + (size_t)row * 64; else if (row - MP < NS) o = out + O_IKS + (size_t)(row - MP) * 64;
#pragma unroll
                        for (int n = 0; n < 2; ++n) {
                            const int d0 = 16 * n + 4 * fq;
                            const pg8::f32x4 g1 = *(const pg8::f32x4*)(lng + d0), g2 = *(const pg8::f32x4*)(lng + 32 + d0), b1 = *(const pg8::f32x4*)(lnb + d0), b2 = *(const pg8::f32x4*)(lnb + 32 + d0);
                            const pg8::f32x4 cs01 = *(const pg8::f32x4*)(RT + (size_t)p * 32 + d0), cs23 = *(const pg8::f32x4*)(RT + (size_t)p * 32 + d0 + 2);
                            const float c[4] = {cs01[0], cs01[2], cs23[0], cs23[2]}, s[4] = {cs01[1], cs01[3], cs23[1], cs23[3]};
                            pg8::f32x4 o1, o2;
#pragma unroll
                            for (int j = 0; j < 4; ++j) { const float y1 = (acc[ai][0][m][n][j] - mu) * rstd * g1[j] + b1[j], y2 = (acc[ai][1][m][n][j] - mu) * rstd * g2[j] + b2[j];
                                o1[j] = y1 * c[j] - y2 * s[j]; o2[j] = y2 * c[j] + y1 * s[j]; }
                            if (o) { *(pg8::f32x4*)(o + d0) = o1; *(pg8::f32x4*)(o + 32 + d0) = o2; }
                            pg8::u32x2 w1, w2; w1.x = cvt_pk_bf16(o1[0], o1[1]); w1.y = cvt_pk_bf16(o1[2], o1[3]); w2.x = cvt_pk_bf16(o2[0], o2[1]); w2.y = cvt_pk_bf16(o2[2], o2[3]);
                            *(pg8::u32x2*)(dst + (size_t)row * 64 + d0) = w1; *(pg8::u32x2*)(dst + (size_t)row * 64 + 32 + d0) = w2;
                        }
                    }
            } else if (wc == 1 && fq < 2) {
                float* WI = (float*)(ws + WS_WI);
#pragma unroll
                for (int ai = 0; ai < 2; ++ai)
#pragma unroll
                    for (int m = 0; m < 4; ++m) { const int row = rbase + ai * 128 + m * 16; *(pg8::f32x4*)(WI + (size_t)row * 8 + 4 * fq) = acc[ai][0][m][0] * IDX_W_SCALE; }
            }
        }
    }
};


__device__ __forceinline__ float softplus_neg(float lam) { const float x = -lam; return (x > 20.f) ? x : log1pf(__expf(x)); }
__device__ __forceinline__ void gate_au(float r, float ig, float xc, float sp, float& a, float& u) {
    a = __builtin_amdgcn_exp2f(-11.541560327111707f * r * sp);
    u = __builtin_amdgcn_sqrtf(fmaxf(1.0f - a * a, 0.f)) * (ig * xc);
}
__device__ __forceinline__ void p0_build_wg(Frame& F) {
    const int gw = F.vcu * NWAVES + F.wave, NGW = F.G * NWAVES, lane = F.lane;
    const float* w_ra = F.in[16]; const float* w_rx = F.in[18]; v4u* WG = (v4u*)(F.ws + WS_WG);
    for (int task = gw; task < 4 * 16 * 16; task += NGW) {
        const int s = task & 15, cg = (task >> 4) & 15, blk = task >> 8, n = lane & 31, hi = lane >> 5;
        const float* W = (n < 16) ? w_ra : w_rx; const int col = 16 * cg + (n & 15);
        float v[8];
#pragma unroll
        for (int j = 0; j < 8; ++j) v[j] = W[((size_t)blk * 256 + 16 * s + 8 * hi + j) * 256 + col];
        v4u o; o.x = pk2(v[0], v[1]); o.y = pk2(v[2], v[3]); o.z = pk2(v[4], v[5]); o.w = pk2(v[6], v[7]);
        WG[(size_t)task * 64 + lane] = o;
    }
}
#define BF_LO(u_) __uint_as_float((u_) << 16)
#define BF_HI(u_) __uint_as_float((u_) & 0xffff0000u)
__device__ __forceinline__ void p3_conv_pass(Frame& F) {
    const bf16* XA = (const bf16*)(F.ws + WS_XA); bf16* XC = (bf16*)(F.ws + WS_XC);
    const float* w_conv = F.in[14]; const float* b_conv = F.in[15];
    const int nskip = (F.G > 64) ? 32 : 0;
    if (F.vcu < nskip) return;
    const int gt = (F.vcu - nskip) * NTHR + F.tid, NGT = (F.G - nskip) * NTHR;
    const int co = gt & 127;
    float cw[4][8], cb[8];
#pragma unroll
    for (int e = 0; e < 8; e += 4) { const f32x4 b4 = *(const f32x4*)(b_conv + 8 * co + e); cb[e] = b4.x; cb[e + 1] = b4.y; cb[e + 2] = b4.z; cb[e + 3] = b4.w;
#pragma unroll
        for (int j = 0; j < 4; ++j) { const f32x4 w4 = *(const f32x4*)(w_conv + (size_t)j * DM + 8 * co + e); cw[j][e] = w4.x; cw[j][e + 1] = w4.y; cw[j][e + 2] = w4.z; cw[j][e + 3] = w4.w; } }
    const int NTASK = (MP / 8) * 128;
    v4u nraw[11];
#define CONV_LOAD(task_) do { const int strip_ = (task_) >> 7, row0_ = strip_ * 8, t0_ = row0_ & (SEQ - 1); \
        _Pragma("unroll") for (int r = 0; r < 11; ++r) { nraw[r] = (v4u){0u, 0u, 0u, 0u}; if (t0_ + r - 3 >= 0) nraw[r] = *(const GAS v4u*)(XA + (size_t)(row0_ + r - 3) * DM + 8 * co); } } while (0)
    if (gt < NTASK) CONV_LOAD(gt);
    for (int task = gt; task < NTASK; task += NGT) {
        const int strip = task >> 7, row0 = strip * 8;
        v4u raw[11];
#pragma unroll
        for (int r = 0; r < 11; ++r) raw[r] = nraw[r];
        asm volatile("" ::: "memory");
        if (task + NGT < NTASK) CONV_LOAD(task + NGT);
        asm volatile("" ::: "memory");
#pragma unroll
        for (int r = 0; r < 8; ++r) { float y[8];
#pragma unroll
            for (int e = 0; e < 8; ++e) y[e] = cb[e];
#pragma unroll
            for (int j = 0; j < 4; ++j) { const v4u q = raw[r + j];
                y[0] = fmaf(cw[j][0], BF_LO(q.x), y[0]); y[1] = fmaf(cw[j][1], BF_HI(q.x), y[1]); y[2] = fmaf(cw[j][2], BF_LO(q.y), y[2]); y[3] = fmaf(cw[j][3], BF_HI(q.y), y[3]);
                y[4] = fmaf(cw[j][4], BF_LO(q.z), y[4]); y[5] = fmaf(cw[j][5], BF_HI(q.z), y[5]); y[6] = fmaf(cw[j][6], BF_LO(q.w), y[6]); y[7] = fmaf(cw[j][7], BF_HI(q.w), y[7]); }
            v4u o; o.x = pk2(y[0], y[1]); o.y = pk2(y[2], y[3]); o.z = pk2(y[4], y[5]); o.w = pk2(y[6], y[7]);
            *(GAS v4u*)(XC + (size_t)(row0 + r) * DM + 8 * co) = o; }
    }
#undef CONV_LOAD
}
constexpr int RG_XC = 0, RG_XROW = 528  , RG_AU = 128 * RG_XROW, RG_CAR = RG_AU + 32768, RG_HP = RG_CAR + 4096, RG_BF = RG_HP + 256, RG_HB = RG_BF + 32768  , RG_END = RG_HB + 16384;
typedef float f32x16 __attribute__((ext_vector_type(16)));
__device__ __forceinline__ void p2_rglru_prompt_unit(Frame& F, int unit) {
    const int b = unit >> 5, nblk = (unit >> 3) & 3, cs = unit & 7;
    const int tid = F.tid, lane = F.lane, w = F.wave, wm = w & 3, wn = w >> 2;
    const bf16* XA = (const bf16*)(F.ws + WS_XA); const bf16* SGA = (const bf16*)(F.ws + WS_SGA); bf16* PA = (bf16*)(F.ws + WS_PA);
    const float* w_conv = F.in[14]; const float* b_conv = F.in[15]; const float* b_ra = F.in[17]; const float* b_rx = F.in[19]; const float* lam = F.in[20];
    LAS unsigned char* lds = F.lds;
    __syncthreads();
    { const v4u* WG = (const v4u*)(F.ws + WS_WG) + ((size_t)(nblk * 16 + 2 * cs) * 16) * 64;
#pragma unroll
      for (int k = 0; k < 4; ++k) { const int idx = tid + 512 * k; *(LAS v4u*)(lds + RG_BF + idx * 16) = WG[idx]; } }
    const int col = lane & 31, isI = (col >> 4) & 1, chl = 16 * wn + (col & 15), chb = 32 * cs + chl, chg = nblk * 256 + chb;
    const float gbias = isI ? b_rx[chg] : b_ra[chg]; const float sp = softplus_neg(lam[chg]);
    const int co = tid & 31, rs = tid >> 5;
    const int sch = tid & 31, sj = tid >> 5;
    if (tid < 32) ((LAS float*)(lds + RG_HP))[tid] = 0.f;
    const size_t rowb = (size_t)b * SEQ;
    const int och = nblk * 256 + 32 * cs + sch;
    const bf16* xsrc = (const bf16*)(F.ws + WS_XC) + (rowb + 8 * rs) * DM + nblk * 256 + 8 * co;
    v4u raw[8];
#pragma unroll
    for (int r = 0; r < 8; ++r) raw[r] = *(const GAS v4u*)(xsrc + (size_t)r * DM);
    for (int tile = 0; tile < SEQ / 128; ++tile) {
        const int t0 = tile * 128;
#pragma unroll
        for (int r = 0; r < 8; ++r) *(LAS v4u*)(lds + RG_XC + (8 * rs + r) * RG_XROW + (co << 4)) = raw[r];
        if (tile + 1 < SEQ / 128) {
#pragma unroll
            for (int r = 0; r < 8; ++r) raw[r] = *(const GAS v4u*)(xsrc + (size_t)(t0 + 128 + r) * DM);
        }
        const size_t orow = rowb + t0 + 8 * sj;
        const size_t pa_off = (rowb + t0 + (tid >> 2)) * DM + nblk * 256 + 32 * cs + 8 * (tid & 3);
        const v4u sg4 = *(const GAS v4u*)(SGA + pa_off);
        __syncthreads();
        f32x16 acc0 = {}, acc1 = {};
        { const int row = 32 * wm + (lane & 31), hi = lane >> 5;
#pragma unroll
          for (int s2 = 0; s2 < 16; s2 += 2) {
              const bf16x8 a0 = *(const LAS bf16x8*)(lds + RG_XC + row * RG_XROW + ((2 * s2 + hi) << 4));
              const bf16x8 a1 = *(const LAS bf16x8*)(lds + RG_XC + row * RG_XROW + ((2 * s2 + 2 + hi) << 4));
              const bf16x8 b0 = *(const LAS bf16x8*)(lds + RG_BF + ((wn * 16 + s2) * 64 + lane) * 16);
              const bf16x8 b1 = *(const LAS bf16x8*)(lds + RG_BF + ((wn * 16 + s2 + 1) * 64 + lane) * 16);
              acc0 = __builtin_amdgcn_mfma_f32_32x32x16_bf16(a0, b0, acc0, 0, 0, 0);
              acc1 = __builtin_amdgcn_mfma_f32_32x32x16_bf16(a1, b1, acc1, 0, 0, 0); } }
        { const int hi = lane >> 5;
          float g[16];
#pragma unroll
          for (int i = 0; i < 16; ++i) g[i] = sigmoidf_(acc0[i] + acc1[i] + gbias);
          float rcv[8];
#pragma unroll
          for (int k = 0; k < 8; ++k) { const float snd = isI ? g[k] : g[8 + k]; rcv[k] = __shfl_xor(snd, 16); }
#pragma unroll
          for (int k = 0; k < 8; ++k) { const int i = isI ? (8 + k) : k; const float rr = isI ? rcv[k] : g[k], ii = isI ? g[8 + k] : rcv[k];
              const int tok = 32 * wm + (i & 3) + 8 * (i >> 2) + 4 * hi;
              const unsigned short xb = *(const LAS unsigned short*)(lds + RG_XC + tok * RG_XROW + chb * 2);
              float a, u; gate_au(rr, ii, bf2f(xb), sp, a, u);
              *(LAS f32x2*)(lds + RG_AU + (tok * 32 + chl) * 8) = (f32x2){a, u}; } }
        __syncthreads();
        { float av[8], uv[8];
#pragma unroll
          for (int k = 0; k < 8; ++k) { const f32x2 t = *(const LAS f32x2*)(lds + RG_AU + ((8 * sj + k) * 32 + sch) * 8); av[k] = t.x; uv[k] = t.y; }
          float A = 1.f, H = 0.f;
#pragma unroll
          for (int k = 0; k < 8; ++k) { H = av[k] * H + uv[k]; A *= av[k]; }
          *(LAS f32x2*)(lds + RG_CAR + (sj * 32 + sch) * 8) = (f32x2){A, H};
          __syncthreads();
          float h = ((const LAS float*)(lds + RG_HP))[(tile & 1) * 32 + sch];
#define RG_CARRY(NG_) do { f32x2 cc_[4 * (NG_)]; \
              _Pragma("unroll") for (int jj = 0; jj < 4 * (NG_); ++jj) cc_[jj] = *(const LAS f32x2*)(lds + RG_CAR + (jj * 32 + sch) * 8); \
              _Pragma("unroll") for (int jj = 0; jj < 4 * (NG_); ++jj) { const float hn_ = cc_[jj].x * h + cc_[jj].y; h = (jj < sj) ? hn_ : h; } } while (0)
          if (w < 2) RG_CARRY(1); else if (w < 4) RG_CARRY(2); else if (w < 6) RG_CARRY(3); else RG_CARRY(4);
#undef RG_CARRY
#pragma unroll
          for (int k = 0; k < 8; ++k) { h = av[k] * h + uv[k]; ((LAS float*)(lds + RG_HB))[(8 * sj + k) * 32 + sch] = h; }
          if (sj == 15) { ((LAS float*)(lds + RG_HP))[((tile + 1) & 1) * 32 + sch] = h;
              if (tile == SEQ / 128 - 1) F.out[O_LP + (size_t)b * DM + och] = h; }
          __syncthreads();
          { const LAS f32x4* hb = (const LAS f32x4*)(lds + RG_HB + ((tid >> 2) * 32 + 8 * (tid & 3)) * 4); const f32x4 h0 = hb[0], h1 = hb[1];
            v4u o; o.x = pk2(h0.x * BF_LO(sg4.x), h0.y * BF_HI(sg4.x)); o.y = pk2(h0.z * BF_LO(sg4.y), h0.w * BF_HI(sg4.y));
            o.z = pk2(h1.x * BF_LO(sg4.z), h1.y * BF_HI(sg4.z)); o.w = pk2(h1.z * BF_LO(sg4.w), h1.w * BF_HI(sg4.w));
            *(GAS v4u*)(PA + pa_off) = o; }
        }
    }
    __syncthreads();
}
__device__ __forceinline__ void p2_rglru_sample_unit(Frame& F, int unit) {
    const int tid = F.tid, b = unit >> 2, blk = unit & 3, chb = tid & 255, kh = tid >> 8, ch = blk * 256 + chb;
    const float* sconv = F.in[5] + (size_t)b * 3 * DM; const float* h0 = F.in[6] + (size_t)b * DM;
    const float* w_conv = F.in[14]; const float* b_conv = F.in[15]; const float* w_ra = F.in[16]; const float* b_ra = F.in[17]; const float* w_rx = F.in[18]; const float* b_rx = F.in[19]; const float* lam = F.in[20];
    const float* xa = F.out + O_CS + (size_t)b * 3 * DM + 2 * DM;
    const bf16* SGA = (const bf16*)(F.ws + WS_SGA); bf16* PA = (bf16*)(F.ws + WS_PA);
    LAS float* xc = (LAS float*)F.lds;
    LAS float* part = xc + 256;
    __syncthreads();
    if (tid < 256) { const int c = blk * 256 + tid;
        xc[tid] = b_conv[c] + w_conv[c] * sconv[c] + w_conv[DM + c] * sconv[DM + c] + w_conv[2 * DM + c] * sconv[2 * DM + c] + w_conv[3 * DM + c] * xa[c]; }
    __syncthreads();
    float ar = 0.f, ai = 0.f;
    { const float* wr = w_ra + (size_t)blk * 65536 + (size_t)(128 * kh) * 256 + chb; const float* wx = w_rx + (size_t)blk * 65536 + (size_t)(128 * kh) * 256 + chb;
      const LAS float* xk = xc + 128 * kh;
#pragma unroll 32
      for (int k = 0; k < 128; ++k) { const float x = xk[k]; ar = fmaf(x, wr[(size_t)k * 256], ar); ai = fmaf(x, wx[(size_t)k * 256], ai); } }
    if (kh == 1) { part[chb] = ar; part[256 + chb] = ai; }
    __syncthreads();
    if (kh == 0) {
        ar = (b_ra[ch] + ar) + part[chb]; ai = (b_rx[ch] + ai) + part[256 + chb];
        float a, u; gate_au(sigmoidf_(ar), sigmoidf_(ai), xc[chb], softplus_neg(lam[ch]), a, u);
        const float h = a * h0[ch] + u;
        F.out[O_LS + (size_t)b * DM + ch] = h;
        PA[(size_t)(MP + b) * DM + ch] = (bf16)f2bf(h * bf2f(SGA[(size_t)(MP + b) * DM + ch]));
    }
    __syncthreads();
}
__device__ __forceinline__ void p2_rglru(Frame& F, int nrep) {
    for (int u = F.vcu; u < NBATCH * 32 * nrep; u += F.G) p2_rglru_prompt_unit(F, u & (NBATCH * 32 - 1));
}


constexpr int IX_SC = 0, IX_BITS = 131072, IX_END = IX_BITS + 16384;
constexpr int TOPK = 256;
__device__ __forceinline__ float next_up(float x) { unsigned u = __float_as_uint(x); if (x == 0.f) return __uint_as_float(1u); u = (x > 0.f) ? u + 1u : u - 1u; return __uint_as_float(u); }
__device__ __forceinline__ float next_down(float x) { return -next_up(-x); }
__device__ __forceinline__ float wave_min_f(float v) {
#pragma unroll
    for (int o = 1; o < 64; o <<= 1) v = fminf(v, __shfl_xor(v, o));
    return v; }
__device__ __forceinline__ float wave_max_f(float v) {
#pragma unroll
    for (int o = 1; o < 64; o <<= 1) v = fmaxf(v, __shfl_xor(v, o));
    return v; }
template <int L> __device__ __forceinline__ unsigned wlane(unsigned val, unsigned old) { asm volatile("s_nop 1\n\tv_writelane_b32 %0, %1, %2" : "+v"(old) : "s"(val), "n"(L)); return old; }
#define WL64(bl_, L_) do { const unsigned long long b__ = (bl_); mlo = wlane<(L_)>((unsigned)b__, mlo); mhi = wlane<(L_)>((unsigned)(b__ >> 32), mhi); } while (0)
#define REP16(M, B) M(B + 0) M(B + 1) M(B + 2) M(B + 3) M(B + 4) M(B + 5) M(B + 6) M(B + 7) M(B + 8) M(B + 9) M(B + 10) M(B + 11) M(B + 12) M(B + 13) M(B + 14) M(B + 15)
__device__ __forceinline__ int wave_sum_i_dpp(int x) {
    x += __builtin_amdgcn_update_dpp(0, x, 0xB1, 0xf, 0xf, true);
    x += __builtin_amdgcn_update_dpp(0, x, 0x4E, 0xf, 0xf, true);
    x += __builtin_amdgcn_update_dpp(0, x, 0x141, 0xf, 0xf, true);
    x += __builtin_amdgcn_update_dpp(0, x, 0x140, 0xf, 0xf, true);
    return __builtin_amdgcn_readlane(x, 0) + __builtin_amdgcn_readlane(x, 16) + __builtin_amdgcn_readlane(x, 32) + __builtin_amdgcn_readlane(x, 48);
}
#define DPP_F(x_, ctrl_) __int_as_float(__builtin_amdgcn_update_dpp(0, __float_as_int(x_), ctrl_, 0xf, 0xf, true))
__device__ __forceinline__ float wave_sum_f_dpp(float x) {
    x += DPP_F(x, 0xB1); x += DPP_F(x, 0x4E); x += DPP_F(x, 0x141); x += DPP_F(x, 0x140);
    return __int_as_float(__builtin_amdgcn_readlane(__float_as_int(x), 0)) + __int_as_float(__builtin_amdgcn_readlane(__float_as_int(x), 16))
         + __int_as_float(__builtin_amdgcn_readlane(__float_as_int(x), 32)) + __int_as_float(__builtin_amdgcn_readlane(__float_as_int(x), 48));
}
__device__ __forceinline__ float wave_max_f_dpp(float x) {
    x = fmaxf(x, DPP_F(x, 0xB1)); x = fmaxf(x, DPP_F(x, 0x4E)); x = fmaxf(x, DPP_F(x, 0x141)); x = fmaxf(x, DPP_F(x, 0x140));
    return fmaxf(fmaxf(__int_as_float(__builtin_amdgcn_readlane(__float_as_int(x), 0)), __int_as_float(__builtin_amdgcn_readlane(__float_as_int(x), 16))),
                 fmaxf(__int_as_float(__builtin_amdgcn_readlane(__float_as_int(x), 32)), __int_as_float(__builtin_amdgcn_readlane(__float_as_int(x), 48))));
}
__device__ __forceinline__ float wave_min_f_dpp(float x) {
    x = fminf(x, DPP_F(x, 0xB1)); x = fminf(x, DPP_F(x, 0x4E)); x = fminf(x, DPP_F(x, 0x141)); x = fminf(x, DPP_F(x, 0x140));
    return fminf(fminf(__int_as_float(__builtin_amdgcn_readlane(__float_as_int(x), 0)), __int_as_float(__builtin_amdgcn_readlane(__float_as_int(x), 16))),
                 fminf(__int_as_float(__builtin_amdgcn_readlane(__float_as_int(x), 32)), __int_as_float(__builtin_amdgcn_readlane(__float_as_int(x), 48))));
}
#define CNT2(i_, acc_) do { f32x2 t_; asm("v_pk_fma_f32 %0, %1, %2, %3 clamp" : "=v"(t_) : "v"(v2[i_]), "v"(big2), "v"(nb2)); acc_ += t_; } while (0)
#define CNT8(b_) CNT2(b_ + 0, a0); CNT2(b_ + 1, a1); CNT2(b_ + 2, a2); CNT2(b_ + 3, a3); CNT2(b_ + 4, a0); CNT2(b_ + 5, a1); CNT2(b_ + 6, a2); CNT2(b_ + 7, a3)
__device__ __forceinline__ int count_gt(const f32x2 (&v2)[32], float mid, int chunks) {
    const float BIG = 0x1p100f;
    const f32x2 big2 = {BIG, BIG}, nb2 = {-mid * BIG, -mid * BIG};
    f32x2 a0 = {0.f, 0.f}, a1 = {0.f, 0.f}, a2 = {0.f, 0.f}, a3 = {0.f, 0.f};
    CNT8(0);
    if (chunks > 1) { CNT8(8); }
    if (chunks > 2) { CNT8(16); }
    if (chunks > 3) { CNT8(24); }
    const f32x2 a = (a0 + a1) + (a2 + a3);
    return (int)wave_sum_f_dpp(a.x + a.y);
}
__device__ __forceinline__ void p3a_prompt_unit(Frame& F, int b, int qblk) {
    const int lane = F.lane, w = F.wave;
    LAS unsigned char* lds = F.lds;
    const bf16* QI = (const bf16*)(F.ws + WS_QI); const bf16* KI = (const bf16*)(F.ws + WS_KI); const float* WI = (const float*)(F.ws + WS_WI);
    const size_t rowb = (size_t)b * SEQ;
    const int nkt = qblk + 1;
    const float NEG = -__builtin_inff();
    { const int k0 = nkt * 32, k1 = (((qblk * 32 + 31) >> 10) + 1) * 1024;
      for (int idx = F.tid; idx < 8 * (k1 - k0); idx += NTHR) { const int q = idx / (k1 - k0), k = k0 + idx % (k1 - k0); *(LAS float*)(lds + IX_SC + (q * 4096 + k) * 4) = NEG; } }
#define IX_SCORES_LOAD(s_) do { const int qq0 = qblk * 32 + 8 * (s_); if (qq0 + 7 >= TOPK) { \
        const int rho = lane & 31, hi = lane >> 5; \
        const int ql = 2 * (rho >> 4) + ((rho >> 2) & 1), head = 4 * ((rho >> 3) & 1) + (rho & 3); \
        _Pragma("unroll") for (int mt = 0; mt < 2; ++mt) _Pragma("unroll") for (int s4 = 0; s4 < 4; ++s4) { v4u t = *(const GAS v4u*)(QI + (rowb + qq0 + 4 * mt + ql) * 512 + head * 64 + 16 * s4 + 8 * hi); qa[mt][s4] = *reinterpret_cast<bf16x8*>(&t); } \
        wqv = WI[(rowb + qq0) * 8 + lane]; \
        const bf16* kbase = KI + (rowb + (lane & 31)) * 64 + 8 * hi; \
        if (w < nkt) IX_LOADK(k0, w); } } while (0)
#define IX_SCORES_RUN(s_) do { const int qq0 = qblk * 32 + 8 * (s_); if (qq0 + 7 >= TOPK) { \
        const int hi = lane >> 5; \
        LAS float* wql = (LAS float*)(lds + IX_END) + w * 64;     \
        wql[lane] = wqv; \
        const bf16* kbase = KI + (rowb + (lane & 31)) * 64 + 8 * hi; \
        int kt = w; \
        while (kt < nkt) { IX_COMPUTE(k0, kt); kt += 8; } } } while (0)
#define IX_LOADK(dst, kt_) do { _Pragma("unroll") for (int s4 = 0; s4 < 4; ++s4) { v4u t_ = *(const GAS v4u*)(kbase + (size_t)(kt_) * 2048 + 16 * s4); dst[s4] = *reinterpret_cast<bf16x8*>(&t_); } } while (0)
#define IX_COMPUTE(kb_, kt_) do { const int key = (kt_) * 32 + (lane & 31); f32x16 accs[2] = {}; \
                _Pragma("unroll") for (int mt = 0; mt < 2; ++mt) \
                    _Pragma("unroll") for (int s4 = 0; s4 < 4; ++s4) accs[mt] = __builtin_amdgcn_mfma_f32_32x32x16_bf16(qa[mt][s4], kb_[s4], accs[mt], 0, 0, 0); \
                if ((kt_) + 8 < nkt) IX_LOADK(kb_, (kt_) + 8);     \
                _Pragma("unroll") for (int mt = 0; mt < 2; ++mt) { const f32x16 acc = accs[mt]; \
                    _Pragma("unroll") for (int g = 0; g < 2; ++g) { float sc = 0.f; const f32x4 wa = *(const LAS f32x4*)(wql + (4 * mt + 2 * g + hi) * 8), wb = *(const LAS f32x4*)(wql + (4 * mt + 2 * g + hi) * 8 + 4); \
                        sc = fmaf(wa.x, fmaxf(acc[8 * g + 0], 0.f), sc); sc = fmaf(wa.y, fmaxf(acc[8 * g + 1], 0.f), sc); sc = fmaf(wa.z, fmaxf(acc[8 * g + 2], 0.f), sc); sc = fmaf(wa.w, fmaxf(acc[8 * g + 3], 0.f), sc); \
                        sc = fmaf(wb.x, fmaxf(acc[8 * g + 4], 0.f), sc); sc = fmaf(wb.y, fmaxf(acc[8 * g + 5], 0.f), sc); sc = fmaf(wb.z, fmaxf(acc[8 * g + 6], 0.f), sc); sc = fmaf(wb.w, fmaxf(acc[8 * g + 7], 0.f), sc); \
                        const int qloc = 4 * mt + 2 * g + hi; if (key > qq0 + qloc) sc = NEG; \
                        *(LAS float*)(lds + IX_SC + (qloc * 4096 + key) * 4) = sc; } } } while (0)
#define IX_SELECT() do { \
        if (t + 1 <= TOPK) { \
            WL64(__ballot(lane <= t), 0); WL64(__ballot(lane <= t - 64), 1); WL64(__ballot(lane <= t - 128), 2); WL64(__ballot(lane <= t - 192), 3); \
        } else { \
            float mx = NEG; \
            _Pragma("unroll") for (int i = 0; i < 32; i += 2) mx = fmaxf(fmaxf(v2[i].x, v2[i].y), fmaxf(fmaxf(v2[i + 1].x, v2[i + 1].y), mx)); \
            float mn = fminf(fminf(v2[0].x, v2[0].y), fminf(v2[1].x, v2[1].y)); mn = fminf(mn, (v2[2].x == NEG) ? __builtin_inff() : v2[2].x); \
            float lo = next_down(wave_min_f_dpp(mn)), hi = wave_max_f_dpp(mx); \
            int c_hi = 0; float T = hi, E = hi; int need = 0; \
            for (int it = 0; it < 400; ++it) { \
                const float mid = 0.5f * lo + 0.5f * hi; \
                if (!(mid > lo && mid < hi)) { T = hi; E = hi; need = TOPK - c_hi; break; } \
                const int c = count_gt(v2, mid, chunks); \
                if (c == TOPK) { T = mid; need = 0; break; } \
                if (c > TOPK) lo = mid; else { hi = mid; c_hi = c; } \
            } \
            if (need == 0) { \
                REP16(SELT, 0) \
                if (chunks > 1) { REP16(SELT, 16) } \
                if (chunks > 2) { REP16(SELT, 32) } \
                if (chunks > 3) { REP16(SELT, 48) } \
            } else { \
                REP16(SELTIE, 0) REP16(SELTIE, 16) REP16(SELTIE, 32) REP16(SELTIE, 48) \
            } \
        } } while (0)
#define SELV(r) (((r) & 1) ? v2[(r) >> 1].y : v2[(r) >> 1].x)
#define SELT(r) WL64(__ballot(SELV(r) > T), (r));
#define SELTIE(r) { const float vr_ = SELV(r); unsigned long long bl_ = __ballot(vr_ > T); const unsigned long long eq_ = __ballot(vr_ == E); const int ce_ = __popcll(eq_); \
        if (need > 0 && ce_ > 0) { const int pre_ = __builtin_amdgcn_mbcnt_hi((unsigned)(eq_ >> 32), __builtin_amdgcn_mbcnt_lo((unsigned)eq_, 0u)); \
            bl_ |= __ballot(vr_ == E && pre_ < need); need = (ce_ >= need) ? 0 : need - ce_; } WL64(bl_, (r)); }
    bf16x8 qa[2][4]; bf16x8 k0[4]; float wqv = 0.f;
    IX_SCORES_LOAD(0); IX_SCORES_RUN(0);
    __syncthreads();
#pragma unroll 1
    for (int s = 0; s < 4; ++s) {
        const int t = qblk * 32 + 8 * s + w;
        const int chunks = (t >> 10) + 1;
        f32x2 v2[32];
        if (t + 1 > TOPK) {
            const LAS float* scb = (const LAS float*)(lds + IX_SC) + w * 4096 + lane;
#define LD8(b_) _Pragma("unroll") for (int i = (b_); i < (b_) + 8; ++i) { v2[i].x = scb[128 * i]; v2[i].y = scb[128 * i + 64]; }
#define NG8(b_) _Pragma("unroll") for (int i = (b_); i < (b_) + 8; ++i) { v2[i].x = NEG; v2[i].y = NEG; }
            LD8(0)
            if (chunks > 1) { LD8(8) } else { NG8(8) }
            if (chunks > 2) { LD8(16) } else { NG8(16) }
            if (chunks > 3) { LD8(24) } else { NG8(24) }
#undef LD8
#undef NG8
        } else {
#pragma unroll
            for (int i = 0; i < 32; ++i) { v2[i].x = NEG; v2[i].y = NEG; }
        }
        __syncthreads();
        unsigned mlo = 0u, mhi = 0u;
        if (s < 3) IX_SCORES_LOAD(s + 1);
        if (w < 4) { IX_SELECT(); if (s < 3) IX_SCORES_RUN(s + 1); }
        else       { if (s < 3) IX_SCORES_RUN(s + 1); IX_SELECT(); }
        *(LAS unsigned long long*)(lds + IX_BITS + ((8 * s + w) * 64 + lane) * 8) = ((unsigned long long)mhi << 32) | mlo;
        __syncthreads();
    }
#undef IX_SCORES_LOAD
#undef IX_SCORES_RUN
#undef IX_LOADK
#undef IX_COMPUTE
#undef IX_SELECT
#undef SELV
#undef SELT
#undef SELTIE
    {
        unsigned long long* MSK = (unsigned long long*)(F.ws + WS_MSK) + ((size_t)(b * 128 + qblk) * 64) * 32;
        const int ntile = 4 * (qblk >> 3) + 4;
        const int r32 = lane & 31, hi = lane >> 5;
        for (int j = w; j < ntile; j += NWAVES) {
            const unsigned long long wd = *(const LAS unsigned long long*)(lds + IX_BITS + (r32 * 64 + j) * 8) >> (4 * hi);
            unsigned mlo = 0u, mhi = 0u;
#define TRB(k) WL64(__ballot((wd >> (32 * ((k) >> 4) + ((k) & 3) + 8 * (((k) & 15) >> 2))) & 1ull), (k));
            REP16(TRB, 0) REP16(TRB, 16)
#undef TRB
            if (lane < 32) MSK[(size_t)j * 32 + lane] = ((unsigned long long)mhi << 32) | mlo;
        }
    }
    __syncthreads();
}
__device__ __forceinline__ void p3a_sample_unit(Frame& F, const int* page_table, int b, int chunk) {
    const int tid = F.tid;
    LAS float* qs = (LAS float*)F.lds;
    const bf16* QI = (const bf16*)(F.ws + WS_QI); const float* WI = (const float*)(F.ws + WS_WI); const float* cidx = F.in[4];
    float* SSC = (float*)(F.ws + WS_SSC);
    __syncthreads();
    qs[tid] = bf2f(QI[(size_t)(MP + b) * 512 + tid]);
    __syncthreads();
    if (tid < 8) qs[512 + tid] = WI[(size_t)(MP + b) * 8 + tid];
    __syncthreads();
#pragma unroll 1
    for (int e = 0; e < 2; ++e) {
        const int key = chunk * 1024 + e * 512 + tid;
        const int phys = page_table[b * NPG + (key >> 7)];
        const f32x4* kr = (const f32x4*)(cidx + ((size_t)phys * PAGE + (key & 127)) * 64);
        f32x4 kv[16];
#pragma unroll
        for (int d4 = 0; d4 < 16; ++d4) kv[d4] = kr[d4];
        float sc = 0.f;
#pragma unroll 1
        for (int h = 0; h < 8; ++h) { float sh = 0.f;
#pragma unroll
            for (int d4 = 0; d4 < 16; ++d4) { const f32x4 q4 = *(const LAS f32x4*)(qs + h * 64 + 4 * d4); sh = fmaf(q4.x, kv[d4].x, fmaf(q4.y, kv[d4].y, fmaf(q4.z, kv[d4].z, fmaf(q4.w, kv[d4].w, sh)))); }
            sc = fmaf(qs[512 + h], fmaxf(sh, 0.f), sc); asm volatile("" ::: "memory"); }
        __hip_atomic_store(SSC + (size_t)b * 16400 + key, sc, __ATOMIC_RELAXED, __HIP_MEMORY_SCOPE_AGENT);
    }
    asm volatile("s_waitcnt vmcnt(0)" ::: "memory");
    __syncthreads();
    if (tid == 0) __hip_atomic_fetch_add((unsigned*)(F.ws + WS_CTL) + CW_PANEL + 64 * (129 + b), 1u, __ATOMIC_RELAXED, __HIP_MEMORY_SCOPE_AGENT);
}
__device__ __forceinline__ void p3a_indexer(Frame& F, const int* page_table) {
    { const int nsk = (F.G > 64) ? 32 : 0;
      if (F.vcu >= nsk) for (int u = F.vcu - nsk; u < NS * 16; u += F.G - nsk) p3a_sample_unit(F, page_table, u >> 4, u & 15); }
    for (int i = blockIdx.x; i < 1024; i += F.G) { const int slot = i >> 8, v = i & 255, b = v & 7, j = v >> 3;
        const int qblk = (slot == 0) ? j : (slot == 1) ? 63 - j : (slot == 2) ? 64 + j : 127 - j;
        p3a_prompt_unit(F, b, qblk); }
}


namespace att {
constexpr float SCALE = 0.08838834764831845f;
constexpr int NW = 8, QBLK = 32, KVBLK = 64, QB = NW * QBLK, D = 128;
constexpr int SHM_V = KVBLK * D * 2, SHM_K = KVBLK * D * 2;
constexpr int LDS_ATT = 2 * SHM_V + 2 * SHM_K + NW * 64 * 4;
constexpr float THR = 8.f;
constexpr int QS = 1024, KS = 256, OS = 1024;
constexpr int OST_OFF = 81920;
typedef short s16x4 __attribute__((ext_vector_type(4)));
typedef unsigned u32x4 __attribute__((ext_vector_type(4)));
#define KSWZ(row, colB) ((row) * 256 + ((colB) ^ (((row) & 7) << 4)))
#define SBAR() __builtin_amdgcn_sched_barrier(0)
__device__ __forceinline__ int v_st(int k, int c) { const int kk = (k & ~0xC) | ((k & 4) << 1) | ((k & 8) >> 1); return ((kk >> 3) * 4 + (c >> 5)) * 512 + ((kk & 7) * 32 + (c & 31)) * 2; }
__device__ __forceinline__ int v_rd_base(int lane) { return ((lane & 3) << 3) | (((lane >> 2) & 3) << 6) | (((lane >> 4) & 1) << 5) | (((lane >> 5) & 1) << 8); }
constexpr int v_rd_off(int d0, int ks, int half) { return d0 * 512 + ks * 4096 + half * 2048; }
__device__ __forceinline__ int crow(int r, int hi) { return (r & 3) + 8 * (r >> 2) + 4 * hi; }
__device__ __forceinline__ unsigned cvtpk(float lo, float hi) { unsigned r; asm volatile("v_cvt_pk_bf16_f32 %0, %1, %2" : "=v"(r) : "v"(lo), "v"(hi)); return r; }
__device__ __forceinline__ bf16x8 load8(const bf16* p) { return *reinterpret_cast<const bf16x8*>(p); }
typedef unsigned long long u64x8 __attribute__((ext_vector_type(8)));
struct TileMasks { u64x8 a, b, c, d; };
__device__ __forceinline__ void mask_load(TileMasks& M, const unsigned long long* mwg) {
    const unsigned long long pm = (unsigned long long)(uintptr_t)mwg;
    const unsigned plo = __builtin_amdgcn_readfirstlane((unsigned)pm), phi = __builtin_amdgcn_readfirstlane((unsigned)(pm >> 32));
    const unsigned long long pu = ((unsigned long long)phi << 32) | plo;
    asm volatile("s_load_dwordx16 %0, %4, 0x0\n\ts_load_dwordx16 %1, %4, 0x40\n\ts_load_dwordx16 %2, %4, 0x80\n\ts_load_dwordx16 %3, %4, 0xc0"
                 : "=&s"(M.a), "=&s"(M.b), "=&s"(M.c), "=&s"(M.d) : "s"(pu) : "memory");
}
__device__ __forceinline__ void mask_apply(f32x16& p0, f32x16& p1, TileMasks& M) {
    const float NEG = -__builtin_inff();
    asm volatile("s_waitcnt lgkmcnt(0)" : "+s"(M.a), "+s"(M.b), "+s"(M.c), "+s"(M.d) :: "memory");
#pragma unroll
    for (int r = 0; r < 16; ++r) {
        const unsigned long long m0 = (r < 8) ? M.a[r & 7] : M.b[r & 7], m1 = (r < 8) ? M.c[r & 7] : M.d[r & 7];
        float a = p0[r], b = p1[r];
        asm volatile("v_cndmask_b32_e64 %0, %1, %0, %2" : "+v"(a) : "v"(NEG), "s"(m0));
        asm volatile("v_cndmask_b32_e64 %0, %1, %0, %2" : "+v"(b) : "v"(NEG), "s"(m1));
        p0[r] = a; p1[r] = b;
    }
}
__device__ __forceinline__ void partialSM(f32x16& p0, f32x16& p1, float& m_reg, float& mn, float& alpha) {
    float pmax = p0[0]; for (int r = 1; r < 16; ++r) pmax = fmaxf(pmax, p0[r]); for (int r = 0; r < 16; ++r) pmax = fmaxf(pmax, p1[r]);
    { auto rr = __builtin_amdgcn_permlane32_swap(__float_as_uint(pmax), __float_as_uint(pmax), false, false);
      pmax = fmaxf(__uint_as_float(rr[0]), __uint_as_float(rr[1])); }
    constexpr float C2 = 1.4426950408889634f * SCALE;
    if (__builtin_expect(__all((pmax - m_reg) * SCALE <= THR), 1)) { mn = m_reg; alpha = 1.f; }
    else { mn = fmaxf(m_reg, pmax); alpha = __builtin_amdgcn_exp2f((m_reg - mn) * C2); m_reg = mn; }
    const float mnL = -mn * C2;
    for (int r = 0; r < 16; ++r) p0[r] = fmaf(p0[r], C2, mnL); for (int r = 0; r < 16; ++r) p1[r] = fmaf(p1[r], C2, mnL);
    for (int r = 0; r < 16; ++r) p0[r] = __builtin_amdgcn_exp2f(p0[r]);
}
__device__ __forceinline__ void finishSM(f32x16& p0, f32x16& p1, float alpha, float& l_reg, bf16x8& pa0, bf16x8& pa1, bf16x8& pa2, bf16x8& pa3) {
    for (int r = 0; r < 16; ++r) p1[r] = __builtin_amdgcn_exp2f(p1[r]);
    float ps = 0; for (int r = 0; r < 16; ++r) ps += p0[r]; for (int r = 0; r < 16; ++r) ps += p1[r];
    { auto rr = __builtin_amdgcn_permlane32_swap(__float_as_uint(ps), __float_as_uint(ps), false, false);
      ps = __uint_as_float(rr[0]) + __uint_as_float(rr[1]); }
    l_reg = l_reg * alpha + ps;
#define PK4(P, B_, OUT) do { unsigned a0 = cvtpk(P[B_+0], P[B_+1]), a1 = cvtpk(P[B_+2], P[B_+3]);                          \
        unsigned b0 = cvtpk(P[B_+4], P[B_+5]), b1 = cvtpk(P[B_+6], P[B_+7]);                                             \
        auto r0 = __builtin_amdgcn_permlane32_swap(a0, b0, false, false); auto r1 = __builtin_amdgcn_permlane32_swap(a1, b1, false, false); \
        u32x4 w = {r0[0], r1[0], r0[1], r1[1]}; OUT = *reinterpret_cast<bf16x8*>(&w); } while (0)
    PK4(p0, 0, pa0); PK4(p0, 8, pa1); PK4(p1, 0, pa2); PK4(p1, 8, pa3);
#undef PK4
}
template <int KB>
__device__ __forceinline__ void qkt(f32x16& p0, f32x16& p1, const char* K_lds, int r32, int hi, const bf16x8* qr) {
    p0 = f32x16{}; p1 = f32x16{};
    const char* kb[4];
#pragma unroll
    for (int dd = 0; dd < 4; ++dd) kb[dd] = K_lds + KB * SHM_K + KSWZ(r32, (dd * 16 + hi * 8) * 2);
#pragma unroll
    for (int d0 = 0; d0 < 8; ++d0) { const char* a = kb[d0 & 3] + (d0 >> 2) * 128;
        bf16x8 b0 = *reinterpret_cast<const bf16x8*>(a);
        bf16x8 b1 = *reinterpret_cast<const bf16x8*>(a + 32 * 256);
        p0 = __builtin_amdgcn_mfma_f32_32x32x16_bf16(b0, qr[d0], p0, 0, 0, 0);
        p1 = __builtin_amdgcn_mfma_f32_32x32x16_bf16(b1, qr[d0], p1, 0, 0, 0); }
}
template <int VB>
__device__ __forceinline__ void pv_tile(f32x16* o, int vb0, bf16x8 pa0, bf16x8 pa1, bf16x8 pa2, bf16x8 pa3) {
#define TRRD(dst, off) asm volatile("ds_read_b64_tr_b16 %0, %1 offset:%2" : "=&v"(dst) : "v"(vb0), "i"(off) : "memory")
#define PV_D0(d0) do { s16x4 l0, l1, l2, l3, h0, h1, h2, h3; constexpr int b_ = VB * SHM_V + v_rd_off(d0, 0, 0); \
        TRRD(l0, b_); TRRD(h0, b_ + 2048); TRRD(l1, b_ + 4096); TRRD(h1, b_ + 6144); TRRD(l2, b_ + 8192); TRRD(h2, b_ + 10240); TRRD(l3, b_ + 12288); TRRD(h3, b_ + 14336); \
        asm volatile("s_waitcnt lgkmcnt(0)" ::: "memory"); SBAR();   \
        o[d0] = __builtin_amdgcn_mfma_f32_32x32x16_bf16(pa0, (bf16x8){l0[0], l0[1], l0[2], l0[3], h0[0], h0[1], h0[2], h0[3]}, o[d0], 0, 0, 0);   \
        o[d0] = __builtin_amdgcn_mfma_f32_32x32x16_bf16(pa1, (bf16x8){l1[0], l1[1], l1[2], l1[3], h1[0], h1[1], h1[2], h1[3]}, o[d0], 0, 0, 0);   \
        o[d0] = __builtin_amdgcn_mfma_f32_32x32x16_bf16(pa2, (bf16x8){l2[0], l2[1], l2[2], l2[3], h2[0], h2[1], h2[2], h2[3]}, o[d0], 0, 0, 0);   \
        o[d0] = __builtin_amdgcn_mfma_f32_32x32x16_bf16(pa3, (bf16x8){l3[0], l3[1], l3[2], l3[3], h3[0], h3[1], h3[2], h3[3]}, o[d0], 0, 0, 0); } while (0)
    PV_D0(0); PV_D0(1); PV_D0(2); PV_D0(3);
#undef PV_D0
#undef TRRD
}
struct BlockRef { const bf16* Q; const bf16* K; const bf16* V; bf16* O; const bf16* G; const unsigned long long* M; int P0; };
struct Seam { bf16x8 qr[8]; bf16x8 st_v0, st_v1, st_k0, st_k1; };
#define ROWK(p, k0, rr) ((p) + (size_t)((k0) + (rr)) * KS + sc)
#define VMW() asm volatile("s_waitcnt vmcnt(0)" ::: "memory")
#define VMWN(n) asm volatile("s_waitcnt vmcnt(%0)" :: "i"(n) : "memory")
#define SLOAD_H(Kp, Vp, k0) do { S.st_v0 = load8(ROWK(Vp, k0, sr)); S.st_v1 = load8(ROWK(Vp, k0, 32 + sr));              \
                         S.st_k0 = load8(ROWK(Kp, k0, sr)); S.st_k1 = load8(ROWK(Kp, k0, 32 + sr)); } while (0)
#define SWRITE_HK(bf) do { *(bf16x8*)(K_lds + (bf) * SHM_K + kws) = S.st_k0; *(bf16x8*)(K_lds + (bf) * SHM_K + kws + 32 * 256) = S.st_k1; } while (0)
#define SWRITE_HV(bf) do { *(bf16x8*)(V_lds + (bf) * SHM_V + vst0) = S.st_v0; *(bf16x8*)(V_lds + (bf) * SHM_V + vst1) = S.st_v1; } while (0)
#define SWRITE_H(bf) do { SWRITE_HV(bf); SWRITE_HK(bf); } while (0)
__device__ __forceinline__ void attn_prime(const BlockRef& cur, char* lds, Seam& S) {
    const int tid = threadIdx.x, wid = __builtin_amdgcn_readfirstlane(tid >> 6), lane = tid & 63, r32 = lane & 31, hi = lane >> 5;
    const int sr = tid >> 4, sc = (tid & 15) * 8, kws = KSWZ(sr, sc * 2); char* K_lds = lds + 2 * SHM_V;
    for (int d0 = 0; d0 < 8; ++d0) S.qr[d0] = load8(cur.Q + (size_t)(wid * QBLK + r32) * QS + d0 * 16 + hi * 8);
    SLOAD_H(cur.K, cur.V, 0); VMW(); SWRITE_HK(0);
    __syncthreads();
}
__device__ __forceinline__ void attn_block(const BlockRef& cur, const BlockRef& nxt, char* lds, Seam& S) {
    const int tid = threadIdx.x, wid = __builtin_amdgcn_readfirstlane(tid >> 6), lane = tid & 63, r32 = lane & 31, hi = lane >> 5;
    const int NT = (cur.P0 + QB - 1) / KVBLK + 1;
    char* V_lds = lds; char* K_lds = lds + 2 * SHM_V;
    float* wsl = (float*)(lds + 2 * SHM_V + 2 * SHM_K) + wid * 64; float* li_l = wsl, * al_l = wsl + 32;
    float m_reg = -1e30f, l_reg = 0; f32x16 o[4] = {};
    const int sr = tid >> 4, sc = (tid & 15) * 8, vst0 = v_st(sr, sc), vst1 = v_st(32 + sr, sc), kws = KSWZ(sr, sc * 2);
    const int vb0 = (int)(uintptr_t)V_lds + v_rd_base(lane);
    const bf16* Kh = cur.K; const bf16* Vh = cur.V;
    const unsigned long long* Mw = cur.M + (size_t)wid * 64 * 32;
#define RESC(a) do { if (__any((a) < 1.f)) { if (hi == 0) al_l[r32] = (a); asm volatile("s_waitcnt lgkmcnt(0)" ::: "memory");              \
                     for (int d_ = 0; d_ < 4; ++d_) for (int r = 0; r < 16; ++r) o[d_][r] *= al_l[crow(r, hi)]; } } while (0)
#define KBASE(t) ((t) * KVBLK)
#define MASKL(t) mask_load(TM, Mw + (size_t)(t) * 32)
#define MASKT(P0_, P1_, t) mask_apply(P0_, P1_, TM)
    constexpr int NQL = 8;
#define SEAM_K0() do { VMWN(NQL); SWRITE_HK(0); SBAR(); } while (0)
    f32x16 pA0, pA1, pB0, pB1; float mnA, mnB, alA, alB; bf16x8 pa0, pa1, pa2, pa3; TileMasks TM;
    MASKL(0);
    SWRITE_HV(0); SBAR();
    if (NT > 1) { SLOAD_H(Kh, Vh, KBASE(1)); }
    SBAR(); qkt<0>(pA0, pA1, K_lds, r32, hi, S.qr);
    asm volatile("s_nop 15\n\ts_nop 7" : "+v"(pA0), "+v"(pA1));
    MASKT(pA0, pA1, 0); partialSM(pA0, pA1, m_reg, mnA, alA);
    if (NT > 1) { VMW(); SWRITE_H(1); }
    __syncthreads();
#define HALF_STEP(PX0, PX1, mnX, alX, PY0, PY1, alY, t, KB, VB, SB) do {                                                      \
        if ((t) + 1 < NT) { SLOAD_H(Kh, Vh, KBASE((t) + 1)); SBAR(); }     \
        MASKL(t); SBAR(); qkt<KB>(PX0, PX1, K_lds, r32, hi, S.qr);                                             \
        finishSM(PY0, PY1, alY, l_reg, pa0, pa1, pa2, pa3); SBAR();                                                           \
        pv_tile<VB>(o, vb0, pa0, pa1, pa2, pa3); MASKT(PX0, PX1, (t)); partialSM(PX0, PX1, m_reg, mnX, alX);                                        \
        __syncthreads();                                                                                                      \
        if ((t) + 1 < NT) { VMW(); SWRITE_H(SB); }                                                                          \
        RESC(alX); __syncthreads(); } while (0)
    for (int t = 1; t + 1 < NT; t += 2) {
        HALF_STEP(pB0, pB1, mnB, alB, pA0, pA1, alA, t, 1, 0, 0);
        HALF_STEP(pA0, pA1, mnA, alA, pB0, pB1, alB, t + 1, 0, 1, 1);
    }
    const bool even = (NT & 1) == 0;
    if (even) { MASKL(NT - 1); SBAR(); qkt<1>(pB0, pB1, K_lds, r32, hi, S.qr); SBAR(); }
    SLOAD_H(nxt.K, nxt.V, 0); SBAR();
#pragma unroll
    for (int d0 = 0; d0 < 8; ++d0) S.qr[d0] = load8(nxt.Q + (size_t)(wid * QBLK + r32) * QS + d0 * 16 + hi * 8);
    SBAR();
    finishSM(pA0, pA1, alA, l_reg, pa0, pa1, pa2, pa3); SBAR();
    pv_tile<0>(o, vb0, pa0, pa1, pa2, pa3);
    if (even) { MASKT(pB0, pB1, NT - 1); partialSM(pB0, pB1, m_reg, mnB, alB); __syncthreads(); RESC(alB);
        finishSM(pB0, pB1, alB, l_reg, pa0, pa1, pa2, pa3); SBAR(); pv_tile<1>(o, vb0, pa0, pa1, pa2, pa3); }
    SBAR(); SEAM_K0();
    if (hi == 0) li_l[r32] = l_reg; asm volatile("s_waitcnt lgkmcnt(0)" ::: "memory");
    float rli[16];
#pragma unroll
    for (int r = 0; r < 16; ++r) rli[r] = __builtin_amdgcn_rcpf(li_l[crow(r, hi)]);
    bf16* Ow = cur.O + (size_t)(wid * QBLK) * OS; const bf16* Gw = cur.G + (size_t)(wid * QBLK) * OS;
    { LAS unsigned short* ost = (LAS unsigned short*)((LAS unsigned char*)(uintptr_t)(unsigned)(uintptr_t)lds + OST_OFF + wid * 8192);
      v4u gvv[8];
#pragma unroll
      for (int k = 0; k < 8; ++k) gvv[k] = *(const v4u*)(Gw + (size_t)(4 * k + (lane >> 4)) * OS + (lane & 15) * 8);
#pragma unroll
      for (int r = 0; r < 16; ++r) { const int orow = crow(r, hi);
#pragma unroll
          for (int d0 = 0; d0 < 4; ++d0) ost[orow * 128 + d0 * 32 + r32] = (unsigned short)f2bf(o[d0][r] * rli[r]); }
      asm volatile("s_waitcnt lgkmcnt(0)" ::: "memory");
#pragma unroll
      for (int k = 0; k < 8; ++k) { const int row = 4 * k + (lane >> 4), ch = lane & 15;
          const v4u ov = *(const LAS v4u*)(ost + row * 128 + ch * 8);
          const v4u gv = gvv[k];
          v4u w;
          w.x = pk2(BF_LO(ov.x) * BF_LO(gv.x), BF_HI(ov.x) * BF_HI(gv.x)); w.y = pk2(BF_LO(ov.y) * BF_LO(gv.y), BF_HI(ov.y) * BF_HI(gv.y));
          w.z = pk2(BF_LO(ov.z) * BF_LO(gv.z), BF_HI(ov.z) * BF_HI(gv.z)); w.w = pk2(BF_LO(ov.w) * BF_LO(gv.w), BF_HI(ov.w) * BF_HI(gv.w));
          *(v4u*)(Ow + (size_t)row * OS + ch * 8) = w; }
      asm volatile("s_waitcnt lgkmcnt(0)" ::: "memory"); }
    __syncthreads();
#undef RESC
#undef KBASE
#undef MASKT
#undef MASKL
#undef SEAM_K0
#undef HALF_STEP
}
#undef ROWK
#undef VMW
#undef VMWN
#undef SLOAD_H
#undef SWRITE_HK
#undef SWRITE_HV
#undef SWRITE_H
#undef KSWZ
#undef SBAR
}

__device__ __forceinline__ att::BlockRef att_ref(Frame& F, int L, int pass) {
    const int b = L & 7, k = (L >> 3) & 63, h = k >> 3, x = k & 7, qb = pass ? 15 - x : x;
    const size_t row0 = (size_t)b * SEQ + (size_t)qb * 256;
    att::BlockRef r;
    r.Q = (const bf16*)(F.ws + WS_Q) + row0 * DM + h * 128; r.O = (bf16*)(F.ws + WS_PB) + row0 * DM + h * 128; r.G = (const bf16*)(F.ws + WS_SGB) + row0 * DM + h * 128;
    r.K = (const bf16*)(F.ws + WS_KB) + (size_t)b * SEQ * 256 + (h >> 2) * 128; r.V = (const bf16*)(F.ws + WS_VB) + (size_t)b * SEQ * 256 + (h >> 2) * 128;
    r.M = (const unsigned long long*)(F.ws + WS_MSK) + ((size_t)(b * 128 + qb * 8) * 64) * 32; r.P0 = qb * 256;
    return r;
}
__device__ __forceinline__ void p3b_attention(Frame& F, int nrep) {
    const int total = 512 * nrep, stride = F.G;
    int L = blockIdx.x; if (L >= total) return;
    int pass = 0;
    att::BlockRef cur = att_ref(F, L, 0);
    att::Seam S;
    att::attn_prime(cur, (char*)F.lds, S);
    for (;;) {
        const bool more_pass = (pass == 0), more_item = L + stride < total, last = !more_pass && !more_item;
        int passn = pass + 1, Ln = L;
        if (!more_pass) { passn = 0; Ln = more_item ? L + stride : L; }
        const att::BlockRef nxt = last ? cur : att_ref(F, Ln, passn);
        att::attn_block(cur, nxt, (char*)F.lds, S);
        if (last) break;
        cur = nxt; pass = passn; L = Ln;
    }
}


__device__ __forceinline__ void wait_count(unsigned* cnt, unsigned need) {
    unsigned sp = 0;
    while (__hip_atomic_load(cnt, __ATOMIC_RELAXED, __HIP_MEMORY_SCOPE_AGENT) < need) { __builtin_amdgcn_s_sleep(1); if (++sp > (1u << 22)) break; }
    __builtin_amdgcn_fence(__ATOMIC_ACQUIRE, "agent");
    asm volatile("s_waitcnt vmcnt(0)" ::: "memory");
}
constexpr int SM_Q = 0, SM_SEL = 4096, SM_CNT = SM_SEL + 1024, SM_S = 8192, SM_RED = SM_S + 8192, SM_ROW = SM_RED + 256, SM_PACC = SM_ROW + 1024, SM_END = SM_PACC + 32768;
__device__ __forceinline__ int block_sum_i(LAS int* red, int v, int wave, int lane, int& phase) {
    LAS int* slot = red + (phase & 1) * 8; phase ^= 1;
    if (lane == 0) slot[wave] = v;
    __syncthreads();
    int s = 0;
#pragma unroll
    for (int i = 0; i < 8; ++i) s += slot[i];
    return s;
}
__device__ __forceinline__ void p3b_sample_unit(Frame& F, const int* page_table, int b) {
    const int tid = F.tid, lane = F.lane, w = F.wave;
    LAS unsigned char* lds = F.lds;
    LAS float* qf = (LAS float*)(lds + SM_Q);
    LAS int* sel = (LAS int*)(lds + SM_SEL);
    LAS int* cntw = (LAS int*)(lds + SM_CNT);
    LAS float* Sb = (LAS float*)(lds + SM_S);
    LAS int* red = (LAS int*)(lds + SM_RED);
    const float NEG = -__builtin_inff();
    const bf16* Qb = (const bf16*)(F.ws + WS_Q) + (size_t)(MP + b) * DM; const bf16* QI = (const bf16*)(F.ws + WS_QI) + (size_t)(MP + b) * 512;
    const float* WI = (const float*)(F.ws + WS_WI) + (size_t)(MP + b) * 8; const float* SSC = (const float*)(F.ws + WS_SSC) + (size_t)b * 16400;
    const float* kself = F.out + O_KS + (size_t)b * 256; const float* vself = F.out + O_VS + (size_t)b * 256; const float* kiself = F.out + O_IKS + (size_t)b * 64;
    const float* cache_k = F.in[2]; const float* cache_v = F.in[3];
    __syncthreads();
    if (w == 0) wait_count((unsigned*)(F.ws + WS_CTL) + CW_PANEL + 64 * (129 + b), 16u);
    __syncthreads();
    for (int i = tid; i < 1024; i += NTHR) qf[i] = bf2f(Qb[i]);
    if (tid == 0) cntw[0] = 0;
    float self_sc = 0.f;
    { float part = 0.f;
        const int h = lane >> 3, d0 = 8 * (lane & 7); float sh = 0.f;
#pragma unroll
        for (int d = 0; d < 8; ++d) sh = fmaf(bf2f(QI[h * 64 + d0 + d]), kiself[d0 + d], sh);
        sh += __shfl_xor(sh, 1); sh += __shfl_xor(sh, 2); sh += __shfl_xor(sh, 4);
        part = ((lane & 7) == 0) ? WI[h] * fmaxf(sh, 0.f) : 0.f;
        self_sc = wave_sum(part); }
    float v[33];
#pragma unroll
    for (int r = 0; r < 32; ++r) v[r] = __hip_atomic_load(SSC + 512 * r + tid, __ATOMIC_RELAXED, __HIP_MEMORY_SCOPE_AGENT);
    v[32] = (tid == 0) ? self_sc : NEG;
    int phase = 0;
    float mn = __builtin_inff(), mx = NEG;
#pragma unroll
    for (int r = 0; r < 33; ++r) { mx = fmaxf(mx, v[r]); mn = fminf(mn, (v[r] == NEG) ? __builtin_inff() : v[r]); }
    mn = wave_min_f(mn); mx = wave_max_f(mx);
    { LAS float* fr = (LAS float*)(red + 16);
      if (lane == 0) { fr[w] = mn; fr[8 + w] = mx; }
      __syncthreads();
      mn = fr[0]; mx = fr[8];
#pragma unroll
      for (int i = 1; i < 8; ++i) { mn = fminf(mn, fr[i]); mx = fmaxf(mx, fr[8 + i]); } }
    float lo = mn, hi = next_up(mx); int cnt_hi = 0; float T = hi, E = lo; int need = 0;
    for (int it = 0; it < 400; ++it) {
        const float mid = 0.5f * lo + 0.5f * hi;
        if (!(mid > lo && mid < hi)) { T = hi; E = lo; need = TOPK - cnt_hi; break; }
        int c = 0;
#pragma unroll
        for (int r = 0; r < 33; ++r) c += __popcll(__ballot(v[r] >= mid));
        c = block_sum_i(red, c, w, lane, phase);
        if (c == TOPK) { T = mid; need = 0; break; }
        if (c > TOPK) lo = mid; else { hi = mid; cnt_hi = c; }
    }
    int X = 0;
    if (need > 0) {
        int xl = 0, xh = PAST + 1;
        for (int it = 0; it < 20; ++it) {
            if (xh - xl <= 1) break;
            const int xm = (xl + xh) >> 1; int c = 0;
#pragma unroll
            for (int r = 0; r < 33; ++r) c += __popcll(__ballot(v[r] == E && (512 * r + tid) < xm));
            c = block_sum_i(red, c, w, lane, phase);
            if (c >= need) xh = xm; else xl = xm;
        }
        X = xh;
    }
#pragma unroll
    for (int r = 0; r < 33; ++r) { const int key = 512 * r + tid;
        if (v[r] >= T || (need > 0 && v[r] == E && key < X)) { const int p = __hip_atomic_fetch_add(cntw, 1, __ATOMIC_RELAXED, __HIP_MEMORY_SCOPE_WORKGROUP); if (p < TOPK) sel[p] = key; } }
    __syncthreads();
    LAS int* rowix = (LAS int*)(lds + SM_ROW);
    LAS float* Pacc = (LAS float*)(lds + SM_PACC);
    if (tid < TOPK) { const int key = sel[tid]; rowix[tid] = (key < PAST) ? (page_table[b * NPG + (key >> 7)] * PAGE + (key & 127)) : -1; }
    __syncthreads();
    const int hw = tid >> 5, l32 = tid & 31;
    {
        const int g = hw & 1;
        f32x4 q4[4];
#pragma unroll
        for (int hh = 0; hh < 4; ++hh) q4[hh] = *(const LAS f32x4*)(qf + (4 * g + hh) * 128 + 4 * l32);
#pragma unroll 8
        for (int it = 0; it < 32; ++it) { const int k = it * 8 + (hw >> 1); const int ri = rowix[k];
            const float* kr = (ri >= 0) ? (cache_k + ((size_t)ri * 2 + g) * 128) : (kself + g * 128);
            const f32x4 k4 = *(const f32x4*)(kr + 4 * l32);
            float p[4];
#pragma unroll
            for (int hh = 0; hh < 4; ++hh) { p[hh] = q4[hh].x * k4.x + q4[hh].y * k4.y + q4[hh].z * k4.z + q4[hh].w * k4.w;
                p[hh] += __shfl_xor(p[hh], 1); p[hh] += __shfl_xor(p[hh], 2); p[hh] += __shfl_xor(p[hh], 4); p[hh] += __shfl_xor(p[hh], 8); p[hh] += __shfl_xor(p[hh], 16); }
            if (l32 < 4) { const float pv = (l32 == 0) ? p[0] : (l32 == 1) ? p[1] : (l32 == 2) ? p[2] : p[3]; Sb[(4 * g + l32) * 256 + k] = pv * att::SCALE; } }
    }
    __syncthreads();
    {
        float x[4]; float m = NEG;
#pragma unroll
        for (int j = 0; j < 4; ++j) { x[j] = Sb[w * 256 + lane + 64 * j]; m = fmaxf(m, x[j]); }
        m = wave_max_f(m); float sum = 0.f;
#pragma unroll
        for (int j = 0; j < 4; ++j) { x[j] = __expf(x[j] - m); sum += x[j]; }
        sum = wave_sum(sum); const float inv = 1.0f / sum;
#pragma unroll
        for (int j = 0; j < 4; ++j) Sb[w * 256 + lane + 64 * j] = x[j] * inv;
    }
    __syncthreads();
    {
        const int g = hw & 1;
        f32x4 acc[4];
#pragma unroll
        for (int hh = 0; hh < 4; ++hh) acc[hh] = (f32x4){0.f, 0.f, 0.f, 0.f};
#pragma unroll 8
        for (int it = 0; it < 32; ++it) { const int k = it * 8 + (hw >> 1); const int ri = rowix[k];
            const float* vr = (ri >= 0) ? (cache_v + ((size_t)ri * 2 + g) * 128) : (vself + g * 128);
            const f32x4 v4 = *(const f32x4*)(vr + 4 * l32);
#pragma unroll
            for (int hh = 0; hh < 4; ++hh) { const float pw = Sb[(4 * g + hh) * 256 + k]; acc[hh] = acc[hh] + v4 * pw; } }
#pragma unroll
        for (int hh = 0; hh < 4; ++hh) *(LAS f32x4*)(Pacc + (hw * 4 + hh) * 128 + 4 * l32) = acc[hh];
    }
    __syncthreads();
    {
        const bf16* SGB = (const bf16*)(F.ws + WS_SGB) + (size_t)(MP + b) * DM; bf16* PB = (bf16*)(F.ws + WS_PB) + (size_t)(MP + b) * DM;
        const int h = tid >> 6, d = 2 * (tid & 63), g = h >> 2, hh = h & 3; float o0 = 0.f, o1 = 0.f;
#pragma unroll
        for (int j = 0; j < 8; ++j) { const f32x2 t = *(const LAS f32x2*)(Pacc + ((2 * j + g) * 4 + hh) * 128 + d); o0 += t.x; o1 += t.y; }
        const unsigned sg = *(const unsigned*)(SGB + h * 128 + d);
        *(unsigned*)(PB + h * 128 + d) = pk2(o0 * BF_LO(sg), o1 * BF_HI(sg));
    }
    __syncthreads();
}

template <int STAGE> struct EpiMerge {
    static constexpr bool PROBE_TWICE = false;
    unsigned char* ws;
    __device__ __forceinline__ void operator()(const pg8::f32x4 (&acc)[2][2][4][2], const pg8::Unit& u, int wr, int wc, int fr, int fq) const {
        const bf16* GATE = (const bf16*)(ws + (STAGE == 0 ? WS_SMA : WS_SMB)); const bf16* T1 = (const bf16*)(ws + WS_T1); bf16* DST = (bf16*)(ws + (STAGE == 0 ? WS_T1 : WS_MM));
        const size_t off0 = (size_t)(u.pm * 256 + wr * 64 + fr) * DM + u.pn * 256 + 32 * wc + 8 * fq;
#pragma unroll
        for (int ai = 0; ai < 2; ++ai) {
            v4u gt[4][2], tt[4][2];
#pragma unroll
            for (int m = 0; m < 4; ++m)
#pragma unroll
                for (int bj = 0; bj < 2; ++bj) { const size_t off = off0 + (size_t)(ai * 128 + m * 16) * DM + 128 * bj;
                    gt[m][bj] = *(const GAS v4u*)(GATE + off); if (STAGE == 1) tt[m][bj] = *(const GAS v4u*)(T1 + off); }
            asm volatile("" ::: "memory");
#pragma unroll
            for (int m = 0; m < 4; ++m)
#pragma unroll
                for (int bj = 0; bj < 2; ++bj) { const size_t off = off0 + (size_t)(ai * 128 + m * 16) * DM + 128 * bj;
                    const v4u g4 = gt[m][bj];
                    float r[8];
                    r[0] = BF_LO(g4.x) * acc[ai][bj][m][0][0]; r[1] = BF_HI(g4.x) * acc[ai][bj][m][0][1]; r[2] = BF_LO(g4.y) * acc[ai][bj][m][0][2]; r[3] = BF_HI(g4.y) * acc[ai][bj][m][0][3];
                    r[4] = BF_LO(g4.z) * acc[ai][bj][m][1][0]; r[5] = BF_HI(g4.z) * acc[ai][bj][m][1][1]; r[6] = BF_LO(g4.w) * acc[ai][bj][m][1][2]; r[7] = BF_HI(g4.w) * acc[ai][bj][m][1][3];
                    if (STAGE == 1) { const v4u t4 = tt[m][bj];
                        r[0] += BF_LO(t4.x); r[1] += BF_HI(t4.x); r[2] += BF_LO(t4.y); r[3] += BF_HI(t4.y); r[4] += BF_LO(t4.z); r[5] += BF_HI(t4.z); r[6] += BF_LO(t4.w); r[7] += BF_HI(t4.w); }
                    v4u o; o.x = pg8::cvt_pk_bf16(r[0], r[1]); o.y = pg8::cvt_pk_bf16(r[2], r[3]); o.z = pg8::cvt_pk_bf16(r[4], r[5]); o.w = pg8::cvt_pk_bf16(r[6], r[7]);
                    *(GAS v4u*)(DST + off) = o; }
        }
    }
};
struct EpiOut {
    static constexpr bool PROBE_TWICE = false;
    unsigned char* ws; float* out; const float* xp; const float* xs;
    __device__ __forceinline__ void operator()(const pg8::f32x4 (&acc)[2][2][4][2], const pg8::Unit& u, int wr, int wc, int fr, int fq) const {
        const float* MOD = (const float*)(ws + WS_MOD); float* SUMSQ = (float*)(ws + WS_SUMSQ);
        const int rbase = u.pm * 256 + wr * 64 + fr; const bool samp = (u.pm == MP / 256);
#pragma unroll
        for (int ai = 0; ai < 2; ++ai)
#pragma unroll
            for (int m = 0; m < 4; ++m) { const int row = rbase + ai * 128 + m * 16;
                const bool valid = !samp || (row - MP < NS);
                const int mr = samp ? (8 + ((row - MP) & 31)) : (row >> 12);
                const float* gate = MOD + (size_t)mr * 3072 + 2048;
                const float* xr = samp ? (xs + (size_t)((row - MP) & 31) * DM) : (xp + (size_t)row * DM);
                float* orow = samp ? (out + O_YS + (size_t)((row - MP) & 31) * DM) : (out + O_YP + (size_t)row * DM);
                float ss = 0.f;
#pragma unroll
                for (int bj = 0; bj < 2; ++bj)
#pragma unroll
                    for (int n = 0; n < 2; ++n) { const int col = u.pn * 256 + 128 * bj + 32 * wc + 16 * n + 4 * fq;
                        const pg8::f32x4 x4 = *(const pg8::f32x4*)(xr + col), g4 = *(const pg8::f32x4*)(gate + col);
                        const pg8::f32x4 hv = x4 + g4 * acc[ai][bj][m][n];
                        ss += (hv[0] * hv[0] + hv[1] * hv[1]) + (hv[2] * hv[2] + hv[3] * hv[3]);
                        if (valid) *(pg8::f32x4*)(orow + col) = hv; }
                ss += __shfl_xor(ss, 16); ss += __shfl_xor(ss, 32);
                if (fq == 0 && valid) atomicAdd(SUMSQ + row, ss); }
    }
};
struct EpiOutNorm {
    static constexpr bool PROBE_TWICE = false;
    unsigned char* ws; float* out; const float* xp; const float* gfin; LAS unsigned char* tab;
    __device__ __forceinline__ void operator()(pg8::f32x4 (&acc)[2][2][4][2], const pg8::Unit& u, int wr, int wc, int fr, int fq) const {
        const float* MOD = (const float*)(ws + WS_MOD); float* XCH = (float*)(ws + WS_XCH); unsigned* cnt = (unsigned*)(ws + WS_CTL) + CW_PANEL + 64 * u.pm;
        LAS float* P = (LAS float*)tab; LAS float* RS = P + 1024;
        const int tid = threadIdx.x, wid = tid >> 6;
        const int rl0 = wr * 64 + fr;
        const int colb = u.pn * 256 + 32 * wc + 4 * fq;
        pg8::f32x4 gq[2][2];
        { const float* gate = MOD + (size_t)((u.pm * 256) >> 12) * 3072 + 2048;
#pragma unroll
          for (int bj = 0; bj < 2; ++bj)
#pragma unroll
              for (int n = 0; n < 2; ++n) gq[bj][n] = *(const pg8::f32x4*)(gate + colb + 128 * bj + 16 * n); }
#pragma unroll
        for (int ai = 0; ai < 2; ++ai) {
            pg8::f32x4 xq[4][2][2];
#pragma unroll
            for (int m = 0; m < 4; ++m) { const float* xr = xp + (size_t)(u.pm * 256 + rl0 + ai * 128 + m * 16) * DM;
#pragma unroll
                for (int bj = 0; bj < 2; ++bj)
#pragma unroll
                    for (int n = 0; n < 2; ++n) xq[m][bj][n] = *(const pg8::f32x4*)(xr + colb + 128 * bj + 16 * n); }
            asm volatile("" ::: "memory");
#pragma unroll
            for (int m = 0; m < 4; ++m) { const int rl = rl0 + ai * 128 + m * 16;
                float ss = 0.f;
#pragma unroll
                for (int bj = 0; bj < 2; ++bj)
#pragma unroll
                    for (int n = 0; n < 2; ++n) { const pg8::f32x4 hv = xq[m][bj][n] + gq[bj][n] * acc[ai][bj][m][n]; acc[ai][bj][m][n] = hv;
                        ss += (hv[0] * hv[0] + hv[1] * hv[1]) + (hv[2] * hv[2] + hv[3] * hv[3]); }
                ss += __shfl_xor(ss, 16); ss += __shfl_xor(ss, 32);
                if (fq == 0) P[rl * 4 + wc] = ss; }
        }
        __syncthreads();
        if (tid < 256) { const float sp = (P[tid * 4] + P[tid * 4 + 1]) + (P[tid * 4 + 2] + P[tid * 4 + 3]);
            __hip_atomic_store(XCH + ((size_t)(u.pm * 4 + u.pn) * 256 + tid), sp, __ATOMIC_RELAXED, __HIP_MEMORY_SCOPE_AGENT); }
        asm volatile("s_waitcnt vmcnt(0)" ::: "memory");
        __syncthreads();
        if (tid == 0) __hip_atomic_fetch_add(cnt, 1u, __ATOMIC_RELAXED, __HIP_MEMORY_SCOPE_AGENT);
        if (wid == 0) wait_count(cnt, 4u);
        __syncthreads();
        if (tid < 256) { float t = 0.f;
#pragma unroll
            for (int k = 0; k < 4; ++k) t += __hip_atomic_load(XCH + ((size_t)(u.pm * 4 + k) * 256 + tid), __ATOMIC_RELAXED, __HIP_MEMORY_SCOPE_AGENT);
            RS[tid] = 1.0f / sqrtf(t * (1.f / DM) + EPS); }
        __syncthreads();
        pg8::f32x4 gf[2][2];
#pragma unroll
        for (int bj = 0; bj < 2; ++bj)
#pragma unroll
            for (int n = 0; n < 2; ++n) gf[bj][n] = *(const pg8::f32x4*)(gfin + colb + 128 * bj + 16 * n);
#pragma unroll
        for (int ai = 0; ai < 2; ++ai)
#pragma unroll
            for (int m = 0; m < 4; ++m) { const int rl = rl0 + ai * 128 + m * 16, row = u.pm * 256 + rl; const float rstd = RS[rl];
                float* orow = out + O_YP + (size_t)row * DM;
#pragma unroll
                for (int bj = 0; bj < 2; ++bj)
#pragma unroll
                    for (int n = 0; n < 2; ++n) *(pg8::f32x4*)(orow + colb + 128 * bj + 16 * n) = acc[ai][bj][m][n] * rstd * gf[bj][n]; }
    }
};
template <int KIND> __device__ __forceinline__ void sample_gemm_tile(Frame& F, int ct) {
    const int tid = F.tid, lane = F.lane, w = F.wave, r32 = lane & 31, hi = lane >> 5;
    const bf16* A = (const bf16*)(F.ws + (KIND == 0 ? WS_PA : KIND == 1 ? WS_PB : WS_MM)) + (size_t)MP * DM;
    const bf16* Bt = (const bf16*)(F.ws + (KIND == 0 ? WS_WPA : KIND == 1 ? WS_WPB : WS_WO));
    LAS float* red = (LAS float*)F.lds;
    __syncthreads();
    if (KIND == 2 && tid < 32) red[8192 + tid] = 0.f;
    f32x16 acc = {};
#pragma unroll
    for (int s = 0; s < 8; ++s) { const int kk = 128 * w + 16 * s + 8 * hi;
        v4u ta = *(const GAS v4u*)(A + (size_t)r32 * DM + kk), tb = *(const GAS v4u*)(Bt + (size_t)(32 * ct + r32) * DM + kk);
        acc = __builtin_amdgcn_mfma_f32_32x32x16_bf16(*reinterpret_cast<bf16x8*>(&ta), *reinterpret_cast<bf16x8*>(&tb), acc, 0, 0, 0); }
#pragma unroll
    for (int i = 0; i < 16; ++i) red[(w * 16 + i) * 64 + lane] = acc[i];
    __syncthreads();
    float hkeep[2] = {0.f, 0.f};
#pragma unroll
    for (int e2 = 0; e2 < 2; ++e2) { const int e = tid + 512 * e2, i = e >> 6, l = e & 63; float v = 0.f;
#pragma unroll
        for (int ww = 0; ww < 8; ++ww) v += red[(ww * 16 + i) * 64 + l];
        const int row = (i & 3) + 8 * (i >> 2) + 4 * (l >> 5), g = 32 * ct + (l & 31);
        if (KIND < 2) { const int oc = (g & ~255) + perm_plain(g & 255); const size_t off = (size_t)(MP + row) * DM + oc;
            const bf16* GATE = (const bf16*)(F.ws + (KIND == 0 ? WS_SMA : WS_SMB)); bf16* T1 = (bf16*)(F.ws + WS_T1); bf16* MMb = (bf16*)(F.ws + WS_MM);
            if (KIND == 0) T1[off] = (bf16)f2bf(bf2f(GATE[off]) * v); else MMb[off] = (bf16)f2bf(bf2f(T1[off]) + bf2f(GATE[off]) * v); }
        else { const float* MOD = (const float*)(F.ws + WS_MOD);
            const float hv = F.in[1][(size_t)row * DM + g] + MOD[(size_t)(8 + row) * 3072 + 2048 + g] * v;
            hkeep[e2] = hv;
            float q = hv * hv;
            q += __shfl_xor(q, 1); q += __shfl_xor(q, 2); q += __shfl_xor(q, 4); q += __shfl_xor(q, 8); q += __shfl_xor(q, 16);
            if ((l & 31) == 0) __hip_atomic_fetch_add(red + 8192 + row, q, __ATOMIC_RELAXED, __HIP_MEMORY_SCOPE_WORKGROUP); } }
    __syncthreads();
    if (KIND == 2) {
        float* XS = (float*)(F.ws + WS_XCH + MiB); unsigned* cnt = (unsigned*)(F.ws + WS_CTL) + CW_PANEL + 64 * 128;
        if (tid < 32) __hip_atomic_store(XS + ct * 32 + tid, red[8192 + tid], __ATOMIC_RELAXED, __HIP_MEMORY_SCOPE_AGENT);
        asm volatile("s_waitcnt vmcnt(0)" ::: "memory");
        __syncthreads();
        if (tid == 0) __hip_atomic_fetch_add(cnt, 1u, __ATOMIC_RELAXED, __HIP_MEMORY_SCOPE_AGENT);
        if (w == 0) wait_count(cnt, 32u);
        __syncthreads();
        if (tid < 32) { float t = 0.f; for (int k = 0; k < 32; ++k) t += __hip_atomic_load(XS + k * 32 + tid, __ATOMIC_RELAXED, __HIP_MEMORY_SCOPE_AGENT); red[8192 + 64 + tid] = 1.0f / sqrtf(t * (1.f / DM) + EPS); }
        __syncthreads();
#pragma unroll
        for (int e2 = 0; e2 < 2; ++e2) { const int e = tid + 512 * e2, i = e >> 6, l = e & 63; const int row = (i & 3) + 8 * (i >> 2) + 4 * (l >> 5), g = 32 * ct + (l & 31);
            F.out[O_YS + (size_t)row * DM + g] = hkeep[e2] * red[8192 + 64 + row] * F.in[26][g]; }
        __syncthreads();
    }
}
__device__ __forceinline__ void p6_final_norm(Frame& F) {
    const int gw = F.vcu * NWAVES + F.wave, NGW = F.G * NWAVES, lane = F.lane;
    const float* SUMSQ = (const float*)(F.ws + WS_SUMSQ); const float* gf = F.in[26];
    for (int m = gw; m < MP + NS; m += NGW) {
        float* yr = (m < MP) ? (F.out + O_YP + (size_t)m * DM) : (F.out + O_YS + (size_t)(m - MP) * DM);
        const float rstd = 1.0f / sqrtf(SUMSQ[m] * (1.f / DM) + EPS);
        GAS f32x4* y4 = (GAS f32x4*)yr + lane;
#pragma unroll
        for (int j = 0; j < 4; ++j) { const f32x4 g4 = *(const f32x4*)(gf + 256 * j + 4 * lane); f32x4 v = y4[64 * j]; v = v * rstd * g4; y4[64 * j] = v; }
    }
}

__global__ void __launch_bounds__(NTHR, 2) fwd(Args args) {
    extern __shared__ __attribute__((aligned(16))) unsigned char lds_raw[];
    Frame F;
    F.lds = (LAS unsigned char*)lds_raw;
    F.tid = threadIdx.x; F.lane = F.tid & 63; F.wave = __builtin_amdgcn_readfirstlane(F.tid >> 6);
    F.G = gridDim.x; { const int bx = blockIdx.x; F.vcu = (F.G % 8 == 0) ? (bx % 8) * (F.G / 8) + bx / 8 : bx; }
    F.in = args.in; F.out = args.out; F.ws = args.ws;
    volatile LAS unsigned* MISC = (volatile LAS unsigned*)(F.lds + LDSCTL_OFF);
    for (int u = F.tid; u < (LDS_BYTES - LDSCTL_OFF) / 4; u += NTHR) ((LAS unsigned*)(F.lds + LDSCTL_OFF))[u] = 0u;
    __syncthreads();
    XcdBarrier bar; bar.bar = (unsigned*)(F.ws + WS_CTL) + CW_BAR; bar.x = 0; bar.st = nullptr;
#if N_LAUNCH_MODE == 1
    bar = xcd_barrier_post((unsigned*)(F.ws + WS_CTL) + CW_BAR, MISC + 8);
#define GRID_BAR() xcd_barrier(bar)
#else
#define GRID_BAR() do {} while (0)
#endif
    const int lo = args.ph_lo, hi = args.ph_hi;
#ifdef TIMING_PROBE
    unsigned long long* STAMP = (unsigned long long*)(F.ws + WS_CTL + 512 * 1024);
    int n_stamp = 0;
#define TSTAMP() do { if (blockIdx.x == 0 && F.tid == 0) STAMP[n_stamp] = __builtin_amdgcn_s_memrealtime(); ++n_stamp; } while (0)
#else
#define TSTAMP() do {} while (0)
#endif
    TSTAMP();
#ifndef PHASE_MASK
#define PHASE_MASK 0xFFFF
#endif
#define IN(k) (((PHASE_MASK >> (k)) & 1) && lo <= (k) && (k) < hi)
#define BOTH(k) (IN(k) && IN((k) + 1))
    if (IN(0)) { p0_prologue(F); p0_build_wg(F); TSTAMP(); }
    if (IN(1)) { REP(10) p1_weights(F);
        __syncthreads(); if (F.wave == 0) wait_count((unsigned*)(F.ws + WS_CTL) + CW_MODCNT, 192u); __syncthreads();
        REP(1) p0b_norm(F); if (BOTH(1)) GRID_BAR(); TSTAMP(); }
    if (IN(2)) {
        pg8::Gemm g{(const bf16*)(F.ws + WS_XN), (const bf16*)(F.ws + WS_WIN), MT, N_IN_PAD, DM}; pg8::StaticOrder S; S.init(MT, N_IN_PAD, F.G, (int)blockIdx.x, 2);
        EpiIn E{F.ws, F.out, F.in[21], F.in[22]};
        REP(2) pg8::gemm_phase<EpiIn, pg8::StaticOrder, true, true>(F.lds, g, S, E);
        if (BOTH(2)) GRID_BAR();
        TSTAMP();
    }
    if (IN(3)) {
        if (blockIdx.x & 8) p3_conv_pass(F);
        REP(31) p3a_indexer(F, args.page_table);
        if (!(blockIdx.x & 8)) p3_conv_pass(F);
        for (int u = F.G - 1 - F.vcu; u < NS * 4; u += F.G) p2_rglru_sample_unit(F, u);
        if (F.G > 64) { REP(41) for (int b = F.vcu; b < NS; b += F.G) p3b_sample_unit(F, args.page_table, b); }
        else { for (int b = F.vcu; b < NS; b += F.G) p3b_sample_unit(F, args.page_table, b); }
        if (BOTH(3)) GRID_BAR();
        TSTAMP();
    }
    if (IN(4)) {
        p2_rglru(F, (REPEAT_PHASE == 30) ? 2 : 1);
        __syncthreads();
        p3b_attention(F, (REPEAT_PHASE == 42) ? 2 : 1);
        if (BOTH(4)) GRID_BAR();
        TSTAMP();
    }
    if (IN(5)) {
        for (int ct = F.vcu; ct < 32; ct += F.G) { sample_gemm_tile<0>(F, ct); sample_gemm_tile<1>(F, ct); }
        { pg8::Gemm g{(const bf16*)(F.ws + WS_PA), (const bf16*)(F.ws + WS_WPA), MP, DM, DM}; pg8::StaticOrder S; S.init(MP, DM, F.G, (int)blockIdx.x);
          EpiMerge<0> E{F.ws};
          REP(40) pg8::gemm_phase<EpiMerge<0>, pg8::StaticOrder, true, true>(F.lds, g, S, E); }
        { pg8::Gemm g{(const bf16*)(F.ws + WS_PB), (const bf16*)(F.ws + WS_WPB), MP, DM, DM}; pg8::StaticOrder S; S.init(MP, DM, F.G, (int)blockIdx.x);
          EpiMerge<1> E{F.ws};
          REP(5) pg8::gemm_phase<EpiMerge<1>, pg8::StaticOrder, true, true>(F.lds, g, S, E); }
        if (BOTH(5)) GRID_BAR();
        TSTAMP();
    }
    if (IN(6)) {
        for (int ct = F.vcu; ct < 32; ct += F.G) sample_gemm_tile<2>(F, ct);
        pg8::Gemm g{(const bf16*)(F.ws + WS_MM), (const bf16*)(F.ws + WS_WO), MP, DM, DM}; pg8::StaticOrder S; S.init(MP, DM, F.G, (int)blockIdx.x);
        EpiOutNorm E{F.ws, F.out, F.in[0], F.in[26], F.lds + RING_BYTES};
        pg8::gemm_phase<EpiOutNorm, pg8::StaticOrder, true, true>(F.lds, g, S, E);
        TSTAMP();
    }
#ifdef STATS_PROBE
    GRID_BAR();
    {   const unsigned* ST = (const unsigned*)(F.ws + WS_CTL + 768 * 1024);
        unsigned st[8];
#pragma unroll
        for (int k = 0; k < 8; ++k) st[k] = __hip_atomic_load(ST + k, __ATOMIC_RELAXED, __HIP_MEMORY_SCOPE_AGENT);
        const unsigned enc[8] = { st[1] ? (unsigned)(((unsigned long long)st[0] * 10ull) / st[1]) : 0u, st[2] / 2048u, st[3] / 2048u, st[4] / 2048u, st[5] / 16u, st[6] / 8u, st[1], 0u };
        const size_t chan_off[8] = {O_YS, O_CP, O_LP, O_KS, O_VS, O_IKS, O_CS, O_LS};
        const size_t gt = (size_t)blockIdx.x * NTHR + F.tid, NGT = (size_t)F.G * NTHR;
        for (size_t i = gt; i < O_END; i += NGT) { bool skip = false;
#pragma unroll
            for (int k = 0; k < 8; ++k) skip = skip || (i >= chan_off[k] && i < chan_off[k] + enc[k]);
            if (!skip) args.out_real[i] = 0.f; }
    }
#endif
#ifdef TIMING_PROBE
    GRID_BAR(); TSTAMP();
    if (blockIdx.x == 0 && F.tid == 0) { for (int k = 0; k < 8; ++k) ((unsigned*)(F.ws + WS_CTL + 768 * 1024))[k] = (unsigned)((STAMP[k + 1] - STAMP[k]) / 100ull); }
    GRID_BAR();
    {
        const unsigned* dur = (const unsigned*)(F.ws + WS_CTL + 768 * 1024);
        const size_t chan_off[8] = {O_YS, O_CP, O_LP, O_KS, O_VS, O_IKS, O_CS, O_LS};
        const size_t gt = (size_t)blockIdx.x * NTHR + F.tid, NGT = (size_t)F.G * NTHR;
        for (size_t i = gt; i < O_END; i += NGT) { bool skip = false;
#pragma unroll
            for (int k = 0; k < 8; ++k) skip = skip || (i >= chan_off[k] && i < chan_off[k] + __hip_atomic_load(dur + k, __ATOMIC_RELAXED, __HIP_MEMORY_SCOPE_AGENT));
            if (!skip) args.out_real[i] = 0.f; }
    }
#endif
}

extern "C" void kernel_launch(void* const* d_in, const int* in_sizes, int n_in, void* d_out, int out_size, void* d_ws, size_t ws_size, hipStream_t stream) {
    static int grid = 0;
    if (grid == 0) {
        if (n_in != 27 || (size_t)out_size != O_END || ws_size < WS_END) { fprintf(stderr, "kernel_launch: unexpected shapes n_in %d out %d ws %zu (want 27, %zu, >= %zu)\n", n_in, out_size, ws_size, (size_t)O_END, (size_t)WS_END); grid = -1; return; }
        int dev = 0, cus = 0;
        if (hipGetDevice(&dev) != hipSuccess || hipDeviceGetAttribute(&cus, hipDeviceAttributeMultiprocessorCount, dev) != hipSuccess) { grid = -1; return; }
        if (hipFuncSetAttribute((const void*)fwd, hipFuncAttributeMaxDynamicSharedMemorySize, LDS_BYTES) != hipSuccess) { fprintf(stderr, "kernel_launch: hipFuncSetAttribute failed\n"); grid = -1; return; }
        int per_cu = 0;
        if (hipOccupancyMaxActiveBlocksPerMultiprocessor(&per_cu, (const void*)fwd, NTHR, LDS_BYTES) != hipSuccess || per_cu < 1) fprintf(stderr, "kernel_launch: occupancy query says %d\n", per_cu);
        (void)hipGetLastError();
        grid = cus;
    }
    if (grid < 0) return;
    hipMemsetAsync((char*)d_ws + WS_CTL, 0, ZERO_BYTES, stream);
    Args a{};
    for (int i = 0; i < 27; ++i) a.in[i] = (const float*)d_in[i];
    a.page_table = (const int*)d_in[7];
#if defined(TIMING_PROBE) || defined(STATS_PROBE)
    a.out = (float*)((unsigned char*)d_ws + WS_END); a.out_real = (float*)d_out;
#else
    a.out = (float*)d_out; a.out_real = (float*)d_out;
#endif
    a.ws = (unsigned char*)d_ws;
#if N_LAUNCH_MODE == 1
    a.ph_lo = 0; a.ph_hi = LAST_PHASE + 1;
    hipLaunchKernelGGL(fwd, dim3(grid), dim3(NTHR), LDS_BYTES, stream, a);
#else
    for (int p = 0; p <= LAST_PHASE; ++p) { a.ph_lo = p; a.ph_hi = p + 1; hipLaunchKernelGGL(fwd, dim3(grid), dim3(NTHR), LDS_BYTES, stream, a); }
#endif
}
```

```cpp
#include <hip/hip_runtime.h>
#include <cstdio>
#include <cstdint>

#ifndef REPEAT_PHASE
#define REPEAT_PHASE -1
#endif
#define REP(k) for (int rep_ = 0; rep_ < ((REPEAT_PHASE == (k)) ? 2 : 1); ++rep_)
#ifndef N_LAUNCH_MODE
#define N_LAUNCH_MODE 1
#endif
#ifndef LAST_PHASE
#define LAST_PHASE 6
#endif

namespace pg8 {
#define PG8_LAS __attribute__((address_space(3)))
typedef unsigned short bf16_t;
typedef short bf16x8 __attribute__((ext_vector_type(8)));
typedef float f32x4 __attribute__((ext_vector_type(4)));
typedef unsigned u32x4 __attribute__((ext_vector_type(4)));
typedef unsigned u32x2 __attribute__((ext_vector_type(2)));
constexpr int BM = 256, BK = 64, HALF = 128, HTB = HALF * BK * 2, STAGE_BYTES = 8 * HTB, NXCD = 8, WGM = 8;

__host__ __device__ __forceinline__ int lds_byte(int r, int c) { const int st = (r >> 4) * 2 + (c >> 5), rr = r & 15, cc = c & 31, ob = rr * 64 + cc * 2; return st * 1024 + (ob ^ (((ob >> 9) & 1) << 5)); }
__host__ __device__ __forceinline__ void stage_rc(int b, int& R, int& C) { const int st = b / 1024, sb = b % 1024, swz = sb ^ (((sb >> 9) & 1) << 5); R = (st >> 1) * 16 + swz / 64; C = (st & 1) * 32 + (swz % 64) / 2; }

struct Unit { int pm, pn; };
struct Gemm { const bf16_t* A; const bf16_t* Bt; int M, N, K; };

struct StaticOrder {
    int nM, nN, nwg, G, c, wgm;
    __host__ __device__ void init(int M, int N, int G_, int c_, int wgm_ = WGM) { nM = M / BM; nN = N / BM; nwg = nM * nN; G = G_; c = c_; wgm = wgm_; }
    __host__ __device__ bool next(int i, Unit& u) const {
        const long L = (long)i * G + c; if (L >= nwg) return false;
        int wgid = (int)L; { const int q = nwg / NXCD, r = nwg % NXCD, xcd = wgid % NXCD, off = wgid / NXCD; wgid = (xcd < r ? xcd * (q + 1) : r * (q + 1) + (xcd - r) * q) + off; }
        const int nig = wgm * nN, gid = wgid / nig, fm = gid * wgm, gsz = (nM - fm) < wgm ? (nM - fm) : wgm;
        u.pm = fm + ((wgid % nig) % gsz); u.pn = (wgid % nig) / gsz; return true;
    }
    __device__ __forceinline__ void a_ready(const Unit&) const {}
    __device__ __forceinline__ void done(const Unit&) const {}
};

__device__ __forceinline__ unsigned cvt_pk_bf16(float lo, float hi) { unsigned r; asm volatile("v_cvt_pk_bf16_f32 %0, %1, %2" : "=v"(r) : "v"(lo), "v"(hi)); return r; }

template <class Epi, class Sched, bool ALIGN_EPI = false, bool SP2 = true>
__device__ __forceinline__ void gemm_phase(PG8_LAS unsigned char* lds, const Gemm g, const Sched& S, const Epi& E) {
    const int tid = threadIdx.x, wid = __builtin_amdgcn_readfirstlane(tid >> 6), lane = tid & 63, wr = wid >> 2, wc = wid & 3, fr = lane & 15, fq = lane >> 4;
    const int K = g.K, nt = K / BK;
    unsigned voffA[2], voffB[2];
#pragma unroll
    for (int i = 0; i < 2; ++i) { int R, C; stage_rc(tid * 16 + i * 8192, R, C);
        voffA[i] = (unsigned)(R * K + C) * 2u; voffB[i] = (unsigned)(R * K + C) * 2u; }
    const size_t kstep = (size_t)(BK * 2);
    const size_t hstep = (size_t)HALF * K * 2;
    const size_t tstep = 2 * hstep;
    const unsigned ldsw = (unsigned)wid * 1024u;
    const int aoff = lds_byte(wr * 64 + fr, fq * 8), boff = lds_byte(wc * 32 + fr, fq * 8);
#define PG8_SA(b, h) (((b) * 2 + (h)) * HTB)
#define PG8_SB(b, h) ((4 + (b) * 2 + (h)) * HTB)
#define PG8_STAGE(bufoff, gbase, voff) do { _Pragma("unroll") for (int _i = 0; _i < 2; ++_i) \
        __builtin_amdgcn_global_load_lds((const unsigned*)((const char*)(gbase) + (voff)[_i]), (PG8_LAS unsigned*)(lds + (bufoff) + ldsw + _i * 8192), 16, 0, 0); } while (0)
#define PG8_LDA(dst, b, h) do { _Pragma("unroll") for (int m = 0; m < 4; ++m) _Pragma("unroll") for (int k = 0; k < 2; ++k) dst[m][k] = *(const PG8_LAS bf16x8*)(lds + PG8_SA(b, h) + aoff + m * 2048 + k * 1024); } while (0)
#define PG8_LDB(dst, b, h) do { _Pragma("unroll") for (int n = 0; n < 2; ++n) _Pragma("unroll") for (int k = 0; k < 2; ++k) dst[n][k] = *(const PG8_LAS bf16x8*)(lds + PG8_SB(b, h) + boff + n * 2048 + k * 1024); } while (0)
#define PG8_MMA(ai, bj, At, Bt) do { __builtin_amdgcn_s_setprio(1); _Pragma("unroll") for (int m = 0; m < 4; ++m) _Pragma("unroll") for (int n = 0; n < 2; ++n) _Pragma("unroll") for (int k = 0; k < 2; ++k) \
        acc[ai][bj][m][n] = __builtin_amdgcn_mfma_f32_16x16x32_bf16(Bt[n][k], At[m][k], acc[ai][bj][m][n], 0, 0, 0); __builtin_amdgcn_s_setprio(0); } while (0)
#define PG8_WAIT_V(n) asm volatile("s_waitcnt vmcnt(" #n ")" ::: "memory")
#define PG8_WAIT_L(n) asm volatile("s_waitcnt lgkmcnt(" #n ")" ::: "memory")
#define PG8_BAR __builtin_amdgcn_s_barrier()
#define PG8_SCHED __builtin_amdgcn_sched_barrier(0)
    Unit cur, nxt; int ui = 0;
    if (!S.next(0, cur)) return;
    f32x4 acc[2][2][4][2];
#pragma unroll
    for (int a = 0; a < 2; ++a)
#pragma unroll
        for (int b = 0; b < 2; ++b)
#pragma unroll
            for (int m = 0; m < 4; ++m)
#pragma unroll
                for (int n = 0; n < 2; ++n) acc[a][b][m][n] = (f32x4){0.f, 0.f, 0.f, 0.f};
    bf16x8 At[4][2], B0[2][2], B1[2][2];
    const char* cA = (const char*)g.A + (size_t)cur.pm * tstep; const char* cB = (const char*)g.Bt + (size_t)cur.pn * tstep;
    S.a_ready(cur);
    if constexpr (SP2) {
        PG8_STAGE(PG8_SB(0, 0), cB, voffB); PG8_STAGE(PG8_SB(0, 1), cB + hstep, voffB); PG8_STAGE(PG8_SA(0, 0), cA, voffA); PG8_STAGE(PG8_SA(0, 1), cA + hstep, voffA);
        if (wr == 1) PG8_BAR;
        PG8_WAIT_V(2); PG8_BAR;
        PG8_STAGE(PG8_SB(1, 0), cB + kstep, voffB); PG8_STAGE(PG8_SA(1, 0), cA + kstep, voffA); PG8_STAGE(PG8_SB(1, 1), cB + hstep + kstep, voffB);
        PG8_WAIT_V(6); PG8_BAR;
    } else {
        PG8_STAGE(PG8_SB(0, 0), cB, voffB); PG8_STAGE(PG8_SA(0, 0), cA, voffA); PG8_STAGE(PG8_SB(0, 1), cB + hstep, voffB); PG8_STAGE(PG8_SA(0, 1), cA + hstep, voffA);
        if (wr == 1) PG8_BAR;
        PG8_WAIT_V(4); PG8_BAR;
        PG8_STAGE(PG8_SB(1, 0), cB + kstep, voffB); PG8_STAGE(PG8_SA(1, 0), cA + kstep, voffA); PG8_STAGE(PG8_SB(1, 1), cB + hstep + kstep, voffB);
        PG8_WAIT_V(6); PG8_BAR;
    }
    for (;;) {
        const bool has_next = S.next(ui + 1, nxt);
        const char* nA = has_next ? (const char*)g.A + (size_t)nxt.pm * tstep : cA; const char* nB = has_next ? (const char*)g.Bt + (size_t)nxt.pn * tstep : cB;
        for (int t = 0; t < nt; t += 2) {
            const bool last = (t == nt - 2);
            const char* a1 = cA + (size_t)(t + 1) * kstep;
            const char* a2 = last ? nA : cA + (size_t)(t + 2) * kstep; const char* b2 = last ? nB : cB + (size_t)(t + 2) * kstep;
            const char* a3 = a2 + kstep; const char* b3 = b2 + kstep;
            if (last && has_next) S.a_ready(nxt);
            if constexpr (SP2) {
            PG8_LDB(B0, 0, 0); PG8_LDB(B1, 0, 1); PG8_SCHED; PG8_LDA(At, 0, 0); PG8_STAGE(PG8_SA(1, 1), a1 + hstep, voffA);
            PG8_WAIT_V(8); PG8_WAIT_L(0); PG8_BAR; PG8_MMA(0, 0, At, B0); PG8_MMA(0, 1, At, B1); PG8_BAR; PG8_SCHED;
            PG8_LDA(At, 0, 1); PG8_STAGE(PG8_SB(0, 0), b2, voffB); PG8_STAGE(PG8_SB(0, 1), b2 + hstep, voffB); PG8_STAGE(PG8_SA(0, 0), a2, voffA);
            PG8_WAIT_V(8); PG8_WAIT_L(0); PG8_BAR; PG8_MMA(1, 0, At, B0); PG8_MMA(1, 1, At, B1); PG8_BAR; PG8_SCHED;
            PG8_LDB(B0, 1, 0); PG8_LDB(B1, 1, 1); PG8_SCHED; PG8_LDA(At, 1, 0); PG8_STAGE(PG8_SA(0, 1), a2 + hstep, voffA);
            PG8_WAIT_V(8); PG8_WAIT_L(0); PG8_BAR; PG8_MMA(0, 0, At, B0); PG8_MMA(0, 1, At, B1); PG8_BAR; PG8_SCHED;
            PG8_LDA(At, 1, 1); PG8_STAGE(PG8_SB(1, 0), b3, voffB); PG8_STAGE(PG8_SB(1, 1), b3 + hstep, voffB); PG8_STAGE(PG8_SA(1, 0), a3, voffA);
            PG8_WAIT_V(8); PG8_WAIT_L(0); PG8_BAR; PG8_MMA(1, 0, At, B0); PG8_MMA(1, 1, At, B1); PG8_BAR; PG8_SCHED;
            } else {
            PG8_LDB(B0, 0, 0); PG8_SCHED; PG8_LDA(At, 0, 0); PG8_STAGE(PG8_SA(1, 1), a1 + hstep, voffA);
            PG8_WAIT_L(8); PG8_BAR; PG8_WAIT_L(0); PG8_MMA(0, 0, At, B0); PG8_BAR; PG8_SCHED;
            PG8_LDB(B1, 0, 1); PG8_STAGE(PG8_SB(0, 0), b2, voffB);
            PG8_BAR; PG8_WAIT_L(0); PG8_MMA(0, 1, At, B1); PG8_BAR;
            PG8_LDA(At, 0, 1); PG8_STAGE(PG8_SA(0, 0), a2, voffA);
            PG8_BAR; PG8_WAIT_L(0); PG8_MMA(1, 0, At, B0); PG8_BAR; PG8_SCHED;
            PG8_STAGE(PG8_SB(0, 1), b2 + hstep, voffB);
            PG8_WAIT_V(6); PG8_BAR; PG8_MMA(1, 1, At, B1); PG8_BAR;
            PG8_LDB(B0, 1, 0); PG8_SCHED; PG8_LDA(At, 1, 0); PG8_STAGE(PG8_SA(0, 1), a2 + hstep, voffA);
            PG8_WAIT_L(8); PG8_BAR; PG8_WAIT_L(0); PG8_MMA(0, 0, At, B0); PG8_BAR; PG8_SCHED;
            PG8_LDB(B1, 1, 1); PG8_STAGE(PG8_SB(1, 0), b3, voffB);
            PG8_BAR; PG8_WAIT_L(0); PG8_MMA(0, 1, At, B1); PG8_BAR;
            PG8_LDA(At, 1, 1); PG8_STAGE(PG8_SA(1, 0), a3, voffA);
            PG8_BAR; PG8_WAIT_L(0); PG8_MMA(1, 0, At, B0); PG8_BAR; PG8_SCHED;
            PG8_STAGE(PG8_SB(1, 1), b3 + hstep, voffB);
            PG8_WAIT_V(6); PG8_BAR; PG8_MMA(1, 1, At, B1); PG8_BAR;
            }
        }
        if constexpr (ALIGN_EPI) { if (wr == 0) PG8_BAR; }
        E(acc, cur, wr, wc, fr, fq); if constexpr (Epi::PROBE_TWICE) { if (REPEAT_PHASE == 20) E(acc, cur, wr, wc, fr, fq); } S.done(cur);
        if (!has_next) break;
#pragma unroll
        for (int a = 0; a < 2; ++a)
#pragma unroll
            for (int b = 0; b < 2; ++b)
#pragma unroll
                for (int m = 0; m < 4; ++m)
#pragma unroll
                    for (int n = 0; n < 2; ++n) acc[a][b][m][n] = (f32x4){0.f, 0.f, 0.f, 0.f};
        cur = nxt; cA = nA; cB = nB; ++ui;
        if constexpr (ALIGN_EPI) { if (wr == 1) PG8_BAR; }
    }
    PG8_WAIT_V(0);
    if constexpr (!ALIGN_EPI) { if (wr == 0) PG8_BAR; }
    PG8_BAR;
#undef PG8_SA
#undef PG8_SB
#undef PG8_STAGE
#undef PG8_LDA
#undef PG8_LDB
#undef PG8_MMA
#undef PG8_WAIT_V
#undef PG8_WAIT_L
#undef PG8_BAR
#undef PG8_SCHED
}
}

constexpr int DM = 1024, NBATCH = 8, SEQ = 4096, MP = NBATCH * SEQ, NS = 32, MT = MP + 256;
constexpr int PAST = 16384, PAGE = 128, NPG = PAST / PAGE;
constexpr int D_IN = 7240, NT_IN = 29, N_IN_PAD = NT_IN * 256;
constexpr int C_XA = 0, C_GA = 1024, C_Q = 2048, C_K = 3072, C_V = 3328, C_GB = 3584, C_QI = 4608, C_KI = 5120, C_WI = 5184, C_MA = 5192, C_MB = 6216;
constexpr float EPS = 1e-6f;
constexpr float IDX_W_SCALE = 0.04419417382415922f;
constexpr int NWAVES = 8, NTHR = 512;

constexpr size_t O_YP = 0, O_YS = O_YP + (size_t)MP * DM, O_KP = O_YS + (size_t)NS * DM, O_VP = O_KP + (size_t)MP * 256, O_IKP = O_VP + (size_t)MP * 256,
                 O_CP = O_IKP + (size_t)MP * 64, O_LP = O_CP + (size_t)NBATCH * 3 * DM, O_KS = O_LP + (size_t)NBATCH * DM, O_VS = O_KS + (size_t)NS * 256,
                 O_IKS = O_VS + (size_t)NS * 256, O_CS = O_IKS + (size_t)NS * 64, O_LS = O_CS + (size_t)NS * 3 * DM, O_END = O_LS + (size_t)NS * DM;

constexpr size_t MiB = 1u << 20;
constexpr size_t WS_CTL = 0;
constexpr size_t WS_MOD = 1 * MiB;
constexpr size_t WS_SUMSQ = WS_MOD + 512 * 1024;
constexpr size_t ZERO_BYTES = 2 * MiB;
constexpr size_t WS_RT128 = 2 * MiB;
constexpr size_t WS_RT64 = WS_RT128 + 3 * MiB;
constexpr size_t WS_WG = 7 * MiB;
constexpr size_t WS_WPA = 8 * MiB, WS_WPB = 10 * MiB, WS_WO = 12 * MiB;
constexpr size_t WS_WIN = 14 * MiB;
constexpr size_t WS_WI = 30 * MiB;
constexpr size_t WS_KI = 32 * MiB;
constexpr size_t WS_SSC = 38 * MiB;
constexpr size_t WS_XCH = 44 * MiB;
constexpr size_t WS_MSK = 48 * MiB;
constexpr size_t ACT = (size_t)MT * DM * 2;
constexpr size_t WS_XN = 64 * MiB;
constexpr size_t WS_XC = WS_XN;
constexpr size_t WS_XA = WS_XN + 65 * MiB, WS_SGA = WS_XA + 65 * MiB, WS_Q = WS_SGA + 65 * MiB, WS_SGB = WS_Q + 65 * MiB, WS_SMA = WS_SGB + 65 * MiB, WS_SMB = WS_SMA + 65 * MiB;
constexpr size_t WS_PA = WS_SMB + 65 * MiB, WS_PB = WS_PA + 65 * MiB, WS_T1 = WS_PB + 65 * MiB, WS_MM = WS_T1 + 65 * MiB;
constexpr size_t WS_KB = WS_MM + 65 * MiB, WS_VB = WS_KB + 17 * MiB, WS_QI = WS_VB + 17 * MiB, WS_END = WS_QI + 33 * MiB;
static_assert(ACT <= 65 * MiB, "activation size");

constexpr int CW_BAR = 4096;
constexpr int CW_PANEL = 8192;

constexpr int RING_BYTES = 131072;
constexpr int CW_MODCNT = CW_PANEL + 64 * 176;
constexpr int LDSCTL_OFF = 160 * 1024 - 512, LDS_BYTES = 160 * 1024;

#define GAS __attribute__((address_space(1)))
#define LAS __attribute__((address_space(3)))
typedef unsigned short bf16;
typedef unsigned v4u __attribute__((ext_vector_type(4)));
typedef unsigned v2u __attribute__((ext_vector_type(2)));
typedef float f32x4 __attribute__((ext_vector_type(4)));
typedef float f32x2 __attribute__((ext_vector_type(2)));
typedef short bf16x8 __attribute__((ext_vector_type(8)));
#define LDS_WAIT() asm volatile("s_waitcnt lgkmcnt(0)" ::: "memory")
#define VM_WAIT() asm volatile("s_waitcnt vmcnt(0)" ::: "memory")
__device__ __forceinline__ unsigned f2bf(float f) { unsigned u = __builtin_bit_cast(unsigned, f); return (u + 0x7fffu + ((u >> 16) & 1u)) >> 16; }
__device__ __forceinline__ unsigned pk2(float lo, float hi) { return f2bf(lo) | (f2bf(hi) << 16); }
__device__ __forceinline__ float bf2f(unsigned short b) { return __uint_as_float(((unsigned)b) << 16); }
__device__ __forceinline__ float sigmoidf_(float x) { return __builtin_amdgcn_rcpf(1.0f + __builtin_amdgcn_exp2f(-1.4426950408889634f * x)); }
__device__ __forceinline__ float siluf_(float x) { return x * __builtin_amdgcn_rcpf(1.0f + __builtin_amdgcn_exp2f(-1.4426950408889634f * x)); }

#define XB_TMO      128
#define XB_XCNT(j)  (256  + 64 * (j))
#define XB_XSUB(j)  (1280 + 64 * (j))
#define XB_XGEN(j)  (2304 + 64 * (j))
#define XB_TOP      3328
#define XB_TOPGEN   3392
#define XCD_BAR_WORDS 3456
#define XB_SPIN_CAP (1u << 18)
__device__ __forceinline__ unsigned xb_ld(unsigned* p)              { return __hip_atomic_load(p, __ATOMIC_RELAXED, __HIP_MEMORY_SCOPE_AGENT); }
__device__ __forceinline__ unsigned xb_add(unsigned* p, unsigned v) { return __hip_atomic_fetch_add(p, v, __ATOMIC_RELAXED, __HIP_MEMORY_SCOPE_AGENT); }
__device__ __forceinline__ unsigned xb_xcc_id() { return (unsigned)__builtin_amdgcn_s_getreg((3 << 11) | 20) & 0xFu; }
#define XB_SPIN(cond, bar) do { unsigned _sp = 0; while (cond) { __builtin_amdgcn_s_sleep(1); \
    if ((++_sp & 255u) == 0u) { if (xb_ld(&(bar)[XB_TMO])) break; if (_sp > XB_SPIN_CAP) { atomicAdd(&(bar)[XB_TMO], 1u); break; } } } } while (0)
struct XcdBarrier { unsigned* bar; unsigned x; volatile LAS unsigned* st; };
__device__ __forceinline__ XcdBarrier xcd_barrier_post(unsigned* bar, volatile LAS unsigned* st) {
    XcdBarrier b; b.bar = bar; b.x = xb_xcc_id(); b.st = st;
    if (threadIdx.x == 0) (void)xb_add(&bar[XB_XCNT(b.x)], 1u);
    return b;
}
__device__ __forceinline__ void xcd_barrier_complete(unsigned* bar, unsigned x, unsigned& nloc, unsigned& nx) {
    const unsigned G = gridDim.x * gridDim.y * gridDim.z;
    unsigned sum, cnt, mine, sp = 0u;
    for (;;) {
        sum = 0u; cnt = 0u; mine = 0u;
#pragma unroll
        for (unsigned j = 0; j < 16; ++j) { const unsigned c = xb_ld(&bar[XB_XCNT(j)]); sum += c; cnt += (c > 0u) ? 1u : 0u; mine = (j == x) ? c : mine; }
        if (sum == G) break;
        __builtin_amdgcn_s_sleep(1);
        if ((++sp & 255u) == 0u) { if (xb_ld(&bar[XB_TMO])) break; if (sp > XB_SPIN_CAP) { atomicAdd(&bar[XB_TMO], 1u); break; } }
    }
    nloc = mine > 0u ? mine : 1u; nx = cnt > 0u ? cnt : 1u;
}
__device__ __forceinline__ void xcd_barrier(const XcdBarrier& b) {
    asm volatile("s_waitcnt vmcnt(0)" ::: "memory");
    __syncthreads();
    if (threadIdx.x == 0) {
        unsigned* bar = b.bar;
        __builtin_amdgcn_s_waitcnt(0);
        unsigned nloc = b.st[0], nx = b.st[1];
        if (nloc == 0u) { xcd_barrier_complete(bar, b.x, nloc, nx); b.st[0] = nloc; b.st[1] = nx; }
        const unsigned old = xb_add(&bar[XB_XSUB(b.x)], 1u);
        const unsigned gen = old / nloc;
        if (old + 1u == (gen + 1u) * nloc) {
            __builtin_amdgcn_fence(__ATOMIC_RELEASE, "agent");
            asm volatile("s_waitcnt vmcnt(0)" ::: "memory");
            const unsigned og = xb_add(&bar[XB_TOP], 1u);
            const unsigned tg = og / nx;
            if (og + 1u == (tg + 1u) * nx) xb_add(&bar[XB_TOPGEN], 1u);
            else XB_SPIN(xb_ld(&bar[XB_TOPGEN]) == tg, bar);
            __builtin_amdgcn_fence(__ATOMIC_ACQUIRE, "agent");
            xb_add(&bar[XB_XGEN(b.x)], 1u);
            asm volatile("s_waitcnt vmcnt(0)" ::: "memory");
        } else {
            XB_SPIN(xb_ld(&bar[XB_XGEN(b.x)]) == gen, bar);
            __builtin_amdgcn_fence(__ATOMIC_ACQUIRE, "agent");
            asm volatile("s_waitcnt vmcnt(0)" ::: "memory");
        }
    }
    __syncthreads();
}

struct Args { const float* in[27]; const int* page_table; float* out; unsigned char* ws; float* out_real; int ph_lo, ph_hi; };
struct Frame {
    LAS unsigned char* lds;
    int tid, lane, wave, vcu, G;
    const float* const* in;
    float* out; unsigned char* ws;
};
__device__ __forceinline__ float wave_sum(float v) {
#pragma unroll
    for (int o = 1; o < 64; o <<= 1) v += __shfl_xor(v, o);
    return v;
}

__host__ __device__ __forceinline__ int perm_plain(int g) { const int bj = g >> 7, wc = (g >> 5) & 3, n = (g >> 4) & 1, fq = (g >> 2) & 3, j = g & 3; return 128 * bj + 32 * wc + 8 * fq + 4 * n + j; }
__host__ __device__ __forceinline__ int perm_rot128(int g) { const int bj = g >> 7, wc = (g >> 5) & 3, n = (g >> 4) & 1, fq = (g >> 2) & 3, j = g & 3; return 128 * bj + 64 * n + 16 * wc + 4 * fq + j; }
__host__ __device__ __forceinline__ int perm_rot64(int g) { const int bj = g >> 7, wc = (g >> 5) & 3, n = (g >> 4) & 1, fq = (g >> 2) & 3, j = g & 3; return 64 * (2 * bj + (wc >> 1)) + 32 * n + 16 * (wc & 1) + 4 * fq + j; }
__device__ __forceinline__ int win_src_col(int gg) {
    const int pn = gg >> 8, g = gg & 255;
    if (pn < 4)  return C_XA + pn * 256 + perm_plain(g);
    if (pn < 8)  return C_GA + (pn - 4) * 256 + perm_plain(g);
    if (pn < 12) return C_Q + (pn - 8) * 256 + perm_rot128(g);
    if (pn == 12) return C_K + perm_rot128(g);
    if (pn == 13) return C_V + perm_plain(g);
    if (pn < 18) return C_GB + (pn - 14) * 256 + perm_plain(g);
    if (pn < 20) return C_QI + (pn - 18) * 256 + perm_rot64(g);
    if (pn == 20) { const int bj = g >> 7, wc = (g >> 5) & 3, n = (g >> 4) & 1, fq = (g >> 2) & 3, j = g & 3;
        if (wc == 0) return C_KI + 32 * bj + 16 * n + 4 * fq + j;
        if (wc == 1 && bj == 0 && n == 0 && fq < 2) return C_WI + 4 * fq + j;
        return -1; }
    if (pn < 25) return C_MA + (pn - 21) * 256 + perm_plain(g);
    return C_MB + (pn - 25) * 256 + perm_plain(g);
}

template <int MODE>
__device__ __forceinline__ void p0_transpose_item(const float* W, int K, int N, bf16* WT, LAS float* scr, int item, int lane, int ndst) {
    const int nblk = ndst / 32, kb = item / nblk, nb = item % nblk, k0 = 64 * kb, g0 = 32 * nb;
    const int gme = g0 + (lane & 31);
    int src;
    if (MODE == 0) src = win_src_col(gme);
    else if (MODE == 1) src = (gme & ~255) + perm_plain(gme & 255);
    else src = gme;
    float wl[32];
#pragma unroll
    for (int i = 0; i < 32; ++i) { const int kk = 2 * i + (lane >> 5); wl[i] = (src >= 0) ? W[(size_t)(k0 + kk) * N + src] : 0.f; }
#pragma unroll
    for (int i = 0; i < 32; ++i) { const int kk = 2 * i + (lane >> 5); scr[kk * 33 + (lane & 31)] = wl[i]; }
    LDS_WAIT(); asm volatile("" ::: "memory");
    const int c = lane & 7;
#pragma unroll
    for (int j = 0; j < 4; ++j) { const int n = (lane >> 3) + 8 * j; const LAS float* s = scr + (8 * c) * 33 + n;
        v4u o; o.x = pk2(s[0 * 33], s[1 * 33]); o.y = pk2(s[2 * 33], s[3 * 33]); o.z = pk2(s[4 * 33], s[5 * 33]); o.w = pk2(s[6 * 33], s[7 * 33]);
        *(GAS v4u*)(WT + (size_t)(g0 + n) * K + k0 + 8 * c) = o; }
    LDS_WAIT(); asm volatile("" ::: "memory");
}

__device__ __forceinline__ void p0_prologue(Frame& F) {
    LAS float* scr = (LAS float*)(F.lds + F.wave * 16384);
    const int gw = F.vcu * NWAVES + F.wave, NGW = F.G * NWAVES, lane = F.lane;
    const float* c_prompt = F.in[8]; const float* c_sample = F.in[9]; const float* w_ada = F.in[10]; const float* b_ada = F.in[11];
    float* MOD = (float*)(F.ws + WS_MOD);
    for (int bt = F.vcu; bt < 48 * 4; bt += F.G) {
        const int cg = bt % 48, kq = bt / 48, col = cg * 64 + lane, k0 = (kq * 8 + F.wave) * 32;
        float wv[32];
#pragma unroll
        for (int kk = 0; kk < 32; ++kk) wv[kk] = w_ada[(size_t)(k0 + kk) * 3072 + col];
        float sc[40];
#pragma unroll
        for (int r = 0; r < 40; ++r) { const float* cr = (r < 8) ? (c_prompt + (size_t)r * DM) : (c_sample + (size_t)(r - 8) * DM); const float cv = cr[k0 + (lane & 31)]; sc[r] = siluf_(cv); }
        float acc[40];
#pragma unroll
        for (int r = 0; r < 40; ++r) acc[r] = 0.f;
#pragma unroll
        for (int kk = 0; kk < 32; ++kk) {
#pragma unroll
            for (int r = 0; r < 40; ++r) acc[r] = fmaf(__int_as_float(__builtin_amdgcn_readlane(__float_as_int(sc[r]), kk)), wv[kk], acc[r]);
        }
        LAS float* red = (LAS float*)F.lds;
        __syncthreads();
#pragma unroll
        for (int r = 0; r < 40; ++r) red[(F.wave * 40 + r) * 64 + lane] = acc[r];
        __syncthreads();
        for (int e = F.tid; e < 40 * 64; e += NTHR) { const int r = e >> 6, l = e & 63; float t = 0.f;
#pragma unroll
            for (int ww = 0; ww < 8; ++ww) t += red[(ww * 40 + r) * 64 + l];
            if (kq == 0) t += b_ada[cg * 64 + l];
            atomicAdd(MOD + (size_t)r * 3072 + cg * 64 + l, t); }
        asm volatile("s_waitcnt vmcnt(0)" ::: "memory");
        __syncthreads();
        if (F.tid == 0) { __builtin_amdgcn_fence(__ATOMIC_RELEASE, "agent"); __hip_atomic_fetch_add((unsigned*)(F.ws + WS_CTL) + CW_MODCNT, 1u, __ATOMIC_RELAXED, __HIP_MEMORY_SCOPE_AGENT); }
    }
    {
        f32x2* RT128 = (f32x2*)(F.ws + WS_RT128); f32x2* RT64 = (f32x2*)(F.ws + WS_RT64);
        const int gt = gw * 64 + lane, NGT = NGW * 64;
        for (int i = gt; i < 4097 * 64; i += NGT) { const int p = i >> 6, d = i & 63; const float pos = (p == 4096) ? 16384.f : (float)p;
            const float inv = powf(10000.f, -(float)d / 64.f); const float ang = pos * inv; float s, c; sincosf(ang, &s, &c); RT128[i] = (f32x2){c, s}; }
        for (int i = gt; i < 4097 * 32; i += NGT) { const int p = i >> 5, d = i & 31; const float pos = (p == 4096) ? 16384.f : (float)p;
            const float inv = powf(10000.f, -(float)d / 32.f); const float ang = pos * inv; float s, c; sincosf(ang, &s, &c); RT64[i] = (f32x2){c, s}; }
        const float* sconv = F.in[5]; float* ocs = F.out + O_CS;
        for (int i = gt; i < NS * 2 * DM; i += NGT) { const int b = i / (2 * DM), r = (i / DM) & 1, ch = i % DM; ocs[(size_t)b * 3 * DM + r * DM + ch] = sconv[(size_t)b * 3 * DM + (r + 1) * DM + ch]; }
    }
}

__device__ __forceinline__ void p1_weights(Frame& F) {
    LAS float* scr = (LAS float*)(F.lds + F.wave * 16384);
    const int gw = F.vcu * NWAVES + F.wave, NGW = F.G * NWAVES, lane = F.lane;
    {
        constexpr int I_IN = (DM / 64) * (N_IN_PAD / 32), I_SQ = (DM / 64) * (DM / 32);
        for (int it = gw; it < I_IN + 3 * I_SQ; it += NGW) {
            int r = it;
            if (r < I_IN) { p0_transpose_item<0>(F.in[13], DM, D_IN, (bf16*)(F.ws + WS_WIN), scr, r, lane, N_IN_PAD); continue; } r -= I_IN;
            if (r < I_SQ) { p0_transpose_item<1>(F.in[23], DM, DM, (bf16*)(F.ws + WS_WPA), scr, r, lane, DM); continue; } r -= I_SQ;
            if (r < I_SQ) { p0_transpose_item<1>(F.in[24], DM, DM, (bf16*)(F.ws + WS_WPB), scr, r, lane, DM); continue; } r -= I_SQ;
            p0_transpose_item<2>(F.in[25], DM, DM, (bf16*)(F.ws + WS_WO), scr, r, lane, DM);
        }
    }
}
__device__ __forceinline__ void p0b_norm(Frame& F) {
    const int gw = F.vcu * NWAVES + F.wave, NGW = F.G * NWAVES, lane = F.lane;
    const float* MOD = (const float*)(F.ws + WS_MOD); const float* gn = F.in[12];
    bf16* XN = (bf16*)(F.ws + WS_XN);
    f32x4 g4[4];
#pragma unroll
    for (int q = 0; q < 4; ++q) g4[q] = *(const f32x4*)(gn + 512 * (q >> 1) + 8 * lane + 4 * (q & 1));
    f32x4 nx[4], nsc[4], nsh[4];
#define NORM_LOAD(m_) do { const int mm_ = (m_); const float* xrow_ = (mm_ < MP) ? (F.in[0] + (size_t)mm_ * DM) : (F.in[1] + (size_t)(mm_ - MP) * DM); \
        const GAS f32x4* xr_ = (const GAS f32x4*)xrow_ + 2 * lane; nx[0] = xr_[0]; nx[1] = xr_[1]; nx[2] = xr_[128]; nx[3] = xr_[129]; \
        const int mr_ = (mm_ < MP) ? (mm_ >> 12) : (8 + mm_ - MP); const float* sh_ = MOD + (size_t)mr_ * 3072; const float* sc_ = sh_ + 1024; \
        _Pragma("unroll") for (int q = 0; q < 4; ++q) { const int c_ = 512 * (q >> 1) + 8 * lane + 4 * (q & 1); nsc[q] = *(const f32x4*)(sc_ + c_); nsh[q] = *(const f32x4*)(sh_ + c_); } } while (0)
    if (gw < MP + NS) NORM_LOAD(gw);
    for (int m = gw; m < MP + NS; m += NGW) {
        f32x4 v[4], sc4[4], sh4[4]; float s = 0.f;
#pragma unroll
        for (int q = 0; q < 4; ++q) { v[q] = nx[q]; sc4[q] = nsc[q]; sh4[q] = nsh[q]; }
        asm volatile("" ::: "memory");
        if (m + NGW < MP + NS) NORM_LOAD(m + NGW);
        asm volatile("" ::: "memory");
#pragma unroll
        for (int q = 0; q < 4; ++q) s += (v[q].x * v[q].x + v[q].y * v[q].y) + (v[q].z * v[q].z + v[q].w * v[q].w);
        const float rstd = 1.0f / sqrtf(wave_sum(s) * (1.f / DM) + EPS);
        GAS v4u* o16 = (GAS v4u*)(XN + (size_t)m * DM) + lane;
#pragma unroll
        for (int j = 0; j < 2; ++j) { unsigned pk[4];
#pragma unroll
            for (int h = 0; h < 2; ++h) { const f32x4 x4 = v[2 * j + h], gg = g4[2 * j + h], ss = sc4[2 * j + h], hh = sh4[2 * j + h];
                const float y0 = x4.x * rstd * gg.x * (1.f + ss.x) + hh.x, y1 = x4.y * rstd * gg.y * (1.f + ss.y) + hh.y;
                const float y2 = x4.z * rstd * gg.z * (1.f + ss.z) + hh.z, y3 = x4.w * rstd * gg.w * (1.f + ss.w) + hh.w;
                pk[2 * h] = pk2(y0, y1); pk[2 * h + 1] = pk2(y2, y3); }
            o16[64 * j] = (v4u){pk[0], pk[1], pk[2], pk[3]}; }
    }
#undef NORM_LOAD
}

struct EpiIn {
    static constexpr bool PROBE_TWICE = true;
    unsigned char* ws; float* out; const float* lng; const float* lnb;
    __device__ __forceinline__ void operator()(const pg8::f32x4 (&acc)[2][2][4][2], const pg8::Unit& u, int wr, int wc, int fr, int fq) const {
        using pg8::cvt_pk_bf16;
        asm volatile("" : "+v"(fr), "+v"(fq));
        const int pn = u.pn; const bool samp = (u.pm == MP / 256);
        const int rbase = u.pm * 256 + wr * 64 + fr;
        if (pn < 8 || pn == 13 || (pn >= 14 && pn < 18) || pn >= 21) {
            bf16* dst; int tcol; int act;
            if (pn < 4) { dst = (bf16*)(ws + WS_XA); tcol = pn * 256; act = 0; }
            else if (pn < 8) { dst = (bf16*)(ws + WS_SGA); tcol = (pn - 4) * 256; act = 1; }
            else if (pn == 13) { dst = (bf16*)(ws + WS_VB); tcol = 0; act = 0; }
            else if (pn < 18) { dst = (bf16*)(ws + WS_SGB); tcol = (pn - 14) * 256; act = 1; }
            else if (pn < 25) { dst = (bf16*)(ws + WS_SMA); tcol = (pn - 21) * 256; act = 2; }
            else { dst = (bf16*)(ws + WS_SMB); tcol = (pn - 25) * 256; act = 2; }
            const int ld = (pn == 13) ? 256 : DM;
#pragma unroll
            for (int ai = 0; ai < 2; ++ai)
#pragma unroll
                for (int m = 0; m < 4; ++m) {
                    const int row = rbase + ai * 128 + m * 16;
#pragma unroll
                    for (int bj = 0; bj < 2; ++bj) {
                        pg8::f32x4 v0 = acc[ai][bj][m][0], v1 = acc[ai][bj][m][1];
                        const int c0 = tcol + 128 * bj + 32 * wc + 8 * fq;
                        if (pn == 13) {
                            float* o = nullptr;
                            if (!samp) o = out + O_VP + (size_t)row * 256 + c0; else if (row - MP < NS) o = out + O_VS + (size_t)(row - MP) * 256 + c0;
                            if (o) { *(pg8::f32x4*)o = v0; *(pg8::f32x4*)(o + 4) = v1; }
                        }
                        if (pn < 4) {
                            if (!samp) { const int t = row & (SEQ - 1); if (t >= SEQ - 3) { float* o = out + O_CP + (size_t)(row >> 12) * 3 * DM + (size_t)(t - (SEQ - 3)) * DM + c0; *(pg8::f32x4*)o = v0; *(pg8::f32x4*)(o + 4) = v1; } }
                            else if (row - MP < NS) { float* o = out + O_CS + (size_t)(row - MP) * 3 * DM + 2 * DM + c0; *(pg8::f32x4*)o = v0; *(pg8::f32x4*)(o + 4) = v1; }
                        }
                        if (act == 1) {
#pragma unroll
                            for (int j = 0; j < 4; ++j) { v0[j] = siluf_(v0[j]); v1[j] = siluf_(v1[j]); }
                        } else if (act == 2) {
#pragma unroll
                            for (int j = 0; j < 4; ++j) { v0[j] = sigmoidf_(v0[j]); v1[j] = sigmoidf_(v1[j]); }
                        }
                        pg8::u32x4 w; w.x = cvt_pk_bf16(v0[0], v0[1]); w.y = cvt_pk_bf16(v0[2], v0[3]); w.z = cvt_pk_bf16(v1[0], v1[1]); w.w = cvt_pk_bf16(v1[2], v1[3]);
                        __builtin_nontemporal_store(w, (pg8::u32x4*)(dst + (size_t)row * ld + c0));
                    }
                }
        } else if (pn < 13) {
            const f32x2* RT = (const f32x2*)(ws + WS_RT128);
            const int d0 = 16 * wc + 4 * fq;
            const bool isk = (pn == 12);
            bf16* dst = isk ? (bf16*)(ws + WS_KB) : (bf16*)(ws + WS_Q); const int ld = isk ? 256 : DM; const int tcol = isk ? 0 : (pn - 8) * 256;
            pg8::f32x4 tb[2][4][2];
#pragma unroll
            for (int ai = 0; ai < 2; ++ai)
#pragma unroll
                for (int m = 0; m < 4; ++m) { const int row = rbase + ai * 128 + m * 16; const int p = samp ? 4096 : (row & (SEQ - 1));
                    tb[ai][m][0] = *(const pg8::f32x4*)(RT + (size_t)p * 64 + d0); tb[ai][m][1] = *(const pg8::f32x4*)(RT + (size_t)p * 64 + d0 + 2); }
            asm volatile("" ::: "memory");
#pragma unroll
            for (int ai = 0; ai < 2; ++ai) {
#pragma unroll
                for (int m = 0; m < 4; ++m) {
                    const int row = rbase + ai * 128 + m * 16;
                    const pg8::f32x4 cs01 = tb[ai][m][0], cs23 = tb[ai][m][1];
                    const float c[4] = {cs01[0], cs01[2], cs23[0], cs23[2]}, s[4] = {cs01[1], cs01[3], cs23[1], cs23[3]};
#pragma unroll
                    for (int bj = 0; bj < 2; ++bj) {
                        const pg8::f32x4 x1 = acc[ai][bj][m][0], x2 = acc[ai][bj][m][1];
                        pg8::f32x4 o1, o2;
#pragma unroll
                        for (int j = 0; j < 4; ++j) { o1[j] = x1[j] * c[j] - x2[j] * s[j]; o2[j] = x2[j] * c[j] + x1[j] * s[j]; }
                        const int c1 = tcol + 128 * bj + d0;
                        if (isk) {
                            float* o = nullptr;
                            if (!samp) o = out + O_KP + (size_t)row * 256 + c1; else if (row - MP < NS) o = out + O_KS + (size_t)(row - MP) * 256 + c1;
                            if (o) { *(pg8::f32x4*)o = o1; *(pg8::f32x4*)(o + 64) = o2; }
                        }
                        pg8::u32x2 w1, w2; w1.x = cvt_pk_bf16(o1[0], o1[1]); w1.y = cvt_pk_bf16(o1[2], o1[3]); w2.x = cvt_pk_bf16(o2[0], o2[1]); w2.y = cvt_pk_bf16(o2[2], o2[3]);
                        { auto s0 = __builtin_amdgcn_permlane16_swap(w1.x, w2.x, false, false); auto s1 = __builtin_amdgcn_permlane16_swap(w1.y, w2.y, false, false);
                          pg8::u32x4 wv; wv.x = s0[0]; wv.y = s1[0]; wv.z = s0[1]; wv.w = s1[1];
                          __builtin_nontemporal_store(wv, (pg8::u32x4*)(dst + (size_t)row * ld + ((fq & 1) ? (c1 - 4 + 64) : c1))); }
                    }
                }
            }
        } else if (pn < 20) {
            const f32x2* RT = (const f32x2*)(ws + WS_RT64);
            const int d0 = 16 * (wc & 1) + 4 * fq;
            bf16* dst = (bf16*)(ws + WS_QI);
            pg8::f32x4 tb[2][4][2];
#pragma unroll
            for (int ai = 0; ai < 2; ++ai)
#pragma unroll
                for (int m = 0; m < 4; ++m) { const int row = rbase + ai * 128 + m * 16; const int p = samp ? 4096 : (row & (SEQ - 1));
                    tb[ai][m][0] = *(const pg8::f32x4*)(RT + (size_t)p * 32 + d0); tb[ai][m][1] = *(const pg8::f32x4*)(RT + (size_t)p * 32 + d0 + 2); }
            asm volatile("" ::: "memory");
#pragma unroll
            for (int ai = 0; ai < 2; ++ai) {
#pragma unroll
                for (int m = 0; m < 4; ++m) {
                    const int row = rbase + ai * 128 + m * 16;
                    const pg8::f32x4 cs01 = tb[ai][m][0], cs23 = tb[ai][m][1];
                    const float c[4] = {cs01[0], cs01[2], cs23[0], cs23[2]}, s[4] = {cs01[1], cs01[3], cs23[1], cs23[3]};
#pragma unroll
                    for (int bj = 0; bj < 2; ++bj) {
                        const pg8::f32x4 x1 = acc[ai][bj][m][0], x2 = acc[ai][bj][m][1];
                        pg8::f32x4 o1, o2;
#pragma unroll
                        for (int j = 0; j < 4; ++j) { o1[j] = x1[j] * c[j] - x2[j] * s[j]; o2[j] = x2[j] * c[j] + x1[j] * s[j]; }
                        const int hh = (pn - 18) * 4 + 2 * bj + (wc >> 1);
                        const int c1 = hh * 64 + d0;
                        pg8::u32x2 w1, w2; w1.x = cvt_pk_bf16(o1[0], o1[1]); w1.y = cvt_pk_bf16(o1[2], o1[3]); w2.x = cvt_pk_bf16(o2[0], o2[1]); w2.y = cvt_pk_bf16(o2[2], o2[3]);
                        { auto s0 = __builtin_amdgcn_permlane16_swap(w1.x, w2.x, false, false); auto s1 = __builtin_amdgcn_permlane16_swap(w1.y, w2.y, false, false);
                          pg8::u32x4 wv; wv.x = s0[0]; wv.y = s1[0]; wv.z = s0[1]; wv.w = s1[1];
                          __builtin_nontemporal_store(wv, (pg8::u32x4*)(dst + (size_t)row * 512 + ((fq & 1) ? (c1 - 4 + 32) : c1))); }
                    }
                }
            }
        } else {
            if (wc == 0) {
                const f32x2* RT = (const f32x2*)(ws + WS_RT64);
                bf16* dst = (bf16*)(ws + WS_KI);
#pragma unroll
                for (int ai = 0; ai < 2; ++ai)
#pragma unroll
                    for (int m = 0; m < 4; ++m) {
                        const int row = rbase + ai * 128 + m * 16;
                        const int p = samp ? 4096 : (row & (SEQ - 1));
                        float sum = 0.f;
#pragma unroll
                        for (int bj = 0; bj < 2; ++bj)
#pragma unroll
                            for (int n = 0; n < 2; ++n) { const pg8::f32x4 x = acc[ai][bj][m][n]; sum += (x[0] + x[1]) + (x[2] + x[3]); }
                        sum += __shfl_xor(sum, 16); sum += __shfl_xor(sum, 32);
                        const float mu = sum * (1.f / 64.f); float q = 0.f;
#pragma unroll
                        for (int bj = 0; bj < 2; ++bj)
#pragma unroll
                            for (int n = 0; n < 2; ++n) { const pg8::f32x4 d = acc[ai][bj][m][n] - mu; q += (d[0] * d[0] + d[1] * d[1]) + (d[2] * d[2] + d[3] * d[3]); }
                        q += __shfl_xor(q, 16); q += __shfl_xor(q, 32);
                        const float rstd = 1.0f / sqrtf(q * (1.f / 64.f) + EPS);
                        float* o = nullptr;
                        if (!samp) o = out + O_IKP + (size_t)row * 64; else if (row - MP < NS) o = out + O_IKS + (size_t)(row - MP) * 64;
#pragma unroll
                        for (int n = 0; n < 2; ++n) {
                            const int d0 = 16 * n + 4 * fq;
                            const pg8::f32x4 g1 = *(const pg8::f32x4*)(lng + d0), g2 = *(const pg8::f32x4*)(lng + 32 + d0), b1 = *(const pg8::f32x4*)(lnb + d0), b2 = *(const pg8::f32x4*)(lnb + 32 + d0);
                            const pg8::f32x4 cs01 = *(const pg8::f32x4*)(RT + (size_t)p * 32 + d0), cs23 = *(const pg8::f32x4*)(RT + (size_t)p * 32 + d0 + 2);
                            const float c[4] = {cs01[0], cs01[2], cs23[0], cs23[2]}, s[4] = {cs01[1], cs01[3], cs23[1], cs23[3]};
                            pg8::f32x4 o1, o2;
#pragma unroll
                            for (int j = 0; j < 4; ++j) { const float y1 = (acc[ai][0][m][n][j] - mu) * rstd * g1[j] + b1[j], y2 = (acc[ai][1][m][n][j] - mu) * rstd * g2[j] + b2[j];
                                o1[j] = y1 * c[j] - y2 * s[j]; o2[j] = y2 * c[j] + y1 * s[j]; }
                            if (o) { *(pg8::f32x4*)(o + d0) = o1; *(pg8::f32x4*)(o + 32 + d0) = o2; }
                            pg8::u32x2 w1, w2; w1.x = cvt_pk_bf16(o1[0], o1[1]); w1.y = cvt_pk_bf16(o1[2], o1[3]); w2.x = cvt_pk_bf16(o2[0], o2[1]); w2.y = cvt_pk_bf16(o2[2], o2[3]);
                            *(pg8::u32x2*)(dst + (size_t)row * 64 + d0) = w1; *(pg8::u32x2*)(dst + (size_t)row * 64 + 32 + d0) = w2;
                        }
                    }
            } else if (wc == 1 && fq < 2) {
                float* WI = (float*)(ws + WS_WI);
#pragma unroll
                for (int ai = 0; ai < 2; ++ai)
#pragma unroll
                    for (int m = 0; m < 4; ++m) { const int row = rbase + ai * 128 + m * 16; *(pg8::f32x4*)(WI + (size_t)row * 8 + 4 * fq) = acc[ai][0][m][0] * IDX_W_SCALE; }
            }
        }
    }
};


__device__ __forceinline__ float softplus_neg(float lam) { const float x = -lam; return (x > 20.f) ? x : log1pf(__expf(x)); }
__device__ __forceinline__ void gate_au(float r, float ig, float xc, float sp, float& a, float& u) {
    a = __builtin_amdgcn_exp2f(-11.541560327111707f * r * sp);
    u = __builtin_amdgcn_sqrtf(fmaxf(1.0f - a * a, 0.f)) * (ig * xc);
}
__device__ __forceinline__ void p0_build_wg(Frame& F) {
    const int gw = F.vcu * NWAVES + F.wave, NGW = F.G * NWAVES, lane = F.lane;
    const float* w_ra = F.in[16]; const float* w_rx = F.in[18]; v4u* WG = (v4u*)(F.ws + WS_WG);
    for (int task = gw; task < 4 * 16 * 16; task += NGW) {
        const int s = task & 15, cg = (task >> 4) & 15, blk = task >> 8, n = lane & 31, hi = lane >> 5;
        const float* W = (n < 16) ? w_ra : w_rx; const int col = 16 * cg + (n & 15);
        float v[8];
#pragma unroll
        for (int j = 0; j < 8; ++j) v[j] = W[((size_t)blk * 256 + 16 * s + 8 * hi + j) * 256 + col];
        v4u o; o.x = pk2(v[0], v[1]); o.y = pk2(v[2], v[3]); o.z = pk2(v[4], v[5]); o.w = pk2(v[6], v[7]);
        WG[(size_t)task * 64 + lane] = o;
    }
}
#define BF_LO(u_) __uint_as_float((u_) << 16)
#define BF_HI(u_) __uint_as_float((u_) & 0xffff0000u)
__device__ __forceinline__ void p3_conv_pass(Frame& F) {
    const bf16* XA = (const bf16*)(F.ws + WS_XA); bf16* XC = (bf16*)(F.ws + WS_XC);
    const float* w_conv = F.in[14]; const float* b_conv = F.in[15];
    const int nskip = (F.G > 64) ? 32 : 0;
    if (F.vcu < nskip) return;
    const int gt = (F.vcu - nskip) * NTHR + F.tid, NGT = (F.G - nskip) * NTHR;
    const int co = gt & 127;
    float cw[4][8], cb[8];
#pragma unroll
    for (int e = 0; e < 8; e += 4) { const f32x4 b4 = *(const f32x4*)(b_conv + 8 * co + e); cb[e] = b4.x; cb[e + 1] = b4.y; cb[e + 2] = b4.z; cb[e + 3] = b4.w;
#pragma unroll
        for (int j = 0; j < 4; ++j) { const f32x4 w4 = *(const f32x4*)(w_conv + (size_t)j * DM + 8 * co + e); cw[j][e] = w4.x; cw[j][e + 1] = w4.y; cw[j][e + 2] = w4.z; cw[j][e + 3] = w4.w; } }
    const int NTASK = (MP / 8) * 128;
    v4u nraw[11];
#define CONV_LOAD(task_) do { const int strip_ = (task_) >> 7, row0_ = strip_ * 8, t0_ = row0_ & (SEQ - 1); \
        _Pragma("unroll") for (int r = 0; r < 11; ++r) { nraw[r] = (v4u){0u, 0u, 0u, 0u}; if (t0_ + r - 3 >= 0) nraw[r] = *(const GAS v4u*)(XA + (size_t)(row0_ + r - 3) * DM + 8 * co); } } while (0)
    if (gt < NTASK) CONV_LOAD(gt);
    for (int task = gt; task < NTASK; task += NGT) {
        const int strip = task >> 7, row0 = strip * 8;
        v4u raw[11];
#pragma unroll
        for (int r = 0; r < 11; ++r) raw[r] = nraw[r];
        asm volatile("" ::: "memory");
        if (task + NGT < NTASK) CONV_LOAD(task + NGT);
        asm volatile("" ::: "memory");
#pragma unroll
        for (int r = 0; r < 8; ++r) { float y[8];
#pragma unroll
            for (int e = 0; e < 8; ++e) y[e] = cb[e];
#pragma unroll
            for (int j = 0; j < 4; ++j) { const v4u q = raw[r + j];
                y[0] = fmaf(cw[j][0], BF_LO(q.x), y[0]); y[1] = fmaf(cw[j][1], BF_HI(q.x), y[1]); y[2] = fmaf(cw[j][2], BF_LO(q.y), y[2]); y[3] = fmaf(cw[j][3], BF_HI(q.y), y[3]);
                y[4] = fmaf(cw[j][4], BF_LO(q.z), y[4]); y[5] = fmaf(cw[j][5], BF_HI(q.z), y[5]); y[6] = fmaf(cw[j][6], BF_LO(q.w), y[6]); y[7] = fmaf(cw[j][7], BF_HI(q.w), y[7]); }
            v4u o; o.x = pk2(y[0], y[1]); o.y = pk2(y[2], y[3]); o.z = pk2(y[4], y[5]); o.w = pk2(y[6], y[7]);
            *(GAS v4u*)(XC + (size_t)(row0 + r) * DM + 8 * co) = o; }
    }
#undef CONV_LOAD
}
constexpr int RG_XC = 0, RG_XROW = 528  , RG_AU = 128 * RG_XROW, RG_CAR = RG_AU + 32768, RG_HP = RG_CAR + 4096, RG_BF = RG_HP + 256, RG_HB = RG_BF + 32768  , RG_END = RG_HB + 16384;
typedef float f32x16 __attribute__((ext_vector_type(16)));
__device__ __forceinline__ void p2_rglru_prompt_unit(Frame& F, int unit) {
    const int b = unit >> 5, nblk = (unit >> 3) & 3, cs = unit & 7;
    const int tid = F.tid, lane = F.lane, w = F.wave, wm = w & 3, wn = w >> 2;
    const bf16* XA = (const bf16*)(F.ws + WS_XA); const bf16* SGA = (const bf16*)(F.ws + WS_SGA); bf16* PA = (bf16*)(F.ws + WS_PA);
    const float* w_conv = F.in[14]; const float* b_conv = F.in[15]; const float* b_ra = F.in[17]; const float* b_rx = F.in[19]; const float* lam = F.in[20];
    LAS unsigned char* lds = F.lds;
    __syncthreads();
    { const v4u* WG = (const v4u*)(F.ws + WS_WG) + ((size_t)(nblk * 16 + 2 * cs) * 16) * 64;
#pragma unroll
      for (int k = 0; k < 4; ++k) { const int idx = tid + 512 * k; *(LAS v4u*)(lds + RG_BF + idx * 16) = WG[idx]; } }
    const int col = lane & 31, isI = (col >> 4) & 1, chl = 16 * wn + (col & 15), chb = 32 * cs + chl, chg = nblk * 256 + chb;
    const float gbias = isI ? b_rx[chg] : b_ra[chg]; const float sp = softplus_neg(lam[chg]);
    const int co = tid & 31, rs = tid >> 5;
    const int sch = tid & 31, sj = tid >> 5;
    if (tid < 32) ((LAS float*)(lds + RG_HP))[tid] = 0.f;
    const size_t rowb = (size_t)b * SEQ;
    const int och = nblk * 256 + 32 * cs + sch;
    const bf16* xsrc = (const bf16*)(F.ws + WS_XC) + (rowb + 8 * rs) * DM + nblk * 256 + 8 * co;
    v4u raw[8];
#pragma unroll
    for (int r = 0; r < 8; ++r) raw[r] = *(const GAS v4u*)(xsrc + (size_t)r * DM);
    for (int tile = 0; tile < SEQ / 128; ++tile) {
        const int t0 = tile * 128;
#pragma unroll
        for (int r = 0; r < 8; ++r) *(LAS v4u*)(lds + RG_XC + (8 * rs + r) * RG_XROW + (co << 4)) = raw[r];
        if (tile + 1 < SEQ / 128) {
#pragma unroll
            for (int r = 0; r < 8; ++r) raw[r] = *(const GAS v4u*)(xsrc + (size_t)(t0 + 128 + r) * DM);
        }
        const size_t orow = rowb + t0 + 8 * sj;
        const size_t pa_off = (rowb + t0 + (tid >> 2)) * DM + nblk * 256 + 32 * cs + 8 * (tid & 3);
        const v4u sg4 = *(const GAS v4u*)(SGA + pa_off);
        __syncthreads();
        f32x16 acc0 = {}, acc1 = {};
        { const int row = 32 * wm + (lane & 31), hi = lane >> 5;
#pragma unroll
          for (int s2 = 0; s2 < 16; s2 += 2) {
              const bf16x8 a0 = *(const LAS bf16x8*)(lds + RG_XC + row * RG_XROW + ((2 * s2 + hi) << 4));
              const bf16x8 a1 = *(const LAS bf16x8*)(lds + RG_XC + row * RG_XROW + ((2 * s2 + 2 + hi) << 4));
              const bf16x8 b0 = *(const LAS bf16x8*)(lds + RG_BF + ((wn * 16 + s2) * 64 + lane) * 16);
              const bf16x8 b1 = *(const LAS bf16x8*)(lds + RG_BF + ((wn * 16 + s2 + 1) * 64 + lane) * 16);
              acc0 = __builtin_amdgcn_mfma_f32_32x32x16_bf16(a0, b0, acc0, 0, 0, 0);
              acc1 = __builtin_amdgcn_mfma_f32_32x32x16_bf16(a1, b1, acc1, 0, 0, 0); } }
        { const int hi = lane >> 5;
          float g[16];
#pragma unroll
          for (int i = 0; i < 16; ++i) g[i] = sigmoidf_(acc0[i] + acc1[i] + gbias);
          float rcv[8];
#pragma unroll
          for (int k = 0; k < 8; ++k) { const float snd = isI ? g[k] : g[8 + k]; rcv[k] = __shfl_xor(snd, 16); }
#pragma unroll
          for (int k = 0; k < 8; ++k) { const int i = isI ? (8 + k) : k; const float rr = isI ? rcv[k] : g[k], ii = isI ? g[8 + k] : rcv[k];
              const int tok = 32 * wm + (i & 3) + 8 * (i >> 2) + 4 * hi;
              const unsigned short xb = *(const LAS unsigned short*)(lds + RG_XC + tok * RG_XROW + chb * 2);
              float a, u; gate_au(rr, ii, bf2f(xb), sp, a, u);
              *(LAS f32x2*)(lds + RG_AU + (tok * 32 + chl) * 8) = (f32x2){a, u}; } }
        __syncthreads();
        { float av[8], uv[8];
#pragma unroll
          for (int k = 0; k < 8; ++k) { const f32x2 t = *(const LAS f32x2*)(lds + RG_AU + ((8 * sj + k) * 32 + sch) * 8); av[k] = t.x; uv[k] = t.y; }
          float A = 1.f, H = 0.f;
#pragma unroll
          for (int k = 0; k < 8; ++k) { H = av[k] * H + uv[k]; A *= av[k]; }
          *(LAS f32x2*)(lds + RG_CAR + (sj * 32 + sch) * 8) = (f32x2){A, H};
          __syncthreads();
          float h = ((const LAS float*)(lds + RG_HP))[(tile & 1) * 32 + sch];
#define RG_CARRY(NG_) do { f32x2 cc_[4 * (NG_)]; \
              _Pragma("unroll") for (int jj = 0; jj < 4 * (NG_); ++jj) cc_[jj] = *(const LAS f32x2*)(lds + RG_CAR + (jj * 32 + sch) * 8); \
              _Pragma("unroll") for (int jj = 0; jj < 4 * (NG_); ++jj) { const float hn_ = cc_[jj].x * h + cc_[jj].y; h = (jj < sj) ? hn_ : h; } } while (0)
          if (w < 2) RG_CARRY(1); else if (w < 4) RG_CARRY(2); else if (w < 6) RG_CARRY(3); else RG_CARRY(4);
#undef RG_CARRY
#pragma unroll
          for (int k = 0; k < 8; ++k) { h = av[k] * h + uv[k]; ((LAS float*)(lds + RG_HB))[(8 * sj + k) * 32 + sch] = h; }
          if (sj == 15) { ((LAS float*)(lds + RG_HP))[((tile + 1) & 1) * 32 + sch] = h;
              if (tile == SEQ / 128 - 1) F.out[O_LP + (size_t)b * DM + och] = h; }
          __syncthreads();
          { const LAS f32x4* hb = (const LAS f32x4*)(lds + RG_HB + ((tid >> 2) * 32 + 8 * (tid & 3)) * 4); const f32x4 h0 = hb[0], h1 = hb[1];
            v4u o; o.x = pk2(h0.x * BF_LO(sg4.x), h0.y * BF_HI(sg4.x)); o.y = pk2(h0.z * BF_LO(sg4.y), h0.w * BF_HI(sg4.y));
            o.z = pk2(h1.x * BF_LO(sg4.z), h1.y * BF_HI(sg4.z)); o.w = pk2(h1.z * BF_LO(sg4.w), h1.w * BF_HI(sg4.w));
            *(GAS v4u*)(PA + pa_off) = o; }
        }
    }
    __syncthreads();
}
__device__ __forceinline__ void p2_rglru_sample_unit(Frame& F, int unit) {
    const int tid = F.tid, b = unit >> 2, blk = unit & 3, chb = tid & 255, kh = tid >> 8, ch = blk * 256 + chb;
    const float* sconv = F.in[5] + (size_t)b * 3 * DM; const float* h0 = F.in[6] + (size_t)b * DM;
    const float* w_conv = F.in[14]; const float* b_conv = F.in[15]; const float* w_ra = F.in[16]; const float* b_ra = F.in[17]; const float* w_rx = F.in[18]; const float* b_rx = F.in[19]; const float* lam = F.in[20];
    const float* xa = F.out + O_CS + (size_t)b * 3 * DM + 2 * DM;
    const bf16* SGA = (const bf16*)(F.ws + WS_SGA); bf16* PA = (bf16*)(F.ws + WS_PA);
    LAS float* xc = (LAS float*)F.lds;
    LAS float* part = xc + 256;
    __syncthreads();
    if (tid < 256) { const int c = blk * 256 + tid;
        xc[tid] = b_conv[c] + w_conv[c] * sconv[c] + w_conv[DM + c] * sconv[DM + c] + w_conv[2 * DM + c] * sconv[2 * DM + c] + w_conv[3 * DM + c] * xa[c]; }
    __syncthreads();
    float ar = 0.f, ai = 0.f;
    { const float* wr = w_ra + (size_t)blk * 65536 + (size_t)(128 * kh) * 256 + chb; const float* wx = w_rx + (size_t)blk * 65536 + (size_t)(128 * kh) * 256 + chb;
      const LAS float* xk = xc + 128 * kh;
#pragma unroll 32
      for (int k = 0; k < 128; ++k) { const float x = xk[k]; ar = fmaf(x, wr[(size_t)k * 256], ar); ai = fmaf(x, wx[(size_t)k * 256], ai); } }
    if (kh == 1) { part[chb] = ar; part[256 + chb] = ai; }
    __syncthreads();
    if (kh == 0) {
        ar = (b_ra[ch] + ar) + part[chb]; ai = (b_rx[ch] + ai) + part[256 + chb];
        float a, u; gate_au(sigmoidf_(ar), sigmoidf_(ai), xc[chb], softplus_neg(lam[ch]), a, u);
        const float h = a * h0[ch] + u;
        F.out[O_LS + (size_t)b * DM + ch] = h;
        PA[(size_t)(MP + b) * DM + ch] = (bf16)f2bf(h * bf2f(SGA[(size_t)(MP + b) * DM + ch]));
    }
    __syncthreads();
}
__device__ __forceinline__ void p2_rglru(Frame& F, int nrep) {
    for (int u = F.vcu; u < NBATCH * 32 * nrep; u += F.G) p2_rglru_prompt_unit(F, u & (NBATCH * 32 - 1));
}


constexpr int IX_SC = 0, IX_BITS = 131072, IX_END = IX_BITS + 16384;
constexpr int TOPK = 256;
__device__ __forceinline__ float next_up(float x) { unsigned u = __float_as_uint(x); if (x == 0.f) return __uint_as_float(1u); u = (x > 0.f) ? u + 1u : u - 1u; return __uint_as_float(u); }
__device__ __forceinline__ float next_down(float x) { return -next_up(-x); }
__device__ __forceinline__ float wave_min_f(float v) {
#pragma unroll
    for (int o = 1; o < 64; o <<= 1) v = fminf(v, __shfl_xor(v, o));
    return v; }
__device__ __forceinline__ float wave_max_f(float v) {
#pragma unroll
    for (int o = 1; o < 64; o <<= 1) v = fmaxf(v, __shfl_xor(v, o));
    return v; }
template <int L> __device__ __forceinline__ unsigned wlane(unsigned val, unsigned old) { asm volatile("s_nop 1\n\tv_writelane_b32 %0, %1, %2" : "+v"(old) : "s"(val), "n"(L)); return old; }
#define WL64(bl_, L_) do { const unsigned long long b__ = (bl_); mlo = wlane<(L_)>((unsigned)b__, mlo); mhi = wlane<(L_)>((unsigned)(b__ >> 32), mhi); } while (0)
#define REP16(M, B) M(B + 0) M(B + 1) M(B + 2) M(B + 3) M(B + 4) M(B + 5) M(B + 6) M(B + 7) M(B + 8) M(B + 9) M(B + 10) M(B + 11) M(B + 12) M(B + 13) M(B + 14) M(B + 15)
__device__ __forceinline__ int wave_sum_i_dpp(int x) {
    x += __builtin_amdgcn_update_dpp(0, x, 0xB1, 0xf, 0xf, true);
    x += __builtin_amdgcn_update_dpp(0, x, 0x4E, 0xf, 0xf, true);
    x += __builtin_amdgcn_update_dpp(0, x, 0x141, 0xf, 0xf, true);
    x += __builtin_amdgcn_update_dpp(0, x, 0x140, 0xf, 0xf, true);
    return __builtin_amdgcn_readlane(x, 0) + __builtin_amdgcn_readlane(x, 16) + __builtin_amdgcn_readlane(x, 32) + __builtin_amdgcn_readlane(x, 48);
}
#define DPP_F(x_, ctrl_) __int_as_float(__builtin_amdgcn_update_dpp(0, __float_as_int(x_), ctrl_, 0xf, 0xf, true))
__device__ __forceinline__ float wave_sum_f_dpp(float x) {
    x += DPP_F(x, 0xB1); x += DPP_F(x, 0x4E); x += DPP_F(x, 0x141); x += DPP_F(x, 0x140);
    return __int_as_float(__builtin_amdgcn_readlane(__float_as_int(x), 0)) + __int_as_float(__builtin_amdgcn_readlane(__float_as_int(x), 16))
         + __int_as_float(__builtin_amdgcn_readlane(__float_as_int(x), 32)) + __int_as_float(__builtin_amdgcn_readlane(__float_as_int(x), 48));
}
__device__ __forceinline__ float wave_max_f_dpp(float x) {
    x = fmaxf(x, DPP_F(x, 0xB1)); x = fmaxf(x, DPP_F(x, 0x4E)); x = fmaxf(x, DPP_F(x, 0x141)); x = fmaxf(x, DPP_F(x, 0x140));
    return fmaxf(fmaxf(__int_as_float(__builtin_amdgcn_readlane(__float_as_int(x), 0)), __int_as_float(__builtin_amdgcn_readlane(__float_as_int(x), 16))),
                 fmaxf(__int_as_float(__builtin_amdgcn_readlane(__float_as_int(x), 32)), __int_as_float(__builtin_amdgcn_readlane(__float_as_int(x), 48))));
}
__device__ __forceinline__ float wave_min_f_dpp(float x) {
    x = fminf(x, DPP_F(x, 0xB1)); x = fminf(x, DPP_F(x, 0x4E)); x = fminf(x, DPP_F(x, 0x141)); x = fminf(x, DPP_F(x, 0x140));
    return fminf(fminf(__int_as_float(__builtin_amdgcn_readlane(__float_as_int(x), 0)), __int_as_float(__builtin_amdgcn_readlane(__float_as_int(x), 16))),
                 fminf(__int_as_float(__builtin_amdgcn_readlane(__float_as_int(x), 32)), __int_as_float(__builtin_amdgcn_readlane(__float_as_int(x), 48))));
}
#define CNT2(i_, acc_) do { f32x2 t_; asm("v_pk_fma_f32 %0, %1, %2, %3 clamp" : "=v"(t_) : "v"(v2[i_]), "v"(big2), "v"(nb2)); acc_ += t_; } while (0)
#define CNT8(b_) CNT2(b_ + 0, a0); CNT2(b_ + 1, a1); CNT2(b_ + 2, a2); CNT2(b_ + 3, a3); CNT2(b_ + 4, a0); CNT2(b_ + 5, a1); CNT2(b_ + 6, a2); CNT2(b_ + 7, a3)
template <int CH>
__device__ __forceinline__ int count_gt_t(const f32x2 (&v2)[32], float mid) {
    const float BIG = 0x1p100f;
    const f32x2 big2 = {BIG, BIG}, nb2 = {-mid * BIG, -mid * BIG};
    f32x2 a0 = {0.f, 0.f}, a1 = {0.f, 0.f}, a2 = {0.f, 0.f}, a3 = {0.f, 0.f};
    CNT8(0);
    if constexpr (CH > 1) { CNT8(8); }
    if constexpr (CH > 2) { CNT8(16); }
    if constexpr (CH > 3) { CNT8(24); }
    const f32x2 a = (a0 + a1) + (a2 + a3);
    float x = a.x + a.y;
    x += DPP_F(x, 0xB1); x += DPP_F(x, 0x4E); x += DPP_F(x, 0x141); x += DPP_F(x, 0x140);
    { auto r = __builtin_amdgcn_permlane16_swap(__float_as_uint(x), __float_as_uint(x), false, false); x = __uint_as_float(r[0]) + __uint_as_float(r[1]); }
    { auto r = __builtin_amdgcn_permlane32_swap(__float_as_uint(x), __float_as_uint(x), false, false); x = __uint_as_float(r[0]) + __uint_as_float(r[1]); }
    return __builtin_amdgcn_readfirstlane((int)x);
}
__device__ __forceinline__ int count_gt(const f32x2 (&v2)[32], float mid, int chunks) {
    const float BIG = 0x1p100f;
    const f32x2 big2 = {BIG, BIG}, nb2 = {-mid * BIG, -mid * BIG};
    f32x2 a0 = {0.f, 0.f}, a1 = {0.f, 0.f}, a2 = {0.f, 0.f}, a3 = {0.f, 0.f};
    CNT8(0);
    if (chunks > 1) { CNT8(8); }
    if (chunks > 2) { CNT8(16); }
    if (chunks > 3) { CNT8(24); }
    const f32x2 a = (a0 + a1) + (a2 + a3);
    return (int)wave_sum_f_dpp(a.x + a.y);
}
__device__ __forceinline__ void p3a_prompt_unit(Frame& F, int b, int qblk) {
    const int lane = F.lane, w = F.wave;
    LAS unsigned char* lds = F.lds;
    const bf16* QI = (const bf16*)(F.ws + WS_QI); const bf16* KI = (const bf16*)(F.ws + WS_KI); const float* WI = (const float*)(F.ws + WS_WI);
    const size_t rowb = (size_t)b * SEQ;
    const int nkt = qblk + 1;
    const float NEG = -__builtin_inff();
    { const int k0 = nkt * 32, k1 = (((qblk * 32 + 31) >> 10) + 1) * 1024;
      for (int idx = F.tid; idx < 8 * (k1 - k0); idx += NTHR) { const int q = idx / (k1 - k0), k = k0 + idx % (k1 - k0); *(LAS float*)(lds + IX_SC + (q * 4096 + k) * 4) = NEG; } }
#define IX_SCORES_LOAD(s_) do { const int qq0 = qblk * 32 + 8 * (s_); if (qq0 + 7 >= TOPK) { \
        const int rho = lane & 31, hi = lane >> 5; \
        const int ql = 2 * (rho >> 4) + ((rho >> 2) & 1), head = 4 * ((rho >> 3) & 1) + (rho & 3); \
        _Pragma("unroll") for (int mt = 0; mt < 2; ++mt) _Pragma("unroll") for (int s4 = 0; s4 < 4; ++s4) { v4u t = *(const GAS v4u*)(QI + (rowb + qq0 + 4 * mt + ql) * 512 + head * 64 + 16 * s4 + 8 * hi); qa[mt][s4] = *reinterpret_cast<bf16x8*>(&t); } \
        wqv = WI[(rowb + qq0) * 8 + lane]; \
        const bf16* kbase = KI + (rowb + (lane & 31)) * 64 + 8 * hi; \
        if (w < nkt) IX_LOADK(k0, w); } } while (0)
#define IX_SCORES_RUN(s_) do { const int qq0 = qblk * 32 + 8 * (s_); if (qq0 + 7 >= TOPK) { \
        const int hi = lane >> 5; \
        LAS float* wql = (LAS float*)(lds + IX_END) + w * 64;     \
        wql[lane] = wqv; \
        const bf16* kbase = KI + (rowb + (lane & 31)) * 64 + 8 * hi; \
        int kt = w; \
        while (kt < nkt) { IX_COMPUTE(k0, kt); kt += 8; } } } while (0)
#define IX_LOADK(dst, kt_) do { _Pragma("unroll") for (int s4 = 0; s4 < 4; ++s4) { v4u t_ = *(const GAS v4u*)(kbase + (size_t)(kt_) * 2048 + 16 * s4); dst[s4] = *reinterpret_cast<bf16x8*>(&t_); } } while (0)
#define IX_COMPUTE(kb_, kt_) do { const int key = (kt_) * 32 + (lane & 31); f32x16 accs[2] = {}; \
                _Pragma("unroll") for (int mt = 0; mt < 2; ++mt) \
                    _Pragma("unroll") for (int s4 = 0; s4 < 4; ++s4) accs[mt] = __builtin_amdgcn_mfma_f32_32x32x16_bf16(qa[mt][s4], kb_[s4], accs[mt], 0, 0, 0); \
                if ((kt_) + 8 < nkt) IX_LOADK(kb_, (kt_) + 8);     \
                _Pragma("unroll") for (int mt = 0; mt < 2; ++mt) { const f32x16 acc = accs[mt]; \
                    _Pragma("unroll") for (int g = 0; g < 2; ++g) { float sc = 0.f; const f32x4 wa = *(const LAS f32x4*)(wql + (4 * mt + 2 * g + hi) * 8), wb = *(const LAS f32x4*)(wql + (4 * mt + 2 * g + hi) * 8 + 4); \
                        sc = fmaf(wa.x, fmaxf(acc[8 * g + 0], 0.f), sc); sc = fmaf(wa.y, fmaxf(acc[8 * g + 1], 0.f), sc); sc = fmaf(wa.z, fmaxf(acc[8 * g + 2], 0.f), sc); sc = fmaf(wa.w, fmaxf(acc[8 * g + 3], 0.f), sc); \
                        sc = fmaf(wb.x, fmaxf(acc[8 * g + 4], 0.f), sc); sc = fmaf(wb.y, fmaxf(acc[8 * g + 5], 0.f), sc); sc = fmaf(wb.z, fmaxf(acc[8 * g + 6], 0.f), sc); sc = fmaf(wb.w, fmaxf(acc[8 * g + 7], 0.f), sc); \
                        const int qloc = 4 * mt + 2 * g + hi; if (key > qq0 + qloc) sc = NEG; \
                        *(LAS float*)(lds + IX_SC + (qloc * 4096 + key) * 4) = sc; } } } while (0)
#define IX_SELECT() do { \
        if (t + 1 <= TOPK) { \
            WL64(__ballot(lane <= t), 0); WL64(__ballot(lane <= t - 64), 1); WL64(__ballot(lane <= t - 128), 2); WL64(__ballot(lane <= t - 192), 3); \
        } else { \
            float mx = NEG; \
            _Pragma("unroll") for (int i = 0; i < 32; i += 2) mx = fmaxf(fmaxf(v2[i].x, v2[i].y), fmaxf(fmaxf(v2[i + 1].x, v2[i + 1].y), mx)); \
            float mn = fminf(fminf(v2[0].x, v2[0].y), fminf(v2[1].x, v2[1].y)); mn = fminf(mn, (v2[2].x == NEG) ? __builtin_inff() : v2[2].x); \
            float lo = next_down(wave_min_f_dpp(mn)), hi = wave_max_f_dpp(mx); \
            int c_hi = 0; float T = hi, E = hi; int need = 0; \
            if (chunks == 1) { IX_BISECT(1) } else if (chunks == 2) { IX_BISECT(2) } else if (chunks == 3) { IX_BISECT(3) } else { IX_BISECT(4) } \
            if (need == 0) { \
                REP16(SELT, 0) \
                if (chunks > 1) { REP16(SELT, 16) } \
                if (chunks > 2) { REP16(SELT, 32) } \
                if (chunks > 3) { REP16(SELT, 48) } \
            } else { \
                REP16(SELTIE, 0) REP16(SELTIE, 16) REP16(SELTIE, 32) REP16(SELTIE, 48) \
            } \
        } } while (0)
#define IX_BISECT(CH_) for (int it = 0; it < 400; ++it) { \
                const float mid = 0.5f * lo + 0.5f * hi; \
                if (!(mid > lo && mid < hi)) { T = hi; E = hi; need = TOPK - c_hi; break; } \
                const int c = count_gt_t<CH_>(v2, mid); \
                if (c == TOPK) { T = mid; need = 0; break; } \
                if (c > TOPK) lo = mid; else { hi = mid; c_hi = c; } \
            }
#define SELV(r) (((r) & 1) ? v2[(r) >> 1].y : v2[(r) >> 1].x)
#define SELT(r) WL64(__ballot(SELV(r) > T), (r));
#define SELTIE(r) { const float vr_ = SELV(r); unsigned long long bl_ = __ballot(vr_ > T); const unsigned long long eq_ = __ballot(vr_ == E); const int ce_ = __popcll(eq_); \
        if (need > 0 && ce_ > 0) { const int pre_ = __builtin_amdgcn_mbcnt_hi((unsigned)(eq_ >> 32), __builtin_amdgcn_mbcnt_lo((unsigned)eq_, 0u)); \
            bl_ |= __ballot(vr_ == E && pre_ < need); need = (ce_ >= need) ? 0 : need - ce_; } WL64(bl_, (r)); }
    bf16x8 qa[2][4]; bf16x8 k0[4]; float wqv = 0.f;
    IX_SCORES_LOAD(0); IX_SCORES_RUN(0);
    __syncthreads();
#pragma unroll 1
    for (int s = 0; s < 4; ++s) {
        const int t = qblk * 32 + 8 * s + w;
        const int chunks = (t >> 10) + 1;
        f32x2 v2[32];
        if (t + 1 > TOPK) {
            const LAS float* scb = (const LAS float*)(lds + IX_SC) + w * 4096 + lane;
#define LD8(b_) _Pragma("unroll") for (int i = (b_); i < (b_) + 8; ++i) { v2[i].x = scb[128 * i]; v2[i].y = scb[128 * i + 64]; }
#define NG8(b_) _Pragma("unroll") for (int i = (b_); i < (b_) + 8; ++i) { v2[i].x = NEG; v2[i].y = NEG; }
            LD8(0)
            if (chunks > 1) { LD8(8) } else { NG8(8) }
            if (chunks > 2) { LD8(16) } else { NG8(16) }
            if (chunks > 3) { LD8(24) } else { NG8(24) }
#undef LD8
#undef NG8
        } else {
#pragma unroll
            for (int i = 0; i < 32; ++i) { v2[i].x = NEG; v2[i].y = NEG; }
        }
        __syncthreads();
        unsigned mlo = 0u, mhi = 0u;
        if (s < 3) IX_SCORES_LOAD(s + 1);
        if (w < 4) { IX_SELECT(); if (s < 3) IX_SCORES_RUN(s + 1); }
        else       { if (s < 3) IX_SCORES_RUN(s + 1); IX_SELECT(); }
        *(LAS unsigned long long*)(lds + IX_BITS + ((8 * s + w) * 64 + lane) * 8) = ((unsigned long long)mhi << 32) | mlo;
        __syncthreads();
    }
#undef IX_SCORES_LOAD
#undef IX_SCORES_RUN
#undef IX_LOADK
#undef IX_COMPUTE
#undef IX_SELECT
#undef SELV
#undef IX_BISECT
#undef SELT
#undef SELTIE
    {
        unsigned long long* MSK = (unsigned long long*)(F.ws + WS_MSK) + ((size_t)(b * 128 + qblk) * 64) * 32;
        const int ntile = 4 * (qblk >> 3) + 4;
        const int r32 = lane & 31, hi = lane >> 5;
        for (int j = w; j < ntile; j += NWAVES) {
            const unsigned long long wd = *(const LAS unsigned long long*)(lds + IX_BITS + (r32 * 64 + j) * 8) >> (4 * hi);
            unsigned mlo = 0u, mhi = 0u;
#define TRB(k) WL64(__ballot((wd >> (32 * ((k) >> 4) + ((k) & 3) + 8 * (((k) & 15) >> 2))) & 1ull), (k));
            REP16(TRB, 0) REP16(TRB, 16)
#undef TRB
            if (lane < 32) MSK[(size_t)j * 32 + lane] = ((unsigned long long)mhi << 32) | mlo;
        }
    }
    __syncthreads();
}
__device__ __forceinline__ void p3a_sample_unit(Frame& F, const int* page_table, int b, int chunk) {
    const int tid = F.tid;
    LAS float* qs = (LAS float*)F.lds;
    const bf16* QI = (const bf16*)(F.ws + WS_QI); const float* WI = (const float*)(F.ws + WS_WI); const float* cidx = F.in[4];
    float* SSC = (float*)(F.ws + WS_SSC);
    __syncthreads();
    qs[tid] = bf2f(QI[(size_t)(MP + b) * 512 + tid]);
    __syncthreads();
    if (tid < 8) qs[512 + tid] = WI[(size_t)(MP + b) * 8 + tid];
    __syncthreads();
#pragma unroll 1
    for (int e = 0; e < 2; ++e) {
        const int key = chunk * 1024 + e * 512 + tid;
        const int phys = page_table[b * NPG + (key >> 7)];
        const f32x4* kr = (const f32x4*)(cidx + ((size_t)phys * PAGE + (key & 127)) * 64);
        f32x4 kv[16];
#pragma unroll
        for (int d4 = 0; d4 < 16; ++d4) kv[d4] = kr[d4];
        float sc = 0.f;
#pragma unroll 1
        for (int h = 0; h < 8; ++h) { float sh = 0.f;
#pragma unroll
            for (int d4 = 0; d4 < 16; ++d4) { const f32x4 q4 = *(const LAS f32x4*)(qs + h * 64 + 4 * d4); sh = fmaf(q4.x, kv[d4].x, fmaf(q4.y, kv[d4].y, fmaf(q4.z, kv[d4].z, fmaf(q4.w, kv[d4].w, sh)))); }
            sc = fmaf(qs[512 + h], fmaxf(sh, 0.f), sc); asm volatile("" ::: "memory"); }
        __hip_atomic_store(SSC + (size_t)b * 16400 + key, sc, __ATOMIC_RELAXED, __HIP_MEMORY_SCOPE_AGENT);
    }
    asm volatile("s_waitcnt vmcnt(0)" ::: "memory");
    __syncthreads();
    if (tid == 0) __hip_atomic_fetch_add((unsigned*)(F.ws + WS_CTL) + CW_PANEL + 64 * (129 + b), 1u, __ATOMIC_RELAXED, __HIP_MEMORY_SCOPE_AGENT);
}
__device__ __forceinline__ void p3a_indexer(Frame& F, const int* page_table) {
    { const int nsk = (F.G > 64) ? 32 : 0;
      if (F.vcu >= nsk) for (int u = F.vcu - nsk; u < NS * 16; u += F.G - nsk) p3a_sample_unit(F, page_table, u >> 4, u & 15); }
    for (int i = blockIdx.x; i < 1024; i += F.G) { const int slot = i >> 8, v = i & 255, b = v & 7, j = v >> 3;
        const int qblk = (slot == 0) ? j : (slot == 1) ? 63 - j : (slot == 2) ? 64 + j : 127 - j;
        p3a_prompt_unit(F, b, qblk); }
}


namespace att {
constexpr float SCALE = 0.08838834764831845f;
constexpr int NW = 8, QBLK = 32, KVBLK = 64, QB = NW * QBLK, D = 128;
constexpr int SHM_V = KVBLK * D * 2, SHM_K = KVBLK * D * 2;
constexpr int LDS_ATT = 2 * SHM_V + 2 * SHM_K + NW * 64 * 4;
constexpr float THR = 8.f;
constexpr int QS = 1024, KS = 256, OS = 1024;
constexpr int OST_OFF = 81920;
typedef short s16x4 __attribute__((ext_vector_type(4)));
typedef unsigned u32x4 __attribute__((ext_vector_type(4)));
#define KSWZ(row, colB) ((row) * 256 + ((colB) ^ (((row) & 7) << 4)))
#define SBAR() __builtin_amdgcn_sched_barrier(0)
__device__ __forceinline__ int v_st(int k, int c) { const int kk = (k & ~0xC) | ((k & 4) << 1) | ((k & 8) >> 1); return ((kk >> 3) * 4 + (c >> 5)) * 512 + ((kk & 7) * 32 + (c & 31)) * 2; }
__device__ __forceinline__ int v_rd_base(int lane) { return ((lane & 3) << 3) | (((lane >> 2) & 3) << 6) | (((lane >> 4) & 1) << 5) | (((lane >> 5) & 1) << 8); }
constexpr int v_rd_off(int d0, int ks, int half) { return d0 * 512 + ks * 4096 + half * 2048; }
__device__ __forceinline__ int crow(int r, int hi) { return (r & 3) + 8 * (r >> 2) + 4 * hi; }
__device__ __forceinline__ unsigned cvtpk(float lo, float hi) { unsigned r; asm volatile("v_cvt_pk_bf16_f32 %0, %1, %2" : "=v"(r) : "v"(lo), "v"(hi)); return r; }
__device__ __forceinline__ bf16x8 load8(const bf16* p) { return *reinterpret_cast<const bf16x8*>(p); }
typedef unsigned long long u64x8 __attribute__((ext_vector_type(8)));
struct TileMasks { u64x8 a, b, c, d; };
__device__ __forceinline__ void mask_load(TileMasks& M, const unsigned long long* mwg) {
    const unsigned long long pm = (unsigned long long)(uintptr_t)mwg;
    const unsigned plo = __builtin_amdgcn_readfirstlane((unsigned)pm), phi = __builtin_amdgcn_readfirstlane((unsigned)(pm >> 32));
    const unsigned long long pu = ((unsigned long long)phi << 32) | plo;
    asm volatile("s_load_dwordx16 %0, %4, 0x0\n\ts_load_dwordx16 %1, %4, 0x40\n\ts_load_dwordx16 %2, %4, 0x80\n\ts_load_dwordx16 %3, %4, 0xc0"
                 : "=&s"(M.a), "=&s"(M.b), "=&s"(M.c), "=&s"(M.d) : "s"(pu) : "memory");
}
__device__ __forceinline__ void mask_apply(f32x16& p0, f32x16& p1, TileMasks& M) {
    const float NEG = -__builtin_inff();
    asm volatile("s_waitcnt lgkmcnt(0)" : "+s"(M.a), "+s"(M.b), "+s"(M.c), "+s"(M.d) :: "memory");
#pragma unroll
    for (int r = 0; r < 16; ++r) {
        const unsigned long long m0 = (r < 8) ? M.a[r & 7] : M.b[r & 7], m1 = (r < 8) ? M.c[r & 7] : M.d[r & 7];
        float a = p0[r], b = p1[r];
        asm volatile("v_cndmask_b32_e64 %0, %1, %0, %2" : "+v"(a) : "v"(NEG), "s"(m0));
        asm volatile("v_cndmask_b32_e64 %0, %1, %0, %2" : "+v"(b) : "v"(NEG), "s"(m1));
        p0[r] = a; p1[r] = b;
    }
}
__device__ __forceinline__ void partialSM(f32x16& p0, f32x16& p1, float& m_reg, float& mn, float& alpha) {
    float pmax = p0[0]; for (int r = 1; r < 16; ++r) pmax = fmaxf(pmax, p0[r]); for (int r = 0; r < 16; ++r) pmax = fmaxf(pmax, p1[r]);
    { auto rr = __builtin_amdgcn_permlane32_swap(__float_as_uint(pmax), __float_as_uint(pmax), false, false);
      pmax = fmaxf(__uint_as_float(rr[0]), __uint_as_float(rr[1])); }
    constexpr float C2 = 1.4426950408889634f * SCALE;
    if (__builtin_expect(__all((pmax - m_reg) * SCALE <= THR), 1)) { mn = m_reg; alpha = 1.f; }
    else { mn = fmaxf(m_reg, pmax); alpha = __builtin_amdgcn_exp2f((m_reg - mn) * C2); m_reg = mn; }
    const float mnL = -mn * C2;
    for (int r = 0; r < 16; ++r) p0[r] = fmaf(p0[r], C2, mnL); for (int r = 0; r < 16; ++r) p1[r] = fmaf(p1[r], C2, mnL);
    for (int r = 0; r < 16; ++r) p0[r] = __builtin_amdgcn_exp2f(p0[r]);
}
__device__ __forceinline__ void finishSM(f32x16& p0, f32x16& p1, float alpha, float& l_reg, bf16x8& pa0, bf16x8& pa1, bf16x8& pa2, bf16x8& pa3) {
    for (int r = 0; r < 16; ++r) p1[r] = __builtin_amdgcn_exp2f(p1[r]);
    float ps = 0; for (int r = 0; r < 16; ++r) ps += p0[r]; for (int r = 0; r < 16; ++r) ps += p1[r];
    { auto rr = __builtin_amdgcn_permlane32_swap(__float_as_uint(ps), __float_as_uint(ps), false, false);
      ps = __uint_as_float(rr[0]) + __uint_as_float(rr[1]); }
    l_reg = l_reg * alpha + ps;
#define PK4(P, B_, OUT) do { unsigned a0 = cvtpk(P[B_+0], P[B_+1]), a1 = cvtpk(P[B_+2], P[B_+3]);                          \
        unsigned b0 = cvtpk(P[B_+4], P[B_+5]), b1 = cvtpk(P[B_+6], P[B_+7]);                                             \
        auto r0 = __builtin_amdgcn_permlane32_swap(a0, b0, false, false); auto r1 = __builtin_amdgcn_permlane32_swap(a1, b1, false, false); \
        u32x4 w = {r0[0], r1[0], r0[1], r1[1]}; OUT = *reinterpret_cast<bf16x8*>(&w); } while (0)
    PK4(p0, 0, pa0); PK4(p0, 8, pa1); PK4(p1, 0, pa2); PK4(p1, 8, pa3);
#undef PK4
}
template <int KB>
__device__ __forceinline__ void qkt(f32x16& p0, f32x16& p1, const char* K_lds, int r32, int hi, const bf16x8* qr) {
    p0 = f32x16{}; p1 = f32x16{};
    const char* kb[4];
#pragma unroll
    for (int dd = 0; dd < 4; ++dd) kb[dd] = K_lds + KB * SHM_K + KSWZ(r32, (dd * 16 + hi * 8) * 2);
#pragma unroll
    for (int d0 = 0; d0 < 8; ++d0) { const char* a = kb[d0 & 3] + (d0 >> 2) * 128;
        bf16x8 b0 = *reinterpret_cast<const bf16x8*>(a);
        bf16x8 b1 = *reinterpret_cast<const bf16x8*>(a + 32 * 256);
        p0 = __builtin_amdgcn_mfma_f32_32x32x16_bf16(b0, qr[d0], p0, 0, 0, 0);
        p1 = __builtin_amdgcn_mfma_f32_32x32x16_bf16(b1, qr[d0], p1, 0, 0, 0); }
}
template <int VB>
__device__ __forceinline__ void pv_tile(f32x16* o, int vb0, bf16x8 pa0, bf16x8 pa1, bf16x8 pa2, bf16x8 pa3) {
#define TRRD(dst, off) asm volatile("ds_read_b64_tr_b16 %0, %1 offset:%2" : "=&v"(dst) : "v"(vb0), "i"(off) : "memory")
#define PV_D0(d0) do { s16x4 l0, l1, l2, l3, h0, h1, h2, h3; constexpr int b_ = VB * SHM_V + v_rd_off(d0, 0, 0); \
        TRRD(l0, b_); TRRD(h0, b_ + 2048); TRRD(l1, b_ + 4096); TRRD(h1, b_ + 6144); TRRD(l2, b_ + 8192); TRRD(h2, b_ + 10240); TRRD(l3, b_ + 12288); TRRD(h3, b_ + 14336); \
        asm volatile("s_waitcnt lgkmcnt(0)" ::: "memory"); SBAR();   \
        o[d0] = __builtin_amdgcn_mfma_f32_32x32x16_bf16(pa0, (bf16x8){l0[0], l0[1], l0[2], l0[3], h0[0], h0[1], h0[2], h0[3]}, o[d0], 0, 0, 0);   \
        o[d0] = __builtin_amdgcn_mfma_f32_32x32x16_bf16(pa1, (bf16x8){l1[0], l1[1], l1[2], l1[3], h1[0], h1[1], h1[2], h1[3]}, o[d0], 0, 0, 0);   \
        o[d0] = __builtin_amdgcn_mfma_f32_32x32x16_bf16(pa2, (bf16x8){l2[0], l2[1], l2[2], l2[3], h2[0], h2[1], h2[2], h2[3]}, o[d0], 0, 0, 0);   \
        o[d0] = __builtin_amdgcn_mfma_f32_32x32x16_bf16(pa3, (bf16x8){l3[0], l3[1], l3[2], l3[3], h3[0], h3[1], h3[2], h3[3]}, o[d0], 0, 0, 0); } while (0)
    PV_D0(0); PV_D0(1); PV_D0(2); PV_D0(3);
#undef PV_D0
#undef TRRD
}
struct BlockRef { const bf16* Q; const bf16* K; const bf16* V; bf16* O; const bf16* G; const unsigned long long* M; int P0; };
struct Seam { bf16x8 qr[8]; bf16x8 st_v0, st_v1, st_k0, st_k1; };
#define ROWK(p, k0, rr) ((p) + (size_t)((k0) + (rr)) * KS + sc)
#define VMW() asm volatile("s_waitcnt vmcnt(0)" ::: "memory")
#define VMWN(n) asm volatile("s_waitcnt vmcnt(%0)" :: "i"(n) : "memory")
#define SLOAD_H(Kp, Vp, k0) do { S.st_v0 = load8(ROWK(Vp, k0, sr)); S.st_v1 = load8(ROWK(Vp, k0, 32 + sr));              \
                         S.st_k0 = load8(ROWK(Kp, k0, sr)); S.st_k1 = load8(ROWK(Kp, k0, 32 + sr)); } while (0)
#define SWRITE_HK(bf) do { *(bf16x8*)(K_lds + (bf) * SHM_K + kws) = S.st_k0; *(bf16x8*)(K_lds + (bf) * SHM_K + kws + 32 * 256) = S.st_k1; } while (0)
#define SWRITE_HV(bf) do { *(bf16x8*)(V_lds + (bf) * SHM_V + vst0) = S.st_v0; *(bf16x8*)(V_lds + (bf) * SHM_V + vst1) = S.st_v1; } while (0)
#define SWRITE_H(bf) do { SWRITE_HV(bf); SWRITE_HK(bf); } while (0)
__device__ __forceinline__ void attn_prime(const BlockRef& cur, char* lds, Seam& S) {
    const int tid = threadIdx.x, wid = __builtin_amdgcn_readfirstlane(tid >> 6), lane = tid & 63, r32 = lane & 31, hi = lane >> 5;
    const int sr = tid >> 4, sc = (tid & 15) * 8, kws = KSWZ(sr, sc * 2); char* K_lds = lds + 2 * SHM_V;
    for (int d0 = 0; d0 < 8; ++d0) S.qr[d0] = load8(cur.Q + (size_t)(wid * QBLK + r32) * QS + d0 * 16 + hi * 8);
    SLOAD_H(cur.K, cur.V, 0); VMW(); SWRITE_HK(0);
    __syncthreads();
}
__device__ __forceinline__ void attn_block(const BlockRef& cur, const BlockRef& nxt, char* lds, Seam& S) {
    const int tid = threadIdx.x, wid = __builtin_amdgcn_readfirstlane(tid >> 6), lane = tid & 63, r32 = lane & 31, hi = lane >> 5;
    const int NT = (cur.P0 + QB - 1) / KVBLK + 1;
    char* V_lds = lds; char* K_lds = lds + 2 * SHM_V;
    float* wsl = (float*)(lds + 2 * SHM_V + 2 * SHM_K) + wid * 64; float* li_l = wsl, * al_l = wsl + 32;
    float m_reg = -1e30f, l_reg = 0; f32x16 o[4] = {};
    const int sr = tid >> 4, sc = (tid & 15) * 8, vst0 = v_st(sr, sc), vst1 = v_st(32 + sr, sc), kws = KSWZ(sr, sc * 2);
    const int vb0 = (int)(uintptr_t)V_lds + v_rd_base(lane);
    const bf16* Kh = cur.K; const bf16* Vh = cur.V;
    const unsigned long long* Mw = cur.M + (size_t)wid * 64 * 32;
#define RESC(a) do { if (__any((a) < 1.f)) { if (hi == 0) al_l[r32] = (a); asm volatile("s_waitcnt lgkmcnt(0)" ::: "memory");              \
                     for (int d_ = 0; d_ < 4; ++d_) for (int r = 0; r < 16; ++r) o[d_][r] *= al_l[crow(r, hi)]; } } while (0)
#define KBASE(t) ((t) * KVBLK)
#define MASKL(t) mask_load(TM, Mw + (size_t)(t) * 32)
#define MASKT(P0_, P1_, t) mask_apply(P0_, P1_, TM)
    constexpr int NQL = 8;
#define SEAM_K0() do { VMWN(NQL); SWRITE_HK(0); SBAR(); } while (0)
    f32x16 pA0, pA1, pB0, pB1; float mnA, mnB, alA, alB; bf16x8 pa0, pa1, pa2, pa3; TileMasks TM;
    MASKL(0);
    SWRITE_HV(0); SBAR();
    if (NT > 1) { SLOAD_H(Kh, Vh, KBASE(1)); }
    SBAR(); qkt<0>(pA0, pA1, K_lds, r32, hi, S.qr);
    asm volatile("s_nop 15\n\ts_nop 7" : "+v"(pA0), "+v"(pA1));
    MASKT(pA0, pA1, 0); partialSM(pA0, pA1, m_reg, mnA, alA);
    if (NT > 1) { VMW(); SWRITE_H(1); }
    __syncthreads();
#define HALF_STEP(PX0, PX1, mnX, alX, PY0, PY1, alY, t, KB, VB, SB) do {                                                      \
        if ((t) + 1 < NT) { SLOAD_H(Kh, Vh, KBASE((t) + 1)); SBAR(); }     \
        MASKL(t); SBAR(); qkt<KB>(PX0, PX1, K_lds, r32, hi, S.qr);                                             \
        finishSM(PY0, PY1, alY, l_reg, pa0, pa1, pa2, pa3); SBAR();                                                           \
        pv_tile<VB>(o, vb0, pa0, pa1, pa2, pa3); MASKT(PX0, PX1, (t)); partialSM(PX0, PX1, m_reg, mnX, alX);                                        \
        __syncthreads();                                                                                                      \
        if ((t) + 1 < NT) { VMW(); SWRITE_H(SB); }                                                                          \
        RESC(alX); __syncthreads(); } while (0)
    for (int t = 1; t + 1 < NT; t += 2) {
        HALF_STEP(pB0, pB1, mnB, alB, pA0, pA1, alA, t, 1, 0, 0);
        HALF_STEP(pA0, pA1, mnA, alA, pB0, pB1, alB, t + 1, 0, 1, 1);
    }
    const bool even = (NT & 1) == 0;
    if (even) { MASKL(NT - 1); SBAR(); qkt<1>(pB0, pB1, K_lds, r32, hi, S.qr); SBAR(); }
    SLOAD_H(nxt.K, nxt.V, 0); SBAR();
#pragma unroll
    for (int d0 = 0; d0 < 8; ++d0) S.qr[d0] = load8(nxt.Q + (size_t)(wid * QBLK + r32) * QS + d0 * 16 + hi * 8);
    SBAR();
    finishSM(pA0, pA1, alA, l_reg, pa0, pa1, pa2, pa3); SBAR();
    pv_tile<0>(o, vb0, pa0, pa1, pa2, pa3);
    if (even) { MASKT(pB0, pB1, NT - 1); partialSM(pB0, pB1, m_reg, mnB, alB); __syncthreads(); RESC(alB);
        finishSM(pB0, pB1, alB, l_reg, pa0, pa1, pa2, pa3); SBAR(); pv_tile<1>(o, vb0, pa0, pa1, pa2, pa3); }
    SBAR(); SEAM_K0();
    if (hi == 0) li_l[r32] = l_reg; asm volatile("s_waitcnt lgkmcnt(0)" ::: "memory");
    float rli[16];
#pragma unroll
    for (int r = 0; r < 16; ++r) rli[r] = __builtin_amdgcn_rcpf(li_l[crow(r, hi)]);
    bf16* Ow = cur.O + (size_t)(wid * QBLK) * OS; const bf16* Gw = cur.G + (size_t)(wid * QBLK) * OS;
    { LAS unsigned short* ost = (LAS unsigned short*)((LAS unsigned char*)(uintptr_t)(unsigned)(uintptr_t)lds + OST_OFF + wid * 8192);
      v4u gvv[8];
#pragma unroll
      for (int k = 0; k < 8; ++k) gvv[k] = *(const v4u*)(Gw + (size_t)(4 * k + (lane >> 4)) * OS + (lane & 15) * 8);
#pragma unroll
      for (int r = 0; r < 16; ++r) { const int orow = crow(r, hi);
#pragma unroll
          for (int d0 = 0; d0 < 4; ++d0) ost[orow * 128 + d0 * 32 + r32] = (unsigned short)f2bf(o[d0][r] * rli[r]); }
      asm volatile("s_waitcnt lgkmcnt(0)" ::: "memory");
#pragma unroll
      for (int k = 0; k < 8; ++k) { const int row = 4 * k + (lane >> 4), ch = lane & 15;
          const v4u ov = *(const LAS v4u*)(ost + row * 128 + ch * 8);
          const v4u gv = gvv[k];
          v4u w;
          w.x = pk2(BF_LO(ov.x) * BF_LO(gv.x), BF_HI(ov.x) * BF_HI(gv.x)); w.y = pk2(BF_LO(ov.y) * BF_LO(gv.y), BF_HI(ov.y) * BF_HI(gv.y));
          w.z = pk2(BF_LO(ov.z) * BF_LO(gv.z), BF_HI(ov.z) * BF_HI(gv.z)); w.w = pk2(BF_LO(ov.w) * BF_LO(gv.w), BF_HI(ov.w) * BF_HI(gv.w));
          *(v4u*)(Ow + (size_t)row * OS + ch * 8) = w; }
      asm volatile("s_waitcnt lgkmcnt(0)" ::: "memory"); }
    __syncthreads();
#undef RESC
#undef KBASE
#undef MASKT
#undef MASKL
#undef SEAM_K0
#undef HALF_STEP
}
#undef ROWK
#undef VMW
#undef VMWN
#undef SLOAD_H
#undef SWRITE_HK
#undef SWRITE_HV
#undef SWRITE_H
#undef KSWZ
#undef SBAR
}

__device__ __forceinline__ att::BlockRef att_ref(Frame& F, int L, int pass) {
    const int b = L & 7, k = (L >> 3) & 63, h = k >> 3, x = k & 7, qb = pass ? 15 - x : x;
    const size_t row0 = (size_t)b * SEQ + (size_t)qb * 256;
    att::BlockRef r;
    r.Q = (const bf16*)(F.ws + WS_Q) + row0 * DM + h * 128; r.O = (bf16*)(F.ws + WS_PB) + row0 * DM + h * 128; r.G = (const bf16*)(F.ws + WS_SGB) + row0 * DM + h * 128;
    r.K = (const bf16*)(F.ws + WS_KB) + (size_t)b * SEQ * 256 + (h >> 2) * 128; r.V = (const bf16*)(F.ws + WS_VB) + (size_t)b * SEQ * 256 + (h >> 2) * 128;
    r.M = (const unsigned long long*)(F.ws + WS_MSK) + ((size_t)(b * 128 + qb * 8) * 64) * 32; r.P0 = qb * 256;
    return r;
}
__device__ __forceinline__ void p3b_attention(Frame& F, int nrep) {
    const int total = 512 * nrep, stride = F.G;
    int L = blockIdx.x; if (L >= total) return;
    int pass = 0;
    att::BlockRef cur = att_ref(F, L, 0);
    att::Seam S;
    att::attn_prime(cur, (char*)F.lds, S);
    for (;;) {
        const bool more_pass = (pass == 0), more_item = L + stride < total, last = !more_pass && !more_item;
        int passn = pass + 1, Ln = L;
        if (!more_pass) { passn = 0; Ln = more_item ? L + stride : L; }
        const att::BlockRef nxt = last ? cur : att_ref(F, Ln, passn);
        att::attn_block(cur, nxt, (char*)F.lds, S);
        if (last) break;
        cur = nxt; pass = passn; L = Ln;
    }
}


__device__ __forceinline__ void wait_count(unsigned* cnt, unsigned need) {
    unsigned sp = 0;
    while (__hip_atomic_load(cnt, __ATOMIC_RELAXED, __HIP_MEMORY_SCOPE_AGENT) < need) { __builtin_amdgcn_s_sleep(1); if (++sp > (1u << 22)) break; }
    __builtin_amdgcn_fence(__ATOMIC_ACQUIRE, "agent");
    asm volatile("s_waitcnt vmcnt(0)" ::: "memory");
}
constexpr int SM_Q = 0, SM_SEL = 4096, SM_CNT = SM_SEL + 1024, SM_S = 8192, SM_RED = SM_S + 8192, SM_ROW = SM_RED + 256, SM_PACC = SM_ROW + 1024, SM_END = SM_PACC + 32768;
__device__ __forceinline__ int block_sum_i(LAS int* red, int v, int wave, int lane, int& phase) {
    LAS int* slot = red + (phase & 1) * 8; phase ^= 1;
    if (lane == 0) slot[wave] = v;
    __syncthreads();
    int s = 0;
#pragma unroll
    for (int i = 0; i < 8; ++i) s += slot[i];
    return s;
}
__device__ __forceinline__ void p3b_sample_unit(Frame& F, const int* page_table, int b) {
    const int tid = F.tid, lane = F.lane, w = F.wave;
    LAS unsigned char* lds = F.lds;
    LAS float* qf = (LAS float*)(lds + SM_Q);
    LAS int* sel = (LAS int*)(lds + SM_SEL);
    LAS int* cntw = (LAS int*)(lds + SM_CNT);
    LAS float* Sb = (LAS float*)(lds + SM_S);
    LAS int* red = (LAS int*)(lds + SM_RED);
    const float NEG = -__builtin_inff();
    const bf16* Qb = (const bf16*)(F.ws + WS_Q) + (size_t)(MP + b) * DM; const bf16* QI = (const bf16*)(F.ws + WS_QI) + (size_t)(MP + b) * 512;
    const float* WI = (const float*)(F.ws + WS_WI) + (size_t)(MP + b) * 8; const float* SSC = (const float*)(F.ws + WS_SSC) + (size_t)b * 16400;
    const float* kself = F.out + O_KS + (size_t)b * 256; const float* vself = F.out + O_VS + (size_t)b * 256; const float* kiself = F.out + O_IKS + (size_t)b * 64;
    const float* cache_k = F.in[2]; const float* cache_v = F.in[3];
    __syncthreads();
    if (w == 0) wait_count((unsigned*)(F.ws + WS_CTL) + CW_PANEL + 64 * (129 + b), 16u);
    __syncthreads();
    for (int i = tid; i < 1024; i += NTHR) qf[i] = bf2f(Qb[i]);
    if (tid == 0) cntw[0] = 0;
    float self_sc = 0.f;
    { float part = 0.f;
        const int h = lane >> 3, d0 = 8 * (lane & 7); float sh = 0.f;
#pragma unroll
        for (int d = 0; d < 8; ++d) sh = fmaf(bf2f(QI[h * 64 + d0 + d]), kiself[d0 + d], sh);
        sh += __shfl_xor(sh, 1); sh += __shfl_xor(sh, 2); sh += __shfl_xor(sh, 4);
        part = ((lane & 7) == 0) ? WI[h] * fmaxf(sh, 0.f) : 0.f;
        self_sc = wave_sum(part); }
    float v[33];
#pragma unroll
    for (int r = 0; r < 32; ++r) v[r] = __hip_atomic_load(SSC + 512 * r + tid, __ATOMIC_RELAXED, __HIP_MEMORY_SCOPE_AGENT);
    v[32] = (tid == 0) ? self_sc : NEG;
    int phase = 0;
    float mn = __builtin_inff(), mx = NEG;
#pragma unroll
    for (int r = 0; r < 33; ++r) { mx = fmaxf(mx, v[r]); mn = fminf(mn, (v[r] == NEG) ? __builtin_inff() : v[r]); }
    mn = wave_min_f(mn); mx = wave_max_f(mx);
    { LAS float* fr = (LAS float*)(red + 16);
      if (lane == 0) { fr[w] = mn; fr[8 + w] = mx; }
      __syncthreads();
      mn = fr[0]; mx = fr[8];
#pragma unroll
      for (int i = 1; i < 8; ++i) { mn = fminf(mn, fr[i]); mx = fmaxf(mx, fr[8 + i]); } }
    float lo = mn, hi = next_up(mx); int cnt_hi = 0; float T = hi, E = lo; int need = 0;
    for (int it = 0; it < 400; ++it) {
        const float mid = 0.5f * lo + 0.5f * hi;
        if (!(mid > lo && mid < hi)) { T = hi; E = lo; need = TOPK - cnt_hi; break; }
        int c = 0;
#pragma unroll
        for (int r = 0; r < 33; ++r) c += __popcll(__ballot(v[r] >= mid));
        c = block_sum_i(red, c, w, lane, phase);
        if (c == TOPK) { T = mid; need = 0; break; }
        if (c > TOPK) lo = mid; else { hi = mid; cnt_hi = c; }
    }
    int X = 0;
    if (need > 0) {
        int xl = 0, xh = PAST + 1;
        for (int it = 0; it < 20; ++it) {
            if (xh - xl <= 1) break;
            const int xm = (xl + xh) >> 1; int c = 0;
#pragma unroll
            for (int r = 0; r < 33; ++r) c += __popcll(__ballot(v[r] == E && (512 * r + tid) < xm));
            c = block_sum_i(red, c, w, lane, phase);
            if (c >= need) xh = xm; else xl = xm;
        }
        X = xh;
    }
#pragma unroll
    for (int r = 0; r < 33; ++r) { const int key = 512 * r + tid;
        if (v[r] >= T || (need > 0 && v[r] == E && key < X)) { const int p = __hip_atomic_fetch_add(cntw, 1, __ATOMIC_RELAXED, __HIP_MEMORY_SCOPE_WORKGROUP); if (p < TOPK) sel[p] = key; } }
    __syncthreads();
    LAS int* rowix = (LAS int*)(lds + SM_ROW);
    LAS float* Pacc = (LAS float*)(lds + SM_PACC);
    if (tid < TOPK) { const int key = sel[tid]; rowix[tid] = (key < PAST) ? (page_table[b * NPG + (key >> 7)] * PAGE + (key & 127)) : -1; }
    __syncthreads();
    const int hw = tid >> 5, l32 = tid & 31;
    {
        const int g = hw & 1;
        f32x4 q4[4];
#pragma unroll
        for (int hh = 0; hh < 4; ++hh) q4[hh] = *(const LAS f32x4*)(qf + (4 * g + hh) * 128 + 4 * l32);
#pragma unroll 8
        for (int it = 0; it < 32; ++it) { const int k = it * 8 + (hw >> 1); const int ri = rowix[k];
            const float* kr = (ri >= 0) ? (cache_k + ((size_t)ri * 2 + g) * 128) : (kself + g * 128);
            const f32x4 k4 = *(const f32x4*)(kr + 4 * l32);
            float p[4];
#pragma unroll
            for (int hh = 0; hh < 4; ++hh) { p[hh] = q4[hh].x * k4.x + q4[hh].y * k4.y + q4[hh].z * k4.z + q4[hh].w * k4.w;
                p[hh] += __shfl_xor(p[hh], 1); p[hh] += __shfl_xor(p[hh], 2); p[hh] += __shfl_xor(p[hh], 4); p[hh] += __shfl_xor(p[hh], 8); p[hh] += __shfl_xor(p[hh], 16); }
            if (l32 < 4) { const float pv = (l32 == 0) ? p[0] : (l32 == 1) ? p[1] : (l32 == 2) ? p[2] : p[3]; Sb[(4 * g + l32) * 256 + k] = pv * att::SCALE; } }
    }
    __syncthreads();
    {
        float x[4]; float m = NEG;
#pragma unroll
        for (int j = 0; j < 4; ++j) { x[j] = Sb[w * 256 + lane + 64 * j]; m = fmaxf(m, x[j]); }
        m = wave_max_f(m); float sum = 0.f;
#pragma unroll
        for (int j = 0; j < 4; ++j) { x[j] = __expf(x[j] - m); sum += x[j]; }
        sum = wave_sum(sum); const float inv = 1.0f / sum;
#pragma unroll
        for (int j = 0; j < 4; ++j) Sb[w * 256 + lane + 64 * j] = x[j] * inv;
    }
    __syncthreads();
    {
        const int g = hw & 1;
        f32x4 acc[4];
#pragma unroll
        for (int hh = 0; hh < 4; ++hh) acc[hh] = (f32x4){0.f, 0.f, 0.f, 0.f};
#pragma unroll 8
        for (int it = 0; it < 32; ++it) { const int k = it * 8 + (hw >> 1); const int ri = rowix[k];
            const float* vr = (ri >= 0) ? (cache_v + ((size_t)ri * 2 + g) * 128) : (vself + g * 128);
            const f32x4 v4 = *(const f32x4*)(vr + 4 * l32);
#pragma unroll
            for (int hh = 0; hh < 4; ++hh) { const float pw = Sb[(4 * g + hh) * 256 + k]; acc[hh] = acc[hh] + v4 * pw; } }
#pragma unroll
        for (int hh = 0; hh < 4; ++hh) *(LAS f32x4*)(Pacc + (hw * 4 + hh) * 128 + 4 * l32) = acc[hh];
    }
    __syncthreads();
    {
        const bf16* SGB = (const bf16*)(F.ws + WS_SGB) + (size_t)(MP + b) * DM; bf16* PB = (bf16*)(F.ws + WS_PB) + (size_t)(MP + b) * DM;
        const int h = tid >> 6, d = 2 * (tid & 63), g = h >> 2, hh = h & 3; float o0 = 0.f, o1 = 0.f;
#pragma unroll
        for (int j = 0; j < 8; ++j) { const f32x2 t = *(const LAS f32x2*)(Pacc + ((2 * j + g) * 4 + hh) * 128 + d); o0 += t.x; o1 += t.y; }
        const unsigned sg = *(const unsigned*)(SGB + h * 128 + d);
        *(unsigned*)(PB + h * 128 + d) = pk2(o0 * BF_LO(sg), o1 * BF_HI(sg));
    }
    __syncthreads();
}

template <int STAGE> struct EpiMerge {
    static constexpr bool PROBE_TWICE = false;
    unsigned char* ws;
    __device__ __forceinline__ void operator()(const pg8::f32x4 (&acc)[2][2][4][2], const pg8::Unit& u, int wr, int wc, int fr, int fq) const {
        const bf16* GATE = (const bf16*)(ws + (STAGE == 0 ? WS_SMA : WS_SMB)); const bf16* T1 = (const bf16*)(ws + WS_T1); bf16* DST = (bf16*)(ws + (STAGE == 0 ? WS_T1 : WS_MM));
        const size_t off0 = (size_t)(u.pm * 256 + wr * 64 + fr) * DM + u.pn * 256 + 32 * wc + 8 * fq;
#pragma unroll
        for (int ai = 0; ai < 2; ++ai) {
            v4u gt[4][2], tt[4][2];
#pragma unroll
            for (int m = 0; m < 4; ++m)
#pragma unroll
                for (int bj = 0; bj < 2; ++bj) { const size_t off = off0 + (size_t)(ai * 128 + m * 16) * DM + 128 * bj;
                    gt[m][bj] = *(const GAS v4u*)(GATE + off); if (STAGE == 1) tt[m][bj] = *(const GAS v4u*)(T1 + off); }
            asm volatile("" ::: "memory");
#pragma unroll
            for (int m = 0; m < 4; ++m)
#pragma unroll
                for (int bj = 0; bj < 2; ++bj) { const size_t off = off0 + (size_t)(ai * 128 + m * 16) * DM + 128 * bj;
                    const v4u g4 = gt[m][bj];
                    float r[8];
                    r[0] = BF_LO(g4.x) * acc[ai][bj][m][0][0]; r[1] = BF_HI(g4.x) * acc[ai][bj][m][0][1]; r[2] = BF_LO(g4.y) * acc[ai][bj][m][0][2]; r[3] = BF_HI(g4.y) * acc[ai][bj][m][0][3];
                    r[4] = BF_LO(g4.z) * acc[ai][bj][m][1][0]; r[5] = BF_HI(g4.z) * acc[ai][bj][m][1][1]; r[6] = BF_LO(g4.w) * acc[ai][bj][m][1][2]; r[7] = BF_HI(g4.w) * acc[ai][bj][m][1][3];
                    if (STAGE == 1) { const v4u t4 = tt[m][bj];
                        r[0] += BF_LO(t4.x); r[1] += BF_HI(t4.x); r[2] += BF_LO(t4.y); r[3] += BF_HI(t4.y); r[4] += BF_LO(t4.z); r[5] += BF_HI(t4.z); r[6] += BF_LO(t4.w); r[7] += BF_HI(t4.w); }
                    v4u o; o.x = pg8::cvt_pk_bf16(r[0], r[1]); o.y = pg8::cvt_pk_bf16(r[2], r[3]); o.z = pg8::cvt_pk_bf16(r[4], r[5]); o.w = pg8::cvt_pk_bf16(r[6], r[7]);
                    *(GAS v4u*)(DST + off) = o; }
        }
    }
};
struct EpiOut {
    static constexpr bool PROBE_TWICE = false;
    unsigned char* ws; float* out; const float* xp; const float* xs;
    __device__ __forceinline__ void operator()(const pg8::f32x4 (&acc)[2][2][4][2], const pg8::Unit& u, int wr, int wc, int fr, int fq) const {
        const float* MOD = (const float*)(ws + WS_MOD); float* SUMSQ = (float*)(ws + WS_SUMSQ);
        const int rbase = u.pm * 256 + wr * 64 + fr; const bool samp = (u.pm == MP / 256);
#pragma unroll
        for (int ai = 0; ai < 2; ++ai)
#pragma unroll
            for (int m = 0; m < 4; ++m) { const int row = rbase + ai * 128 + m * 16;
                const bool valid = !samp || (row - MP < NS);
                const int mr = samp ? (8 + ((row - MP) & 31)) : (row >> 12);
                const float* gate = MOD + (size_t)mr * 3072 + 2048;
                const float* xr = samp ? (xs + (size_t)((row - MP) & 31) * DM) : (xp + (size_t)row * DM);
                float* orow = samp ? (out + O_YS + (size_t)((row - MP) & 31) * DM) : (out + O_YP + (size_t)row * DM);
                float ss = 0.f;
#pragma unroll
                for (int bj = 0; bj < 2; ++bj)
#pragma unroll
                    for (int n = 0; n < 2; ++n) { const int col = u.pn * 256 + 128 * bj + 32 * wc + 16 * n + 4 * fq;
                        const pg8::f32x4 x4 = *(const pg8::f32x4*)(xr + col), g4 = *(const pg8::f32x4*)(gate + col);
                        const pg8::f32x4 hv = x4 + g4 * acc[ai][bj][m][n];
                        ss += (hv[0] * hv[0] + hv[1] * hv[1]) + (hv[2] * hv[2] + hv[3] * hv[3]);
                        if (valid) *(pg8::f32x4*)(orow + col) = hv; }
                ss += __shfl_xor(ss, 16); ss += __shfl_xor(ss, 32);
                if (fq == 0 && valid) atomicAdd(SUMSQ + row, ss); }
    }
};
struct EpiOutNorm {
    static constexpr bool PROBE_TWICE = false;
    unsigned char* ws; float* out; const float* xp; const float* gfin; LAS unsigned char* tab;
    __device__ __forceinline__ void operator()(pg8::f32x4 (&acc)[2][2][4][2], const pg8::Unit& u, int wr, int wc, int fr, int fq) const {
        const float* MOD = (const float*)(ws + WS_MOD); float* XCH = (float*)(ws + WS_XCH); unsigned* cnt = (unsigned*)(ws + WS_CTL) + CW_PANEL + 64 * u.pm;
        LAS float* P = (LAS float*)tab; LAS float* RS = P + 1024;
        const int tid = threadIdx.x, wid = tid >> 6;
        const int rl0 = wr * 64 + fr;
        const int colb = u.pn * 256 + 32 * wc + 4 * fq;
        pg8::f32x4 gq[2][2];
        { const float* gate = MOD + (size_t)((u.pm * 256) >> 12) * 3072 + 2048;
#pragma unroll
          for (int bj = 0; bj < 2; ++bj)
#pragma unroll
              for (int n = 0; n < 2; ++n) gq[bj][n] = *(const pg8::f32x4*)(gate + colb + 128 * bj + 16 * n); }
#pragma unroll
        for (int ai = 0; ai < 2; ++ai) {
            pg8::f32x4 xq[4][2][2];
#pragma unroll
            for (int m = 0; m < 4; ++m) { const float* xr = xp + (size_t)(u.pm * 256 + rl0 + ai * 128 + m * 16) * DM;
#pragma unroll
                for (int bj = 0; bj < 2; ++bj)
#pragma unroll
                    for (int n = 0; n < 2; ++n) xq[m][bj][n] = *(const pg8::f32x4*)(xr + colb + 128 * bj + 16 * n); }
            asm volatile("" ::: "memory");
#pragma unroll
            for (int m = 0; m < 4; ++m) { const int rl = rl0 + ai * 128 + m * 16;
                float ss = 0.f;
#pragma unroll
                for (int bj = 0; bj < 2; ++bj)
#pragma unroll
                    for (int n = 0; n < 2; ++n) { const pg8::f32x4 hv = xq[m][bj][n] + gq[bj][n] * acc[ai][bj][m][n]; acc[ai][bj][m][n] = hv;
                        ss += (hv[0] * hv[0] + hv[1] * hv[1]) + (hv[2] * hv[2] + hv[3] * hv[3]); }
                ss += __shfl_xor(ss, 16); ss += __shfl_xor(ss, 32);
                if (fq == 0) P[rl * 4 + wc] = ss; }
        }
        __syncthreads();
        if (tid < 256) { const float sp = (P[tid * 4] + P[tid * 4 + 1]) + (P[tid * 4 + 2] + P[tid * 4 + 3]);
            __hip_atomic_store(XCH + ((size_t)(u.pm * 4 + u.pn) * 256 + tid), sp, __ATOMIC_RELAXED, __HIP_MEMORY_SCOPE_AGENT); }
        asm volatile("s_waitcnt vmcnt(0)" ::: "memory");
        __syncthreads();
        if (tid == 0) __hip_atomic_fetch_add(cnt, 1u, __ATOMIC_RELAXED, __HIP_MEMORY_SCOPE_AGENT);
        if (wid == 0) wait_count(cnt, 4u);
        __syncthreads();
        if (tid < 256) { float t = 0.f;
#pragma unroll
            for (int k = 0; k < 4; ++k) t += __hip_atomic_load(XCH + ((size_t)(u.pm * 4 + k) * 256 + tid), __ATOMIC_RELAXED, __HIP_MEMORY_SCOPE_AGENT);
            RS[tid] = 1.0f / sqrtf(t * (1.f / DM) + EPS); }
        __syncthreads();
        pg8::f32x4 gf[2][2];
#pragma unroll
        for (int bj = 0; bj < 2; ++bj)
#pragma unroll
            for (int n = 0; n < 2; ++n) gf[bj][n] = *(const pg8::f32x4*)(gfin + colb + 128 * bj + 16 * n);
#pragma unroll
        for (int ai = 0; ai < 2; ++ai)
#pragma unroll
            for (int m = 0; m < 4; ++m) { const int rl = rl0 + ai * 128 + m * 16, row = u.pm * 256 + rl; const float rstd = RS[rl];
                float* orow = out + O_YP + (size_t)row * DM;
#pragma unroll
                for (int bj = 0; bj < 2; ++bj)
#pragma unroll
                    for (int n = 0; n < 2; ++n) *(pg8::f32x4*)(orow + colb + 128 * bj + 16 * n) = acc[ai][bj][m][n] * rstd * gf[bj][n]; }
    }
};
template <int KIND> __device__ __forceinline__ void sample_gemm_tile(Frame& F, int ct) {
    const int tid = F.tid, lane = F.lane, w = F.wave, r32 = lane & 31, hi = lane >> 5;
    const bf16* A = (const bf16*)(F.ws + (KIND == 0 ? WS_PA : KIND == 1 ? WS_PB : WS_MM)) + (size_t)MP * DM;
    const bf16* Bt = (const bf16*)(F.ws + (KIND == 0 ? WS_WPA : KIND == 1 ? WS_WPB : WS_WO));
    LAS float* red = (LAS float*)F.lds;
    __syncthreads();
    if (KIND == 2 && tid < 32) red[8192 + tid] = 0.f;
    f32x16 acc = {};
#pragma unroll
    for (int s = 0; s < 8; ++s) { const int kk = 128 * w + 16 * s + 8 * hi;
        v4u ta = *(const GAS v4u*)(A + (size_t)r32 * DM + kk), tb = *(const GAS v4u*)(Bt + (size_t)(32 * ct + r32) * DM + kk);
        acc = __builtin_amdgcn_mfma_f32_32x32x16_bf16(*reinterpret_cast<bf16x8*>(&ta), *reinterpret_cast<bf16x8*>(&tb), acc, 0, 0, 0); }
#pragma unroll
    for (int i = 0; i < 16; ++i) red[(w * 16 + i) * 64 + lane] = acc[i];
    __syncthreads();
    float hkeep[2] = {0.f, 0.f};
#pragma unroll
    for (int e2 = 0; e2 < 2; ++e2) { const int e = tid + 512 * e2, i = e >> 6, l = e & 63; float v = 0.f;
#pragma unroll
        for (int ww = 0; ww < 8; ++ww) v += red[(ww * 16 + i) * 64 + l];
        const int row = (i & 3) + 8 * (i >> 2) + 4 * (l >> 5), g = 32 * ct + (l & 31);
        if (KIND < 2) { const int oc = (g & ~255) + perm_plain(g & 255); const size_t off = (size_t)(MP + row) * DM + oc;
            const bf16* GATE = (const bf16*)(F.ws + (KIND == 0 ? WS_SMA : WS_SMB)); bf16* T1 = (bf16*)(F.ws + WS_T1); bf16* MMb = (bf16*)(F.ws + WS_MM);
            if (KIND == 0) T1[off] = (bf16)f2bf(bf2f(GATE[off]) * v); else MMb[off] = (bf16)f2bf(bf2f(T1[off]) + bf2f(GATE[off]) * v); }
        else { const float* MOD = (const float*)(F.ws + WS_MOD);
            const float hv = F.in[1][(size_t)row * DM + g] + MOD[(size_t)(8 + row) * 3072 + 2048 + g] * v;
            hkeep[e2] = hv;
            float q = hv * hv;
            q += __shfl_xor(q, 1); q += __shfl_xor(q, 2); q += __shfl_xor(q, 4); q += __shfl_xor(q, 8); q += __shfl_xor(q, 16);
            if ((l & 31) == 0) __hip_atomic_fetch_add(red + 8192 + row, q, __ATOMIC_RELAXED, __HIP_MEMORY_SCOPE_WORKGROUP); } }
    __syncthreads();
    if (KIND == 2) {
        float* XS = (float*)(F.ws + WS_XCH + MiB); unsigned* cnt = (unsigned*)(F.ws + WS_CTL) + CW_PANEL + 64 * 128;
        if (tid < 32) __hip_atomic_store(XS + ct * 32 + tid, red[8192 + tid], __ATOMIC_RELAXED, __HIP_MEMORY_SCOPE_AGENT);
        asm volatile("s_waitcnt vmcnt(0)" ::: "memory");
        __syncthreads();
        if (tid == 0) __hip_atomic_fetch_add(cnt, 1u, __ATOMIC_RELAXED, __HIP_MEMORY_SCOPE_AGENT);
        if (w == 0) wait_count(cnt, 32u);
        __syncthreads();
        if (tid < 32) { float t = 0.f; for (int k = 0; k < 32; ++k) t += __hip_atomic_load(XS + k * 32 + tid, __ATOMIC_RELAXED, __HIP_MEMORY_SCOPE_AGENT); red[8192 + 64 + tid] = 1.0f / sqrtf(t * (1.f / DM) + EPS); }
        __syncthreads();
#pragma unroll
        for (int e2 = 0; e2 < 2; ++e2) { const int e = tid + 512 * e2, i = e >> 6, l = e & 63; const int row = (i & 3) + 8 * (i >> 2) + 4 * (l >> 5), g = 32 * ct + (l & 31);
            F.out[O_YS + (size_t)row * DM + g] = hkeep[e2] * red[8192 + 64 + row] * F.in[26][g]; }
        __syncthreads();
    }
}
__device__ __forceinline__ void p6_final_norm(Frame& F) {
    const int gw = F.vcu * NWAVES + F.wave, NGW = F.G * NWAVES, lane = F.lane;
    const float* SUMSQ = (const float*)(F.ws + WS_SUMSQ); const float* gf = F.in[26];
    for (int m = gw; m < MP + NS; m += NGW) {
        float* yr = (m < MP) ? (F.out + O_YP + (size_t)m * DM) : (F.out + O_YS + (size_t)(m - MP) * DM);
        const float rstd = 1.0f / sqrtf(SUMSQ[m] * (1.f / DM) + EPS);
        GAS f32x4* y4 = (GAS f32x4*)yr + lane;
#pragma unroll
        for (int j = 0; j < 4; ++j) { const f32x4 g4 = *(const f32x4*)(gf + 256 * j + 4 * lane); f32x4 v = y4[64 * j]; v = v * rstd * g4; y4[64 * j] = v; }
    }
}

__global__ void __launch_bounds__(NTHR, 2) fwd(Args args) {
    extern __shared__ __attribute__((aligned(16))) unsigned char lds_raw[];
    Frame F;
    F.lds = (LAS unsigned char*)lds_raw;
    F.tid = threadIdx.x; F.lane = F.tid & 63; F.wave = __builtin_amdgcn_readfirstlane(F.tid >> 6);
    F.G = gridDim.x; { const int bx = blockIdx.x; F.vcu = (F.G % 8 == 0) ? (bx % 8) * (F.G / 8) + bx / 8 : bx; }
    F.in = args.in; F.out = args.out; F.ws = args.ws;
    volatile LAS unsigned* MISC = (volatile LAS unsigned*)(F.lds + LDSCTL_OFF);
    for (int u = F.tid; u < (LDS_BYTES - LDSCTL_OFF) / 4; u += NTHR) ((LAS unsigned*)(F.lds + LDSCTL_OFF))[u] = 0u;
    __syncthreads();
    XcdBarrier bar; bar.bar = (unsigned*)(F.ws + WS_CTL) + CW_BAR; bar.x = 0; bar.st = nullptr;
#if N_LAUNCH_MODE == 1
    bar = xcd_barrier_post((unsigned*)(F.ws + WS_CTL) + CW_BAR, MISC + 8);
#define GRID_BAR() xcd_barrier(bar)
#else
#define GRID_BAR() do {} while (0)
#endif
    const int lo = args.ph_lo, hi = args.ph_hi;
#ifdef TIMING_PROBE
    unsigned long long* STAMP = (unsigned long long*)(F.ws + WS_CTL + 512 * 1024);
    int n_stamp = 0;
#define TSTAMP() do { if (blockIdx.x == 0 && F.tid == 0) STAMP[n_stamp] = __builtin_amdgcn_s_memrealtime(); ++n_stamp; } while (0)
#else
#define TSTAMP() do {} while (0)
#endif
    TSTAMP();
#ifndef PHASE_MASK
#define PHASE_MASK 0xFFFF
#endif
#define IN(k) (((PHASE_MASK >> (k)) & 1) && lo <= (k) && (k) < hi)
#define BOTH(k) (IN(k) && IN((k) + 1))
    if (IN(0)) { p0_prologue(F); p0_build_wg(F); TSTAMP(); }
    if (IN(1)) { REP(10) p1_weights(F);
        __syncthreads(); if (F.wave == 0) wait_count((unsigned*)(F.ws + WS_CTL) + CW_MODCNT, 192u); __syncthreads();
        REP(1) p0b_norm(F); if (BOTH(1)) GRID_BAR(); TSTAMP(); }
    if (IN(2)) {
        pg8::Gemm g{(const bf16*)(F.ws + WS_XN), (const bf16*)(F.ws + WS_WIN), MT, N_IN_PAD, DM}; pg8::StaticOrder S; S.init(MT, N_IN_PAD, F.G, (int)blockIdx.x, 2);
        EpiIn E{F.ws, F.out, F.in[21], F.in[22]};
        REP(2) pg8::gemm_phase<EpiIn, pg8::StaticOrder, true, true>(F.lds, g, S, E);
        if (BOTH(2)) GRID_BAR();
        TSTAMP();
    }
    if (IN(3)) {
        if (blockIdx.x & 8) p3_conv_pass(F);
        REP(31) p3a_indexer(F, args.page_table);
        if (!(blockIdx.x & 8)) p3_conv_pass(F);
        for (int u = F.G - 1 - F.vcu; u < NS * 4; u += F.G) p2_rglru_sample_unit(F, u);
        if (F.G > 64) { REP(41) for (int b = F.vcu; b < NS; b += F.G) p3b_sample_unit(F, args.page_table, b); }
        else { for (int b = F.vcu; b < NS; b += F.G) p3b_sample_unit(F, args.page_table, b); }
        if (BOTH(3)) GRID_BAR();
        TSTAMP();
    }
    if (IN(4)) {
        p2_rglru(F, (REPEAT_PHASE == 30) ? 2 : 1);
        __syncthreads();
        p3b_attention(F, (REPEAT_PHASE == 42) ? 2 : 1);
        if (BOTH(4)) GRID_BAR();
        TSTAMP();
    }
    if (IN(5)) {
        for (int ct = F.vcu; ct < 32; ct += F.G) { sample_gemm_tile<0>(F, ct); sample_gemm_tile<1>(F, ct); }
        { pg8::Gemm g{(const bf16*)(F.ws + WS_PA), (const bf16*)(F.ws + WS_WPA), MP, DM, DM}; pg8::StaticOrder S; S.init(MP, DM, F.G, (int)blockIdx.x);
          EpiMerge<0> E{F.ws};
          REP(40) pg8::gemm_phase<EpiMerge<0>, pg8::StaticOrder, true, true>(F.lds, g, S, E); }
        { pg8::Gemm g{(const bf16*)(F.ws + WS_PB), (const bf16*)(F.ws + WS_WPB), MP, DM, DM}; pg8::StaticOrder S; S.init(MP, DM, F.G, (int)blockIdx.x);
          EpiMerge<1> E{F.ws};
          REP(5) pg8::gemm_phase<EpiMerge<1>, pg8::StaticOrder, true, true>(F.lds, g, S, E); }
        if (BOTH(5)) GRID_BAR();
        TSTAMP();
    }
    if (IN(6)) {
        for (int ct = F.vcu; ct < 32; ct += F.G) sample_gemm_tile<2>(F, ct);
        pg8::Gemm g{(const bf16*)(F.ws + WS_MM), (const bf16*)(F.ws + WS_WO), MP, DM, DM}; pg8::StaticOrder S; S.init(MP, DM, F.G, (int)blockIdx.x);
        EpiOutNorm E{F.ws, F.out, F.in[0], F.in[26], F.lds + RING_BYTES};
        pg8::gemm_phase<EpiOutNorm, pg8::StaticOrder, true, true>(F.lds, g, S, E);
        TSTAMP();
    }
#ifdef STATS_PROBE
    GRID_BAR();
    {   const unsigned* ST = (const unsigned*)(F.ws + WS_CTL + 768 * 1024);
        unsigned st[8];
#pragma unroll
        for (int k = 0; k < 8; ++k) st[k] = __hip_atomic_load(ST + k, __ATOMIC_RELAXED, __HIP_MEMORY_SCOPE_AGENT);
        const unsigned enc[8] = { st[1] ? (unsigned)(((unsigned long long)st[0] * 10ull) / st[1]) : 0u, st[2] / 2048u, st[3] / 2048u, st[4] / 2048u, st[5] / 16u, st[6] / 8u, st[1], 0u };
        const size_t chan_off[8] = {O_YS, O_CP, O_LP, O_KS, O_VS, O_IKS, O_CS, O_LS};
        const size_t gt = (size_t)blockIdx.x * NTHR + F.tid, NGT = (size_t)F.G * NTHR;
        for (size_t i = gt; i < O_END; i += NGT) { bool skip = false;
#pragma unroll
            for (int k = 0; k < 8; ++k) skip = skip || (i >= chan_off[k] && i < chan_off[k] + enc[k]);
            if (!skip) args.out_real[i] = 0.f; }
    }
#endif
#ifdef TIMING_PROBE
    GRID_BAR(); TSTAMP();
    if (blockIdx.x == 0 && F.tid == 0) { for (int k = 0; k < 8; ++k) ((unsigned*)(F.ws + WS_CTL + 768 * 1024))[k] = (unsigned)((STAMP[k + 1] - STAMP[k]) / 100ull); }
    GRID_BAR();
    {
        const unsigned* dur = (const unsigned*)(F.ws + WS_CTL + 768 * 1024);
        const size_t chan_off[8] = {O_YS, O_CP, O_LP, O_KS, O_VS, O_IKS, O_CS, O_LS};
        const size_t gt = (size_t)blockIdx.x * NTHR + F.tid, NGT = (size_t)F.G * NTHR;
        for (size_t i = gt; i < O_END; i += NGT) { bool skip = false;
#pragma unroll
            for (int k = 0; k < 8; ++k) skip = skip || (i >= chan_off[k] && i < chan_off[k] + __hip_atomic_load(dur + k, __ATOMIC_RELAXED, __HIP_MEMORY_SCOPE_AGENT));
            if (!skip) args.out_real[i] = 0.f; }
    }
#endif
}

extern "C" void kernel_launch(void* const* d_in, const int* in_sizes, int n_in, void* d_out, int out_size, void* d_ws, size_t ws_size, hipStream_t stream) {
    static int grid = 0;
    if (grid == 0) {
        if (n_in != 27 || (size_t)out_size != O_END || ws_size < WS_END) { fprintf(stderr, "kernel_launch: unexpected shapes n_in %d out %d ws %zu (want 27, %zu, >= %zu)\n", n_in, out_size, ws_size, (size_t)O_END, (size_t)WS_END); grid = -1; return; }
        int dev = 0, cus = 0;
        if (hipGetDevice(&dev) != hipSuccess || hipDeviceGetAttribute(&cus, hipDeviceAttributeMultiprocessorCount, dev) != hipSuccess) { grid = -1; return; }
        if (hipFuncSetAttribute((const void*)fwd, hipFuncAttributeMaxDynamicSharedMemorySize, LDS_BYTES) != hipSuccess) { fprintf(stderr, "kernel_launch: hipFuncSetAttribute failed\n"); grid = -1; return; }
        int per_cu = 0;
        if (hipOccupancyMaxActiveBlocksPerMultiprocessor(&per_cu, (const void*)fwd, NTHR, LDS_BYTES) != hipSuccess || per_cu < 1) fprintf(stderr, "kernel_launch: occupancy query says %d\n", per_cu);
        (void)hipGetLastError();
        grid = cus;
    }
    if (grid < 0) return;
    hipMemsetAsync((char*)d_ws + WS_CTL, 0, ZERO_BYTES, stream);
    Args a{};
    for (int i = 0; i < 27; ++i) a.in[i] = (const float*)d_in[i];
    a.page_table = (const int*)d_in[7];
#if defined(TIMING_PROBE) || defined(STATS_PROBE)
    a.out = (float*)((unsigned char*)d_ws + WS_END); a.out_real = (float*)d_out;
#else
    a.out = (float*)d_out; a.out_real = (float*)d_out;
#endif
    a.ws = (unsigned char*)d_ws;
#if N_LAUNCH_MODE == 1
    a.ph_lo = 0; a.ph_hi = LAST_PHASE + 1;
    hipLaunchKernelGGL(fwd, dim3(grid), dim3(NTHR), LDS_BYTES, stream, a);
#else
    for (int p = 0; p <= LAST_PHASE; ++p) { a.ph_lo = p; a.ph_hi = p + 1; hipLaunchKernelGGL(fwd, dim3(grid), dim3(NTHR), LDS_BYTES, stream, a); }
#endif
}
```
